# Optimizing an MI355X kernel written in HIP

```python
import jax, jax.numpy as jnp
from jax import lax
import numpy as np

D_MODEL = 1024
BATCH = 8
SEQ = 2048
DEPTH = 1

A_HEADS = 8
A_KV_HEADS = 2
A_HEAD_DIM = 64
IDX_HEADS = 8
IDX_DIM = 64
TOPK_MAX = 256
B_HEADS = 8
B_HEAD_DIM = 64
A_WIDTH = A_HEADS * A_HEAD_DIM
B_WIDTH = B_HEADS * B_HEAD_DIM
MIX_WIDTH = A_WIDTH + B_WIDTH
A_KV_WIDTH = A_KV_HEADS * A_HEAD_DIM
IDX_Q_WIDTH = IDX_HEADS * IDX_DIM
IN_SPLITS = (A_WIDTH, A_KV_WIDTH, A_KV_WIDTH, IDX_Q_WIDTH, IDX_DIM, IDX_HEADS,
             B_WIDTH, B_WIDTH, B_WIDTH, B_HEADS)
IN_COLS = sum(IN_SPLITS)
Q_BLOCK = 128
N_GROUPS = 4
EXPERTS_PER_GROUP = 8
N_EXPERTS = N_GROUPS * EXPERTS_PER_GROUP
TOPK_EXPERT = 2
D_FF_EXPERT = D_MODEL // 4
N_MOD = 6
EPS = 1e-6

kernel_name = 'hymba_dsa_fox_hmoe_adaln_block'


def rms_norm(x, g):
    xf = x.astype(jnp.float32)
    y = xf * lax.rsqrt(jnp.mean(xf * xf, axis=-1, keepdims=True) + EPS)
    return (y * g.astype(jnp.float32)).astype(x.dtype)


def alibi_slopes(n):
    return jnp.exp2(-8.0 * jnp.arange(1, n + 1, dtype=jnp.float32) / n)


def to_blocks(a, nb):
    return jnp.moveaxis(a.reshape(a.shape[0], nb, Q_BLOCK, *a.shape[2:]), 1, 0)


def dsa_attention(q, k, v, iq, ik, iw):
    bsz, L = q.shape[0], q.shape[1]
    n_top = min(TOPK_MAX, L // 4)
    nb = L // Q_BLOCK
    rep = A_HEADS // A_KV_HEADS
    slopes = alibi_slopes(A_HEADS).reshape(A_KV_HEADS, rep)
    scale = A_HEAD_DIM ** -0.5
    kpos = jnp.arange(L)
    ikf = ik.astype(jnp.float32)

    def block(args):
        qb, iqb, iwb, t0 = args
        tpos = t0 + jnp.arange(Q_BLOCK)
        dots = jnp.einsum('bqhd,bsd->bqhs', iqb.astype(jnp.float32), ikf)
        score = jnp.einsum('bqh,bqhs->bqs', iwb.astype(jnp.float32), jax.nn.relu(dots))
        causal = kpos[None, :] <= tpos[:, None]
        score = jnp.where(causal[None], score, -jnp.inf)
        _, idx = lax.top_k(score, n_top)
        valid = idx <= tpos[None, :, None]
        ksel = jax.vmap(lambda kb, ib: kb[ib])(k, idx)
        vsel = jax.vmap(lambda vb, ib: vb[ib])(v, idx)
        qg = qb.reshape(bsz, Q_BLOCK, A_KV_HEADS, rep, A_HEAD_DIM)
        logits = jnp.einsum('bqgrd,bqkgd->bqgrk', qg, ksel).astype(jnp.float32) * scale
        dist = (tpos[None, :, None] - idx).astype(jnp.float32)
        logits = logits - slopes[None, None, :, :, None] * dist[:, :, None, None, :]
        logits = jnp.where(valid[:, :, None, None, :], logits, -jnp.inf)
        p = jax.nn.softmax(logits, axis=-1).astype(v.dtype)
        o = jnp.einsum('bqgrk,bqkgd->bqgrd', p, vsel)
        return o.reshape(bsz, Q_BLOCK, A_WIDTH)

    out = lax.map(block, (to_blocks(q, nb), to_blocks(iq, nb), to_blocks(iw, nb),
                          jnp.arange(nb, dtype=jnp.int32) * Q_BLOCK))
    return jnp.moveaxis(out, 0, 1).reshape(bsz, L, A_WIDTH)


def forgetting_attention(q, k, v, log_f):
    bsz, L = q.shape[0], q.shape[1]
    nb = L // Q_BLOCK
    scale = B_HEAD_DIM ** -0.5
    cum = jnp.cumsum(log_f, axis=1)
    cum_k = jnp.transpose(cum, (0, 2, 1))
    kpos = jnp.arange(L)

    def block(args):
        qb, cb, t0 = args
        tpos = t0 + jnp.arange(Q_BLOCK)
        logits = jnp.einsum('bqhd,bshd->bhqs', qb, k).astype(jnp.float32) * scale
        logits = logits + jnp.transpose(cb, (0, 2, 1))[..., None] - cum_k[:, :, None, :]
        causal = kpos[None, :] <= tpos[:, None]
        logits = jnp.where(causal[None, None], logits, -jnp.inf)
        p = jax.nn.softmax(logits, axis=-1).astype(v.dtype)
        o = jnp.einsum('bhqs,bshd->bqhd', p, v)
        return o.reshape(bsz, Q_BLOCK, B_WIDTH)

    out = lax.map(block, (to_blocks(q, nb), to_blocks(cum, nb),
                          jnp.arange(nb, dtype=jnp.int32) * Q_BLOCK))
    return jnp.moveaxis(out, 0, 1).reshape(bsz, L, B_WIDTH)


def hybrid_mixer(h, w_in, b_forget, g_out_a, g_out_b, w_out):
    bsz, L, _ = h.shape
    proj = h @ w_in
    (aq, ak, av, iq, ik, iw, bq, bk, bv, bf) = jnp.split(
        proj, list(np.cumsum(IN_SPLITS)[:-1]), axis=-1)
    oa = dsa_attention(aq.reshape(bsz, L, A_HEADS, A_HEAD_DIM),
                       ak.reshape(bsz, L, A_KV_HEADS, A_HEAD_DIM),
                       av.reshape(bsz, L, A_KV_HEADS, A_HEAD_DIM),
                       iq.reshape(bsz, L, IDX_HEADS, IDX_DIM), ik, iw)
    log_f = jax.nn.log_sigmoid(bf.astype(jnp.float32) + b_forget.astype(jnp.float32))
    ob = forgetting_attention(bq.reshape(bsz, L, B_HEADS, B_HEAD_DIM),
                              bk.reshape(bsz, L, B_HEADS, B_HEAD_DIM),
                              bv.reshape(bsz, L, B_HEADS, B_HEAD_DIM), log_f)
    o = jnp.concatenate([rms_norm(oa, g_out_a), rms_norm(ob, g_out_b)], axis=-1)
    return o @ w_out


def hierarchical_moe(h, w_group, b_group, w_router, b_router, w_gate, w_up, w_down):
    bsz, L, d = h.shape
    t = h.reshape(-1, d)
    g_logits = (t @ w_group).astype(jnp.float32) + b_group.astype(jnp.float32)
    g_prob = jax.nn.softmax(g_logits, axis=-1)
    g_sel = jnp.argmax(g_logits, axis=-1)
    p_group = jnp.take_along_axis(g_prob, g_sel[:, None], axis=1)[:, 0]
    e_all = jnp.einsum('nd,gde->nge', t, w_router).astype(jnp.float32) + b_router.astype(jnp.float32)
    e_logits = jnp.take_along_axis(e_all, g_sel[:, None, None], axis=1)[:, 0]
    top_v, top_i = lax.top_k(e_logits, TOPK_EXPERT)
    w_top = jax.nn.softmax(top_v, axis=-1) * p_group[:, None]
    eid = g_sel[:, None] * EXPERTS_PER_GROUP + top_i
    comb = jnp.sum(jax.nn.one_hot(eid, N_EXPERTS, dtype=jnp.float32) * w_top[..., None], axis=1)
    hg = jnp.einsum('nd,edf->nef', t, w_gate)
    hu = jnp.einsum('nd,edf->nef', t, w_up)
    a = jax.nn.silu(hg) * hu * comb[:, :, None].astype(h.dtype)
    y = jnp.einsum('nef,efd->nd', a, w_down)
    return y.reshape(bsz, L, d)


def setup_inputs(seed: int = 0) -> dict:
    key = jax.random.key(seed)
    ks = jax.random.split(key, 20)
    f32 = jnp.float32
    nrm = lambda k, shape, s: jax.random.normal(k, shape, f32) * s
    return {
        'x': nrm(ks[0], (BATCH, SEQ, D_MODEL), 1.0),
        'c': nrm(ks[1], (BATCH, D_MODEL), 1.0),
        'w_ada': nrm(ks[2], (DEPTH, D_MODEL, N_MOD * D_MODEL), 0.5 * D_MODEL ** -0.5),
        'b_ada': nrm(ks[3], (DEPTH, N_MOD * D_MODEL), 0.01),
        'g_mix': 1.0 + nrm(ks[4], (DEPTH, D_MODEL), 0.01),
        'w_in': nrm(ks[5], (DEPTH, D_MODEL, IN_COLS), D_MODEL ** -0.5),
        'b_forget': jax.random.uniform(ks[6], (DEPTH, B_HEADS), f32, 1.0, 4.0),
        'g_out_a': 1.0 + nrm(ks[7], (DEPTH, A_WIDTH), 0.01),
        'g_out_b': 1.0 + nrm(ks[8], (DEPTH, B_WIDTH), 0.01),
        'w_out': nrm(ks[9], (DEPTH, MIX_WIDTH, D_MODEL), MIX_WIDTH ** -0.5),
        'g_ffn': 1.0 + nrm(ks[10], (DEPTH, D_MODEL), 0.01),
        'w_group': nrm(ks[11], (DEPTH, D_MODEL, N_GROUPS), D_MODEL ** -0.5),
        'b_group': nrm(ks[12], (DEPTH, N_GROUPS), 0.01),
        'w_router': nrm(ks[13], (DEPTH, N_GROUPS, D_MODEL, EXPERTS_PER_GROUP), D_MODEL ** -0.5),
        'b_router': nrm(ks[14], (DEPTH, N_GROUPS, EXPERTS_PER_GROUP), 0.01),
        'w_gate': nrm(ks[15], (DEPTH, N_EXPERTS, D_MODEL, D_FF_EXPERT), D_MODEL ** -0.5),
        'w_up': nrm(ks[16], (DEPTH, N_EXPERTS, D_MODEL, D_FF_EXPERT), D_MODEL ** -0.5),
        'w_down': nrm(ks[17], (DEPTH, N_EXPERTS, D_FF_EXPERT, D_MODEL), D_FF_EXPERT ** -0.5),
        'g_final': 1.0 + nrm(ks[18], (D_MODEL,), 0.01),
    }


def reference(x, c, w_ada, b_ada, g_mix, w_in, b_forget, g_out_a, g_out_b, w_out,
              g_ffn, w_group, b_group, w_router, b_router, w_gate, w_up, w_down, g_final):
    for l in range(DEPTH):
        mod = (jax.nn.silu(c) @ w_ada[l] + b_ada[l])[:, None, :]
        shift_m, scale_m, gate_m, shift_f, scale_f, gate_f = jnp.split(mod, N_MOD, axis=-1)
        h = rms_norm(x, g_mix[l]) * (1.0 + scale_m) + shift_m
        x = x + gate_m * hybrid_mixer(h, w_in[l], b_forget[l], g_out_a[l], g_out_b[l], w_out[l])
        h = rms_norm(x, g_ffn[l]) * (1.0 + scale_f) + shift_f
        x = x + gate_f * hierarchical_moe(h, w_group[l], b_group[l], w_router[l], b_router[l],
                                          w_gate[l], w_up[l], w_down[l])
    return rms_norm(x, g_final)
```

```cpp
#include <hip/hip_runtime.h>
#include <hip/hip_cooperative_groups.h>
#include <cstdio>
#include <cstdint>
namespace cg = cooperative_groups;

#define LAS __attribute__((address_space(3)))
typedef unsigned short bf16_t;
typedef short bf16x8 __attribute__((ext_vector_type(8)));
typedef float f32x4 __attribute__((ext_vector_type(4)));
typedef float f32x16 __attribute__((ext_vector_type(16)));
typedef unsigned u32x4 __attribute__((ext_vector_type(4)));
typedef unsigned u32x2 __attribute__((ext_vector_type(2)));

constexpr int BATCH = 8, SEQ = 2048, DM = 1024, NTOK = BATCH * SEQ;
constexpr int NMOD = 6 * DM;
constexpr int IN_COLS = 2896, NPROJ = 3072;
constexpr int C_AQ = 0, C_BQ = 512, C_IQ = 1024, C_BK = 1536, C_BV = 2048, C_AK = 2560, C_AV = 2688, C_IK = 2816, C_IW = 2880, C_BF = 2888;
constexpr int NEXP = 32, DFF = 256;
constexpr float EPS = 1e-6f;
constexpr float LOG2E = 1.4426950408889634f;
constexpr float C2 = 0.125f * LOG2E;

constexpr size_t KiB = 1024, MiB = 1024 * 1024;
constexpr size_t WS_CNT = 0;
constexpr size_t WS_MOD = 64 * KiB;
constexpr size_t WS_MOD2 = 256 * KiB;
constexpr size_t WS_IW = 512 * KiB;
constexpr size_t WS_LOGF = 1 * MiB;
constexpr size_t WS_SSQ = 1 * MiB + 512 * KiB;
constexpr size_t WS_X1SSQ = 2 * MiB + 512 * KiB;
constexpr size_t WS_RW = 3 * MiB + 512 * KiB;
constexpr size_t WS_LIST = 4 * MiB;
constexpr size_t WS_WR = 6 * MiB;
constexpr size_t WS_WIN = 8 * MiB;
constexpr size_t WS_WOUT = 14 * MiB;
constexpr size_t WS_WGU = 16 * MiB;
constexpr size_t WS_WD = 48 * MiB;
constexpr size_t WS_PROJ = 64 * MiB;
constexpr size_t WS_Y = 64 * MiB;
constexpr size_t WS_ACT = 128 * MiB;
constexpr size_t WS_H = 160 * MiB;
constexpr size_t WS_O = 192 * MiB;
constexpr size_t WS_MASK = 224 * MiB;
constexpr size_t WS_END = 228 * MiB;

constexpr int LDS_BYTES = 147456;

struct Params {
    const float *x, *c, *w_ada, *b_ada, *g_mix, *w_in, *b_forget, *g_out_a, *g_out_b, *w_out, *g_ffn, *w_group, *b_group, *w_router, *b_router, *w_gate, *w_up, *w_down, *g_final;
    float* out;
    unsigned char* ws;
};

__device__ __forceinline__ unsigned f2bf(float f) { unsigned u = __builtin_bit_cast(unsigned, f); return (u + 0x7fffu + ((u >> 16) & 1u)) >> 16; }
__device__ __forceinline__ unsigned pk2(float lo, float hi) { return f2bf(lo) | (f2bf(hi) << 16); }
__device__ __forceinline__ float bf2f(unsigned short b) { return __builtin_bit_cast(float, (unsigned)b << 16); }
__device__ __forceinline__ float wave_sum(float v) {
#pragma unroll
    for (int o = 1; o < 64; o <<= 1) v += __shfl_xor(v, o);
    return v;
}
__device__ __forceinline__ float siluf(float v) { return v / (1.f + __expf(-v)); }

__device__ __forceinline__ int win_row(int n) {
    if (n < 512) return C_AQ + n;
    if (n < 640) return C_AK + (n - 512);
    if (n < 768) return C_AV + (n - 640);
    if (n < 1280) return C_IQ + (n - 768);
    if (n < 1344) return C_IK + (n - 1280);
    if (n < 1352) return C_IW + (n - 1344);
    if (n < 1864) return C_BQ + (n - 1352);
    if (n < 2376) return C_BK + (n - 1864);
    if (n < 2888) return C_BV + (n - 2376);
    return C_BF + (n - 2888);
}
template <int MAP> __device__ __forceinline__ void transpose_item(const float* W, int K, int N, bf16_t* WT, int k0, int n0, LAS float* scr, int lane, const float* kscale) {
    const int nn = n0 + (lane & 31);
#pragma unroll 8
    for (int i = 0; i < 32; ++i) {
        const int kk = 2 * i + (lane >> 5);
        float v = (nn < N) ? W[(size_t)(k0 + kk) * N + nn] : 0.f;
        if (kscale) v *= kscale[k0 + kk];
        scr[kk * 33 + (lane & 31)] = v;
    }
    asm volatile("s_waitcnt lgkmcnt(0)" ::: "memory");
    const int c = lane & 7;
#pragma unroll
    for (int j = 0; j < 4; ++j) {
        const int nl = (lane >> 3) + 8 * j, n = n0 + nl;
        const LAS float* s = scr + (8 * c) * 33 + nl;
        u32x4 o; o.x = pk2(s[0 * 33], s[1 * 33]); o.y = pk2(s[2 * 33], s[3 * 33]); o.z = pk2(s[4 * 33], s[5 * 33]); o.w = pk2(s[6 * 33], s[7 * 33]);
        int row;
        if (MAP == 0) row = n; else if (MAP == 1) row = win_row(n); else if (MAP == 2) row = (n >> 7) * 256 + (n & 127); else row = (n >> 7) * 256 + 128 + (n & 127);
        if (n < N) *(u32x4*)(WT + (size_t)row * K + k0 + 8 * c) = o;
    }
    asm volatile("s_waitcnt lgkmcnt(0)" ::: "memory");
}

__device__ __forceinline__ void phase0(const Params& p, LAS unsigned char* lds) {
    int tid_ = threadIdx.x; asm volatile("" : "+v"(tid_)); const int tid = tid_, lane = tid & 63, wave = tid >> 6, G = gridDim.x;
    unsigned char* ws = p.ws;
    if (blockIdx.x == 0 && tid < 64) ((unsigned*)(ws + WS_CNT))[tid] = 0u;
    if ((int)blockIdx.x < NMOD / 64) {
        LAS float* sc = (LAS float*)lds;
        LAS float* red = (LAS float*)(lds + 32768);
        for (int i = tid; i < BATCH * DM; i += 512) sc[i] = siluf(p.c[i]);
        __syncthreads();
        const int j0 = 64 * blockIdx.x, col = lane;
        float acc[8];
#pragma unroll
        for (int b = 0; b < 8; ++b) acc[b] = 0.f;
        const float* wp = p.w_ada + (size_t)(wave * 128) * NMOD + j0 + col;
        for (int k4 = 0; k4 < 128; k4 += 4) {
            float w[4];
#pragma unroll
            for (int u = 0; u < 4; ++u) w[u] = wp[(size_t)(k4 + u) * NMOD];
#pragma unroll
            for (int b = 0; b < 8; ++b) {
                const f32x4 s = *(const LAS f32x4*)(sc + b * 1024 + wave * 128 + k4);
                acc[b] += s[0] * w[0] + s[1] * w[1] + s[2] * w[2] + s[3] * w[3];
            }
        }
#pragma unroll
        for (int b = 0; b < 8; ++b) red[(wave * 8 + b) * 64 + col] = acc[b];
        __syncthreads();
        {
            const int b = tid >> 6; float s = 0.f;
#pragma unroll
            for (int w = 0; w < 8; ++w) s += red[(w * 8 + b) * 64 + col];
            ((float*)(ws + WS_MOD))[b * NMOD + j0 + col] = s + p.b_ada[j0 + col];
        }
        __syncthreads();
    }
    {
        bf16_t* wrh = (bf16_t*)(ws + WS_WR); bf16_t* wrl = wrh + 48 * 1024;
        for (int i = blockIdx.x * 512 + tid; i < 48 * 1024; i += G * 512) {
            const int o = i >> 10, k = i & 1023; float v = 0.f;
            if (o < 4) v = p.w_group[k * 4 + o];
            else if (o >= 16) { const int g = (o - 16) >> 3, e = (o - 16) & 7; v = p.w_router[((size_t)g * 1024 + k) * 8 + e]; }
            const unsigned hb = f2bf(v); const float hf = bf2f((unsigned short)hb);
            wrh[i] = (bf16_t)hb; wrl[i] = (bf16_t)f2bf(v - hf);
        }
    }
    {
        u32x4* z = (u32x4*)((bf16_t*)(ws + WS_WIN) + (size_t)IN_COLS * 1024);
        const int n16 = (NPROJ - IN_COLS) * 1024 * 2 / 16;
        for (int i = blockIdx.x * 512 + tid; i < n16; i += G * 512) z[i] = (u32x4){0u, 0u, 0u, 0u};
    }
    {
        LAS float* scr = (LAS float*)(lds + 49152 + wave * 8704);
        const int gw = blockIdx.x * 8 + wave, NGW = G * 8;
        constexpr int NB_IN = (IN_COLS + 31) / 32;
        constexpr int I_IN = 16 * NB_IN, I_OUT = 16 * 32, I_G = 32 * 16 * 8, I_U = I_G, I_D = 32 * 4 * 32;
        constexpr int NITEMS = I_IN + I_OUT + I_G + I_U + I_D;
        for (int it = gw; it < NITEMS; it += NGW) {
            int r = it;
            if (r < I_IN) { const int kb = r / NB_IN, nb = r % NB_IN; transpose_item<1>(p.w_in, 1024, IN_COLS, (bf16_t*)(ws + WS_WIN), 64 * kb, 32 * nb, scr, lane, nullptr); continue; } r -= I_IN;
            if (r < I_OUT) { const int kb = r / 32, nb = r % 32; const int k0 = 64 * kb;
                transpose_item<0>(p.w_out, 1024, 1024, (bf16_t*)(ws + WS_WOUT), k0, 32 * nb, scr, lane, k0 < 512 ? p.g_out_a : p.g_out_b - 512); continue; } r -= I_OUT;
            if (r < I_G) { const int e = r >> 7, q = r & 127, kb = q >> 3, nb = q & 7;
                transpose_item<2>(p.w_gate + (size_t)e * 1024 * 256, 1024, 256, (bf16_t*)(ws + WS_WGU) + (size_t)e * 512 * 1024, 64 * kb, 32 * nb, scr, lane, nullptr); continue; } r -= I_G;
            if (r < I_U) { const int e = r >> 7, q = r & 127, kb = q >> 3, nb = q & 7;
                transpose_item<3>(p.w_up + (size_t)e * 1024 * 256, 1024, 256, (bf16_t*)(ws + WS_WGU) + (size_t)e * 512 * 1024, 64 * kb, 32 * nb, scr, lane, nullptr); continue; } r -= I_U;
            { const int e = r >> 7, q = r & 127, kb = q >> 5, nb = q & 31;
                transpose_item<0>(p.w_down + (size_t)e * 256 * 1024, 256, 1024, (bf16_t*)(ws + WS_WD) + (size_t)e * 1024 * 256, 64 * kb, 32 * nb, scr, lane, nullptr); }
        }
    }
}

__device__ __forceinline__ void phase0b(const Params& p) {
    int tid_ = threadIdx.x; asm volatile("" : "+v"(tid_)); const int tid = tid_, lane = tid & 63, wave = tid >> 6, G = gridDim.x;
    const float* mod = (const float*)(p.ws + WS_MOD);
    float* mod2 = (float*)(p.ws + WS_MOD2);
    for (int i = blockIdx.x * 512 + tid; i < BATCH * DM; i += G * 512) {
        const int b = i >> 10, k = i & 1023;
        mod2[(b * 2 + 0) * 1024 + k] = p.g_ffn[k] * (1.f + mod[b * NMOD + 4 * DM + k]);
        mod2[(b * 2 + 1) * 1024 + k] = mod[b * NMOD + 3 * DM + k];
    }
    bf16_t* H = (bf16_t*)(p.ws + WS_H);
    const int gw = blockIdx.x * 8 + wave, NGW = G * 8;
    for (int m = gw; m < NTOK; m += NGW) {
        const int b = m >> 11;
        const f32x4* xr = (const f32x4*)(p.x + (size_t)m * DM) + lane;
        f32x4 v[4]; float s = 0.f;
#pragma unroll
        for (int j = 0; j < 4; ++j) { v[j] = xr[64 * j]; s += (v[j].x * v[j].x + v[j].y * v[j].y) + (v[j].z * v[j].z + v[j].w * v[j].w); }
        const float rstd = 1.f / sqrtf(wave_sum(s) * (1.f / DM) + EPS);
        unsigned long long* o8 = (unsigned long long*)(H + (size_t)m * DM) + lane;
#pragma unroll
        for (int j = 0; j < 4; ++j) {
            const int k = 4 * lane + 256 * j;
            const f32x4 g = *(const f32x4*)(p.g_mix + k), sh = *(const f32x4*)(mod + b * NMOD + k), sc = *(const f32x4*)(mod + b * NMOD + DM + k);
            const f32x4 h = v[j] * rstd * g * (1.f + sc) + sh;
            o8[64 * j] = (unsigned long long)pk2(h.x, h.y) | ((unsigned long long)pk2(h.z, h.w) << 32);
        }
    }
}

__device__ __forceinline__ void phase_final(const Params& p, bool skeleton) {
    int tid_ = threadIdx.x; asm volatile("" : "+v"(tid_)); const int tid = tid_, lane = tid & 63, wave = tid >> 6, G = gridDim.x;
    const float* mod = (const float*)(p.ws + WS_MOD);
    const bf16_t* Y = (const bf16_t*)(p.ws + WS_Y);
    const int gw = blockIdx.x * 8 + wave, NGW = G * 8;
    for (int m = gw; m < NTOK; m += NGW) {
        const int b = m >> 11;
        const f32x4* xr = (const f32x4*)((skeleton ? p.x : p.out) + (size_t)m * DM) + lane;
        f32x4 v[4]; float s = 0.f;
#pragma unroll
        for (int j = 0; j < 4; ++j) {
            v[j] = xr[64 * j];
            if (!skeleton) {
                const int k = 4 * lane + 256 * j;
                const f32x4 gf = *(const f32x4*)(mod + b * NMOD + 5 * DM + k);
                const u32x2 y0 = *(const u32x2*)(Y + ((size_t)m * 2 + 0) * DM + k), y1 = *(const u32x2*)(Y + ((size_t)m * 2 + 1) * DM + k);
                f32x4 ys;
                ys.x = bf2f((unsigned short)(y0.x & 0xffff)) + bf2f((unsigned short)(y1.x & 0xffff)); ys.y = bf2f((unsigned short)(y0.x >> 16)) + bf2f((unsigned short)(y1.x >> 16));
                ys.z = bf2f((unsigned short)(y0.y & 0xffff)) + bf2f((unsigned short)(y1.y & 0xffff)); ys.w = bf2f((unsigned short)(y0.y >> 16)) + bf2f((unsigned short)(y1.y >> 16));
                v[j] = v[j] + gf * ys;
            }
            s += (v[j].x * v[j].x + v[j].y * v[j].y) + (v[j].z * v[j].z + v[j].w * v[j].w);
        }
        const float rstd = 1.f / sqrtf(wave_sum(s) * (1.f / DM) + EPS);
        f32x4* o = (f32x4*)(p.out + (size_t)m * DM) + lane;
#pragma unroll
        for (int j = 0; j < 4; ++j) { const f32x4 g = *(const f32x4*)(p.g_final + 4 * lane + 256 * j); o[64 * j] = v[j] * rstd * g; }
    }
}

namespace pg8 {
constexpr int BM = 256, BK = 64, HALF = 128, HTB = HALF * BK * 2, STAGE_BYTES = 8 * HTB, NXCD = 8, WGM = 8;
__host__ __device__ __forceinline__ int lds_byte(int r, int c) { const int st = (r >> 4) * 2 + (c >> 5), rr = r & 15, cc = c & 31, ob = rr * 64 + cc * 2; return st * 1024 + (ob ^ (((ob >> 9) & 1) << 5)); }
__host__ __device__ __forceinline__ void stage_rc(int b, int& R, int& C) { const int st = b / 1024, sb = b % 1024, swz = sb ^ (((sb >> 9) & 1) << 5); R = (st >> 1) * 16 + swz / 64; C = (st & 1) * 32 + (swz % 64) / 2; }
__host__ __device__ __forceinline__ int perm32(int rho) { const int n = rho >> 4, i = rho & 15; return 8 * (i >> 2) + 4 * n + (i & 3); }

struct Unit { int pm, pn; size_t aoff, boff; int e, r0, cnt; };
struct Gemm { const bf16_t* A; const bf16_t* Bt; int K; };

struct StaticOrder {
    int nM, nN, nwg, G, c; size_t tstep;
    __device__ void init(int M, int N, int K, int G_, int c_) { nM = M / BM; nN = N / BM; nwg = nM * nN; G = G_; c = c_; tstep = (size_t)BM * K * 2; }
    __device__ bool next(int i, Unit& u) const {
        const long L = (long)i * G + c; if (L >= nwg) return false;
        int wgid = (int)L; { const int q = nwg / NXCD, r = nwg % NXCD, xcd = wgid % NXCD, off = wgid / NXCD; wgid = (xcd < r ? xcd * (q + 1) : r * (q + 1) + (xcd - r) * q) + off; }
        const int nig = WGM * nN, gid = wgid / nig, fm = gid * WGM, gsz = (nM - fm) < WGM ? (nM - fm) : WGM;
        u.pm = fm + ((wgid % nig) % gsz); u.pn = (wgid % nig) / gsz; u.aoff = (size_t)u.pm * tstep; u.boff = (size_t)u.pn * tstep; u.e = 0; u.r0 = 0; u.cnt = 0; return true;
    }
    __device__ __forceinline__ unsigned arow(const Unit&, int R) const { return 0u; }
};

__device__ __forceinline__ unsigned cvt_pk_bf16(float lo, float hi) { unsigned r; asm volatile("v_cvt_pk_bf16_f32 %0, %1, %2" : "=v"(r) : "v"(lo), "v"(hi)); return r; }

template <class Epi, class Sched, bool GATHER>
__device__ __forceinline__ void gemm_phase(LAS unsigned char* lds, const Gemm g, const Sched& S, const Epi& E) {
    int tid_ = threadIdx.x; asm volatile("" : "+v"(tid_)); const int tid = tid_, wid = __builtin_amdgcn_readfirstlane(tid >> 6), lane = tid & 63, wr = wid >> 2, wc = wid & 3, fr = lane & 15, fq = lane >> 4;
    const int K = g.K, nt = K / BK;
    int Rst[2], Cst[2]; unsigned voffB[2], cOA[2][2], nOA[2][2];
    const size_t kstep = (size_t)(BK * 2);
    const size_t hstep = (size_t)HALF * K * 2;
#pragma unroll
    for (int i = 0; i < 2; ++i) { int R, C; stage_rc(tid * 16 + i * 8192, R, C); Rst[i] = R; Cst[i] = C; const int Rb = Epi::PERM ? ((R & ~31) + perm32(R & 31)) : R; voffB[i] = (unsigned)(Rb * K + C) * 2u; }
    const unsigned ldsw = (unsigned)wid * 1024u;
    const int aoff = lds_byte(wr * 64 + fr, fq * 8), boff = lds_byte(wc * 32 + fr, fq * 8);
#define PG8_SA(b, h) (((b) * 2 + (h)) * HTB)
#define PG8_SB(b, h) ((4 + (b) * 2 + (h)) * HTB)
#define PG8_STAGE_B(bufoff, gbase) do { _Pragma("unroll") for (int _i = 0; _i < 2; ++_i) \
        __builtin_amdgcn_global_load_lds((const unsigned*)((const char*)(gbase) + voffB[_i]), (LAS unsigned*)(lds + (bufoff) + ldsw + _i * 8192), 16, 0, 0); } while (0)
#define PG8_STAGE_A(bufoff, gbase, o0, o1) do { \
        __builtin_amdgcn_global_load_lds((const unsigned*)((const char*)(gbase) + (o0)), (LAS unsigned*)(lds + (bufoff) + ldsw), 16, 0, 0); \
        __builtin_amdgcn_global_load_lds((const unsigned*)((const char*)(gbase) + (o1)), (LAS unsigned*)(lds + (bufoff) + ldsw + 8192), 16, 0, 0); } while (0)
#define PG8_LDA(dst, b, h) do { _Pragma("unroll") for (int m = 0; m < 4; ++m) _Pragma("unroll") for (int k = 0; k < 2; ++k) dst[m][k] = *(const LAS bf16x8*)(lds + PG8_SA(b, h) + aoff + m * 2048 + k * 1024); } while (0)
#define PG8_LDB(dst, b, h) do { _Pragma("unroll") for (int n = 0; n < 2; ++n) _Pragma("unroll") for (int k = 0; k < 2; ++k) dst[n][k] = *(const LAS bf16x8*)(lds + PG8_SB(b, h) + boff + n * 2048 + k * 1024); } while (0)
#define PG8_MMA(ai, bj, At, Bt) do { __builtin_amdgcn_s_setprio(1); _Pragma("unroll") for (int m = 0; m < 4; ++m) _Pragma("unroll") for (int n = 0; n < 2; ++n) _Pragma("unroll") for (int k = 0; k < 2; ++k) \
        acc[ai][bj][m][n] = __builtin_amdgcn_mfma_f32_16x16x32_bf16(Bt[n][k], At[m][k], acc[ai][bj][m][n], 0, 0, 0); __builtin_amdgcn_s_setprio(0); } while (0)
#define PG8_WAIT_V(n) asm volatile("s_waitcnt vmcnt(" #n ")" ::: "memory")
#define PG8_WAIT_L(n) asm volatile("s_waitcnt lgkmcnt(" #n ")" ::: "memory")
#define PG8_BAR __builtin_amdgcn_s_barrier()
#define PG8_SCHED __builtin_amdgcn_sched_barrier(0)
#define PG8_SETOFF(dst, u) do { _Pragma("unroll") for (int _h = 0; _h < 2; ++_h) _Pragma("unroll") for (int _i = 0; _i < 2; ++_i) { \
        if (GATHER) dst[_h][_i] = S.arow(u, Rst[_i] + HALF * _h) * (unsigned)(K * 2) + (unsigned)(Cst[_i] * 2); \
        else dst[_h][_i] = (unsigned)((Rst[_i] + HALF * _h) * K + Cst[_i]) * 2u; } } while (0)
    Unit cur, nxt; int ui = 0;
    if (!S.next(0, cur)) return;
    f32x4 acc[2][2][4][2];
#pragma unroll
    for (int a = 0; a < 2; ++a)
#pragma unroll
        for (int b = 0; b < 2; ++b)
#pragma unroll
            for (int m = 0; m < 4; ++m)
#pragma unroll
                for (int n = 0; n < 2; ++n) acc[a][b][m][n] = (f32x4){0.f, 0.f, 0.f, 0.f};
    bf16x8 At[4][2], B0[2][2], B1[2][2];
    const char* cA = (const char*)g.A + cur.aoff; const char* cB = (const char*)g.Bt + cur.boff;
    PG8_SETOFF(cOA, cur);
    PG8_STAGE_B(PG8_SB(0, 0), cB); PG8_STAGE_B(PG8_SB(0, 1), cB + hstep); PG8_STAGE_A(PG8_SA(0, 0), cA, cOA[0][0], cOA[0][1]); PG8_STAGE_A(PG8_SA(0, 1), cA, cOA[1][0], cOA[1][1]);
    if (wr == 1) PG8_BAR;
    PG8_WAIT_V(2); PG8_BAR;
    PG8_STAGE_B(PG8_SB(1, 0), cB + kstep); PG8_STAGE_A(PG8_SA(1, 0), cA + kstep, cOA[0][0], cOA[0][1]); PG8_STAGE_B(PG8_SB(1, 1), cB + hstep + kstep);
    PG8_WAIT_V(6); PG8_BAR;
    for (;;) {
        const bool has_next = S.next(ui + 1, nxt);
        const char* nA = has_next ? (const char*)g.A + nxt.aoff : cA; const char* nB = has_next ? (const char*)g.Bt + nxt.boff : cB;
        if (has_next) { PG8_SETOFF(nOA, nxt); } else {
#pragma unroll
            for (int _h = 0; _h < 2; ++_h)
#pragma unroll
                for (int _i = 0; _i < 2; ++_i) nOA[_h][_i] = cOA[_h][_i]; }
        for (int t = 0; t < nt; t += 2) {
            const bool last = (t == nt - 2);
            if constexpr (Epi::MID) { if (t == nt / 2) E.mid(acc, cur, wr, fr); }
            const char* a1 = cA + (size_t)(t + 1) * kstep;
            const char* a2 = last ? nA : cA + (size_t)(t + 2) * kstep; const char* b2 = last ? nB : cB + (size_t)(t + 2) * kstep;
            const char* a3 = a2 + kstep; const char* b3 = b2 + kstep;
            const unsigned x00 = last ? nOA[0][0] : cOA[0][0], x01 = last ? nOA[0][1] : cOA[0][1], x10 = last ? nOA[1][0] : cOA[1][0], x11 = last ? nOA[1][1] : cOA[1][1];
            PG8_LDB(B0, 0, 0); PG8_LDB(B1, 0, 1); PG8_SCHED; PG8_LDA(At, 0, 0); PG8_STAGE_A(PG8_SA(1, 1), a1, cOA[1][0], cOA[1][1]);
            PG8_WAIT_V(8); PG8_WAIT_L(0); PG8_BAR; PG8_MMA(0, 0, At, B0); PG8_MMA(0, 1, At, B1); PG8_BAR; PG8_SCHED;
            PG8_LDA(At, 0, 1); PG8_STAGE_B(PG8_SB(0, 0), b2); PG8_STAGE_B(PG8_SB(0, 1), b2 + hstep); PG8_STAGE_A(PG8_SA(0, 0), a2, x00, x01);
            PG8_WAIT_V(8); PG8_WAIT_L(0); PG8_BAR; PG8_MMA(1, 0, At, B0); PG8_MMA(1, 1, At, B1); PG8_BAR; PG8_SCHED;
            PG8_LDB(B0, 1, 0); PG8_LDB(B1, 1, 1); PG8_SCHED; PG8_LDA(At, 1, 0); PG8_STAGE_A(PG8_SA(0, 1), a2, x10, x11);
            PG8_WAIT_V(8); PG8_WAIT_L(0); PG8_BAR; PG8_MMA(0, 0, At, B0); PG8_MMA(0, 1, At, B1); PG8_BAR; PG8_SCHED;
            PG8_LDA(At, 1, 1); PG8_STAGE_B(PG8_SB(1, 0), b3); PG8_STAGE_B(PG8_SB(1, 1), b3 + hstep); PG8_STAGE_A(PG8_SA(1, 0), a3, x00, x01);
            PG8_WAIT_V(8); PG8_WAIT_L(0); PG8_BAR; PG8_MMA(1, 0, At, B0); PG8_MMA(1, 1, At, B1); PG8_BAR; PG8_SCHED;
        }
        if (wr == 0) PG8_BAR;
        E(acc, cur, wr, wc, fr, fq);
        if (!has_next) break;
#pragma unroll
        for (int a = 0; a < 2; ++a)
#pragma unroll
            for (int b = 0; b < 2; ++b)
#pragma unroll
                for (int m = 0; m < 4; ++m)
#pragma unroll
                    for (int n = 0; n < 2; ++n) acc[a][b][m][n] = (f32x4){0.f, 0.f, 0.f, 0.f};
        cur = nxt; cA = nA; cB = nB; ++ui;
#pragma unroll
        for (int _h = 0; _h < 2; ++_h)
#pragma unroll
            for (int _i = 0; _i < 2; ++_i) cOA[_h][_i] = nOA[_h][_i];
        if (wr == 1) PG8_BAR;
    }
    PG8_WAIT_V(0);
    PG8_BAR;
#undef PG8_SA
#undef PG8_SB
#undef PG8_STAGE_A
#undef PG8_STAGE_B
#undef PG8_LDA
#undef PG8_LDB
#undef PG8_MMA
#undef PG8_WAIT_V
#undef PG8_WAIT_L
#undef PG8_BAR
#undef PG8_SCHED
#undef PG8_SETOFF
}
}
typedef float f32x2 __attribute__((ext_vector_type(2)));
using pg8::cvt_pk_bf16;

struct EpiProj {
    static constexpr bool PERM = true, MID = false;
    bf16_t* O; float* iw; float* logf; const float* b_forget;
    __device__ __forceinline__ void operator()(const f32x4 (&acc)[2][2][4][2], const pg8::Unit& u, int wr, int wc, int fr_, int fq_) const {
        int fr = fr_, fq = fq_; asm volatile("" : "+v"(fr), "+v"(fq));
        const int row0 = u.pm * 256 + wr * 64 + fr, col0 = u.pn * 256 + wc * 32 + 8 * fq;
        const float sc = (u.pn < 4) ? C2 : 1.f;
#pragma unroll
        for (int ai = 0; ai < 2; ++ai)
#pragma unroll
            for (int m = 0; m < 4; ++m) {
                const int row = row0 + ai * 128 + m * 16;
                bf16_t* rowp = O + (size_t)row * NPROJ + col0;
#pragma unroll
                for (int bj = 0; bj < 2; ++bj) {
                    const f32x4 v0 = acc[ai][bj][m][0] * sc, v1 = acc[ai][bj][m][1] * sc;
                    u32x4 w; w.x = cvt_pk_bf16(v0[0], v0[1]); w.y = cvt_pk_bf16(v0[2], v0[3]); w.z = cvt_pk_bf16(v1[0], v1[1]); w.w = cvt_pk_bf16(v1[2], v1[3]);
                    *(u32x4*)(rowp + bj * 128) = w;
                }
                if (u.pn == 11 && wc == 2 && fq < 2) {
                    const f32x4 v0 = acc[ai][0][m][0], v1 = acc[ai][0][m][1];
                    if (fq == 0) { *(f32x4*)(iw + (size_t)row * 8) = v0; *(f32x4*)(iw + (size_t)row * 8 + 4) = v1; }
                    else {
                        f32x4 o0, o1;
#pragma unroll
                        for (int i = 0; i < 4; ++i) {
                            const float z0 = v0[i] + b_forget[i], z1 = v1[i] + b_forget[4 + i];
                            o0[i] = fminf(z0, 0.f) - log1pf(__expf(-fabsf(z0))); o1[i] = fminf(z1, 0.f) - log1pf(__expf(-fabsf(z1)));
                        }
                        *(f32x4*)(logf + (size_t)row * 8) = o0; *(f32x4*)(logf + (size_t)row * 8 + 4) = o1;
                    }
                }
            }
    }
};

struct EpiOut {
    static constexpr bool PERM = false, MID = true;
    const float* x; float* x1; const float* mod; const float* ssq; float* x1ssq;
    __device__ __forceinline__ void rowscale(int row, float& ra, float& rb) const {
        const f32x4* s = (const f32x4*)(ssq + (size_t)row * 16);
        const f32x4 a0 = s[0], a1 = s[1], b0 = s[2], b1 = s[3];
        const float sa = (a0[0] + a0[1]) + (a0[2] + a0[3]) + (a1[0] + a1[1]) + (a1[2] + a1[3]);
        const float sb = (b0[0] + b0[1]) + (b0[2] + b0[3]) + (b1[0] + b1[1]) + (b1[2] + b1[3]);
        ra = 1.f / sqrtf(sa * (1.f / 512.f) + EPS); rb = 1.f / sqrtf(sb * (1.f / 512.f) + EPS);
    }
    __device__ __forceinline__ void mid(f32x4 (&acc)[2][2][4][2], const pg8::Unit& u, int wr, int fr_) const {
        int fr = fr_; asm volatile("" : "+v"(fr));
#pragma unroll
        for (int ai = 0; ai < 2; ++ai)
#pragma unroll
            for (int m = 0; m < 4; ++m) {
                float ra, rb; rowscale(u.pm * 256 + ai * 128 + wr * 64 + m * 16 + fr, ra, rb);
                const float f = ra / rb;
#pragma unroll
                for (int bj = 0; bj < 2; ++bj)
#pragma unroll
                    for (int n = 0; n < 2; ++n) acc[ai][bj][m][n] = acc[ai][bj][m][n] * f;
            }
    }
    __device__ __forceinline__ void operator()(const f32x4 (&acc)[2][2][4][2], const pg8::Unit& u, int wr, int wc, int fr_, int fq_) const {
        int fr = fr_, fq = fq_; asm volatile("" : "+v"(fr), "+v"(fq));
        const int col0 = u.pn * 256 + wc * 32 + 4 * fq;
#pragma unroll
        for (int ai = 0; ai < 2; ++ai)
#pragma unroll
            for (int m = 0; m < 4; ++m) {
                const int row = u.pm * 256 + ai * 128 + wr * 64 + m * 16 + fr, b = row >> 11;
                float ra, rb; rowscale(row, ra, rb);
                float q = 0.f;
#pragma unroll
                for (int bj = 0; bj < 2; ++bj)
#pragma unroll
                    for (int n = 0; n < 2; ++n) {
                        const int col = col0 + bj * 128 + n * 16;
                        const f32x4 xv = *(const f32x4*)(x + (size_t)row * DM + col), gm = *(const f32x4*)(mod + b * NMOD + 2 * DM + col);
                        const f32x4 o = xv + gm * (acc[ai][bj][m][n] * rb);
                        *(f32x4*)(x1 + (size_t)row * DM + col) = o;
                        q += (o[0] * o[0] + o[1] * o[1]) + (o[2] * o[2] + o[3] * o[3]);
                    }
                q += __shfl_xor(q, 16); q += __shfl_xor(q, 32);
                if (fq == 0) x1ssq[(size_t)row * 16 + u.pn * 4 + wc] = q;
            }
    }
};

struct EpiAct {
    static constexpr bool PERM = true, MID = false;
    bf16_t* act; const int* list; const float* rw;
    __device__ __forceinline__ void operator()(const f32x4 (&acc)[2][2][4][2], const pg8::Unit& u, int wr, int wc, int fr_, int fq_) const {
        int fr = fr_, fq = fq_; asm volatile("" : "+v"(fr), "+v"(fq));
        const int col0 = u.pn * 128 + wc * 32 + 8 * fq;
#pragma unroll
        for (int ai = 0; ai < 2; ++ai)
#pragma unroll
            for (int m = 0; m < 4; ++m) {
                const int rl = ai * 128 + wr * 64 + m * 16 + fr;
                float w = 0.f;
                if (u.r0 + rl < u.cnt) w = rw[list[u.e * 16384 + u.r0 + rl]];
                f32x4 o[2];
#pragma unroll
                for (int n = 0; n < 2; ++n)
#pragma unroll
                    for (int i = 0; i < 4; ++i) { const float gv = acc[ai][0][m][n][i], uv = acc[ai][1][m][n][i]; o[n][i] = gv / (1.f + __expf(-gv)) * uv * w; }
                u32x4 pk; pk.x = cvt_pk_bf16(o[0][0], o[0][1]); pk.y = cvt_pk_bf16(o[0][2], o[0][3]); pk.z = cvt_pk_bf16(o[1][0], o[1][1]); pk.w = cvt_pk_bf16(o[1][2], o[1][3]);
                *(u32x4*)(act + ((size_t)u.pm * 256 + rl) * 256 + col0) = pk;
            }
    }
};

struct EpiDown {
    static constexpr bool PERM = true, MID = false;
    bf16_t* y; const int* list;
    __device__ __forceinline__ void operator()(const f32x4 (&acc)[2][2][4][2], const pg8::Unit& u, int wr, int wc, int fr_, int fq_) const {
        int fr = fr_, fq = fq_; asm volatile("" : "+v"(fr), "+v"(fq));
        const int col0 = u.pn * 256 + wc * 32 + 8 * fq;
#pragma unroll
        for (int ai = 0; ai < 2; ++ai)
#pragma unroll
            for (int m = 0; m < 4; ++m) {
                const int rl = ai * 128 + wr * 64 + m * 16 + fr;
                if (u.r0 + rl < u.cnt) {
                    const int slot = list[u.e * 16384 + u.r0 + rl];
#pragma unroll
                    for (int bj = 0; bj < 2; ++bj) {
                        const f32x4 v0 = acc[ai][bj][m][0], v1 = acc[ai][bj][m][1];
                        u32x4 pk; pk.x = cvt_pk_bf16(v0[0], v0[1]); pk.y = cvt_pk_bf16(v0[2], v0[3]); pk.z = cvt_pk_bf16(v1[0], v1[1]); pk.w = cvt_pk_bf16(v1[2], v1[3]);
                        *(u32x4*)(y + (size_t)slot * DM + col0 + bj * 128) = pk;
                    }
                }
            }
    }
};

struct MoeOrder {
    const int* cnt; const int* list; int NN, G, c; size_t a_tile, b_exp, b_tile; bool gather;
    __device__ bool next(int i, pg8::Unit& u) const {
        const int L = i * G + c, tau = L / NN, pn = L - tau * NN;
        int base = 0, e = 0, ce = 0;
        for (; e < NEXP; ++e) { ce = cnt[e]; const int nt_ = (ce + 255) >> 8; if (tau < base + nt_) break; base += nt_; }
        if (e >= NEXP) return false;
        u.pm = tau; u.pn = pn; u.e = e; u.r0 = (tau - base) * 256; u.cnt = ce;
        u.aoff = gather ? 0 : (size_t)tau * a_tile; u.boff = (size_t)e * b_exp + (size_t)pn * b_tile; return true;
    }
    __device__ __forceinline__ unsigned arow(const pg8::Unit& u, int R) const {
        int r = u.r0 + R; if (r >= u.cnt) r = u.cnt - 1;
        return (unsigned)(list[u.e * 16384 + r] >> 1);
    }
};
constexpr int AT_K = 0, AT_V = 16384, AT_CUM = 32768, AT_WSF = 40960, AT_OST = 43008, AT_END = 43008 + 32768;
__device__ __forceinline__ int crow(int r, int hi) { return (r & 3) + 8 * (r >> 2) + 4 * hi; }
typedef short v4i16_t __attribute__((ext_vector_type(4)));
__device__ __forceinline__ v4i16_t vtr(const LAS unsigned char* p) { return __builtin_amdgcn_ds_read_tr16_b64_v4i16((LAS v4i16_t*)p); }

template <int MODE>
__device__ __forceinline__ void attn_unit(const Params& p, int b, int h, int qb, LAS unsigned char* lds) {
    int tid_ = threadIdx.x; asm volatile("" : "+v"(tid_)); const int tid = tid_, lane = tid & 63, r32 = lane & 31, hi = lane >> 5, wid = __builtin_amdgcn_readfirstlane(tid >> 6);
    const bf16_t* proj = (const bf16_t*)(p.ws + WS_PROJ);
    const int rowbase = b * SEQ, q0 = qb * 256;
    const int qcol = (MODE == 0 ? C_BQ : C_AQ) + h * 64;
    const int kcol = (MODE == 0 ? C_BK + h * 64 : C_AK + (h >> 2) * 64);
    const int vcol = (MODE == 0 ? C_BV + h * 64 : C_AV + (h >> 2) * 64);
    const int NT = (q0 + 256) / 64;
    LAS float* cumk = (LAS float*)(lds + AT_CUM);
    LAS float* wsf = (LAS float*)(lds + AT_WSF) + wid * 64;
    if (MODE == 0) {
        const float* lf = (const float*)(p.ws + WS_LOGF);
        const int NK = q0 + 256;
        float v[4]; float run = 0.f;
#pragma unroll
        for (int i = 0; i < 4; ++i) { const int s = 4 * tid + i; const float x = (s < NK) ? lf[(size_t)(rowbase + s) * 8 + h] : 0.f; run += x; v[i] = run; }
        float inc = run;
#pragma unroll
        for (int o = 1; o < 64; o <<= 1) { const float t = __shfl_up(inc, o); if (lane >= o) inc += t; }
        LAS float* wt = (LAS float*)(lds + AT_WSF);
        if (lane == 63) wt[wid] = inc;
        __syncthreads();
        float pre = inc - run;
        for (int w = 0; w < wid; ++w) pre += wt[w];
#pragma unroll
        for (int i = 0; i < 4; ++i) cumk[4 * tid + i] = -(pre + v[i]) * LOG2E;
        __syncthreads();
    }
    const float slope2 = (MODE == 1) ? exp2f(-(float)(h + 1)) * LOG2E : 0.f;
    const bf16_t* ksrc = proj + (size_t)(rowbase + lane) * NPROJ + kcol + wid * 8;
    const bf16_t* vsrc = proj + (size_t)(rowbase + 16 * (wid & 3) + (lane >> 2)) * NPROJ + vcol + (wid >> 2) * 32 + (lane & 3) * 8;
    const int stoff = wid * 1024 + lane * 16;
    u32x4 kreg = *(const u32x4*)ksrc, vreg = *(const u32x4*)vsrc;
    const int qrow = q0 + wid * 32 + r32;
    bf16x8 qr[4];
    {
        const bf16_t* qp = proj + (size_t)(rowbase + qrow) * NPROJ + qcol + hi * 8;
#pragma unroll
        for (int d0 = 0; d0 < 4; ++d0) qr[d0] = *(const bf16x8*)(qp + d0 * 16);
    }
    const unsigned* mrow = (const unsigned*)(p.ws + WS_MASK) + (size_t)(rowbase + qrow) * 64;
    *(LAS u32x4*)(lds + AT_K + stoff) = kreg; *(LAS u32x4*)(lds + AT_V + stoff) = vreg;
    __syncthreads();
    float m_run = -1e30f, l_run = 0.f;
    f32x16 o[2]; o[0] = f32x16{}; o[1] = f32x16{};
    const int wq_lo = q0 + wid * 32;
    for (int t = 0; t < NT; ++t) {
        const int cur = t & 1;
        if (t + 1 < NT) { kreg = *(const u32x4*)(ksrc + (size_t)(t + 1) * 64 * NPROJ); vreg = *(const u32x4*)(vsrc + (size_t)(t + 1) * 64 * NPROJ); }
        const int kv0 = 64 * t;
        if (kv0 <= wq_lo + 31) {
            u32x2 mw = (u32x2){0u, 0u};
            if (MODE == 1) mw = *(const u32x2*)(mrow + 2 * t);
            const LAS unsigned char* kb = lds + AT_K + cur * 8192 + hi * 1024 + r32 * 16;
            f32x16 p0 = f32x16{}, p1 = f32x16{};
#pragma unroll
            for (int d0 = 0; d0 < 4; ++d0) {
                const bf16x8 b0 = *(const LAS bf16x8*)(kb + d0 * 2048), b1 = *(const LAS bf16x8*)(kb + d0 * 2048 + 512);
                p0 = __builtin_amdgcn_mfma_f32_32x32x16_bf16(b0, qr[d0], p0, 0, 0, 0);
                p1 = __builtin_amdgcn_mfma_f32_32x32x16_bf16(b1, qr[d0], p1, 0, 0, 0);
            }
            if (MODE == 0) {
#pragma unroll
                for (int g4 = 0; g4 < 4; ++g4) {
                    const f32x4 c0 = *(const LAS f32x4*)(cumk + kv0 + 8 * g4 + 4 * hi), c1 = *(const LAS f32x4*)(cumk + kv0 + 32 + 8 * g4 + 4 * hi);
#pragma unroll
                    for (int i = 0; i < 4; ++i) { p0[4 * g4 + i] += c0[i]; p1[4 * g4 + i] += c1[i]; }
                }
                if (kv0 + 63 > wq_lo) {
#pragma unroll
                    for (int r = 0; r < 16; ++r) { const int kv = kv0 + crow(r, hi); if (kv > qrow) p0[r] = -INFINITY; if (kv + 32 > qrow) p1[r] = -INFINITY; }
                }
            } else {
#pragma unroll
                for (int r = 0; r < 16; ++r) {
                    const int cr = crow(r, hi);
                    p0[r] = ((mw.x >> cr) & 1u) ? p0[r] + slope2 * (float)(kv0 + cr) : -INFINITY;
                    p1[r] = ((mw.y >> cr) & 1u) ? p1[r] + slope2 * (float)(kv0 + 32 + cr) : -INFINITY;
                }
            }
            float rm = fmaxf(p0[0], p1[0]);
#pragma unroll
            for (int r = 1; r < 16; ++r) rm = fmaxf(rm, fmaxf(p0[r], p1[r]));
            rm = fmaxf(rm, __shfl_xor(rm, 32));
            const float m_new = fmaxf(m_run, rm);
            const float f = exp2f(m_run - m_new);
            m_run = m_new;
            float ls = 0.f;
#pragma unroll
            for (int r = 0; r < 16; ++r) { p0[r] = __builtin_amdgcn_exp2f(p0[r] - m_new); p1[r] = __builtin_amdgcn_exp2f(p1[r] - m_new); ls += p0[r] + p1[r]; }
            l_run = l_run * f + ls;
            if (__any(f != 1.f)) {
                if (hi == 0) wsf[r32] = f;
#pragma unroll
                for (int g4 = 0; g4 < 4; ++g4) {
                    const f32x4 fv = *(const LAS f32x4*)(wsf + 8 * g4 + 4 * hi);
#pragma unroll
                    for (int i = 0; i < 4; ++i) { o[0][4 * g4 + i] *= fv[i]; o[1][4 * g4 + i] *= fv[i]; }
                }
            }
            bf16x8 pa[4];
#pragma unroll
            for (int s = 0; s < 4; ++s) {
                u32x4 w;
                if (s < 2) { w.x = pg8::cvt_pk_bf16(p0[8 * s + 0], p0[8 * s + 1]); w.y = pg8::cvt_pk_bf16(p0[8 * s + 2], p0[8 * s + 3]); w.z = pg8::cvt_pk_bf16(p0[8 * s + 4], p0[8 * s + 5]); w.w = pg8::cvt_pk_bf16(p0[8 * s + 6], p0[8 * s + 7]); }
                else { const int q = s - 2; w.x = pg8::cvt_pk_bf16(p1[8 * q + 0], p1[8 * q + 1]); w.y = pg8::cvt_pk_bf16(p1[8 * q + 2], p1[8 * q + 3]); w.z = pg8::cvt_pk_bf16(p1[8 * q + 4], p1[8 * q + 5]); w.w = pg8::cvt_pk_bf16(p1[8 * q + 6], p1[8 * q + 7]); }
                pa[s] = __builtin_bit_cast(bf16x8, w);
            }
            const LAS unsigned char* vp = lds + AT_V + cur * 8192 + ((lane >> 4) & 1) * 32 + (lane & 3) * 8 + (4 * hi + ((lane & 15) >> 2)) * 64;
#pragma unroll
            for (int d0 = 0; d0 < 2; ++d0)
#pragma unroll
                for (int ks = 0; ks < 4; ++ks) {
                    const v4i16_t lo = vtr(vp + d0 * 4096 + ks * 1024), hh = vtr(vp + d0 * 4096 + ks * 1024 + 512);
                    const bf16x8 vf = (bf16x8){lo[0], lo[1], lo[2], lo[3], hh[0], hh[1], hh[2], hh[3]};
                    o[d0] = __builtin_amdgcn_mfma_f32_32x32x16_bf16(pa[ks], vf, o[d0], 0, 0, 0);
                }
        }
        if (t + 1 < NT) { *(LAS u32x4*)(lds + AT_K + (cur ^ 1) * 8192 + stoff) = kreg; *(LAS u32x4*)(lds + AT_V + (cur ^ 1) * 8192 + stoff) = vreg; }
        __syncthreads();
    }
    l_run += __shfl_xor(l_run, 32);
    if (hi == 0) wsf[32 + r32] = l_run;
    float rli[16];
#pragma unroll
    for (int g4 = 0; g4 < 4; ++g4) {
        const f32x4 lv = *(const LAS f32x4*)(wsf + 32 + 8 * g4 + 4 * hi);
#pragma unroll
        for (int i = 0; i < 4; ++i) rli[4 * g4 + i] = 1.f / lv[i];
    }
    LAS bf16_t* stg = (LAS bf16_t*)(lds + AT_OST) + wid * 2048;
#pragma unroll
    for (int r = 0; r < 16; ++r) {
        const int orow = crow(r, hi);
#pragma unroll
        for (int d0 = 0; d0 < 2; ++d0) stg[orow * 64 + d0 * 32 + r32] = (bf16_t)f2bf(o[d0][r] * rli[r]);
    }
    bf16_t* O = (bf16_t*)(p.ws + WS_O);
    float* ssq = (float*)(p.ws + WS_SSQ);
    const int ocol = (MODE == 1 ? 0 : 512) + h * 64, slot = (MODE == 1 ? 0 : 8) + h;
#pragma unroll
    for (int i = 0; i < 4; ++i) {
        const int row = i * 8 + (lane >> 3), ch = lane & 7;
        const u32x4 v = *(const LAS u32x4*)(stg + row * 64 + ch * 8);
        const size_t grow = (size_t)(rowbase + q0 + wid * 32 + row);
        *(u32x4*)(O + grow * DM + ocol + ch * 8) = v;
        float q = 0.f;
#pragma unroll
        for (int j = 0; j < 4; ++j) { const float a = bf2f((unsigned short)(v[j] & 0xffff)), c = bf2f((unsigned short)(v[j] >> 16)); q += a * a + c * c; }
        q += __shfl_xor(q, 1); q += __shfl_xor(q, 2); q += __shfl_xor(q, 4);
        if (ch == 0) ssq[grow * 16 + slot] = q;
    }
    __syncthreads();
}
constexpr int IX_SC = 0, IX_HIST = 65536, IX_CAND = 98304, IX_END = 98304 + 2048;
__device__ __forceinline__ float wave_maxf(float v) {
#pragma unroll
    for (int o = 1; o < 64; o <<= 1) v = fmaxf(v, __shfl_xor(v, o));
    return v;
}
__device__ __forceinline__ float wave_minf(float v) {
#pragma unroll
    for (int o = 1; o < 64; o <<= 1) v = fminf(v, __shfl_xor(v, o));
    return v;
}
__device__ __forceinline__ void indexer_unit(const Params& p, int b, int t0, LAS unsigned char* lds) {
    int tid_ = threadIdx.x; asm volatile("" : "+v"(tid_)); const int tid = tid_, lane = tid & 63, r32 = lane & 31, hi = lane >> 5, wid = __builtin_amdgcn_readfirstlane(tid >> 6);
    const bf16_t* proj = (const bf16_t*)(p.ws + WS_PROJ);
    const float* iwp = (const float*)(p.ws + WS_IW);
    const int rowbase = b * SEQ;
    LAS float* sc = (LAS float*)(lds + IX_SC);
    bf16x8 aq[2][4]; float wq[2][2][8];
    {
        const int i = r32, qi = 2 * ((i >> 2) & 1) + (i >> 4), head = 4 * ((i >> 3) & 1) + (i & 3);
#pragma unroll
        for (int g = 0; g < 2; ++g) {
            const bf16_t* ap = proj + (size_t)(rowbase + t0 + 4 * g + qi) * NPROJ + C_IQ + head * 64 + hi * 8;
#pragma unroll
            for (int d0 = 0; d0 < 4; ++d0) aq[g][d0] = *(const bf16x8*)(ap + d0 * 16);
#pragma unroll
            for (int a = 0; a < 2; ++a) {
                const float* wp = iwp + (size_t)(rowbase + t0 + 4 * g + 2 * hi + a) * 8;
                const f32x4 w0 = *(const f32x4*)wp, w1 = *(const f32x4*)(wp + 4);
#pragma unroll
                for (int j = 0; j < 4; ++j) { wq[g][a][j] = w0[j]; wq[g][a][4 + j] = w1[j]; }
            }
        }
    }
    const int NTI = (t0 + 7) / 32 + 1;
    for (int j = wid; j < NTI; j += 8) {
        const int key = 32 * j + r32;
        const bf16_t* kp = proj + (size_t)(rowbase + key) * NPROJ + C_IK + hi * 8;
        bf16x8 kf[4];
#pragma unroll
        for (int d0 = 0; d0 < 4; ++d0) kf[d0] = *(const bf16x8*)(kp + d0 * 16);
#pragma unroll
        for (int g = 0; g < 2; ++g) {
            f32x16 d = f32x16{};
#pragma unroll
            for (int d0 = 0; d0 < 4; ++d0) d = __builtin_amdgcn_mfma_f32_32x32x16_bf16(aq[g][d0], kf[d0], d, 0, 0, 0);
#pragma unroll
            for (int a = 0; a < 2; ++a) {
                float s = 0.f;
#pragma unroll
                for (int hh = 0; hh < 8; ++hh) s += wq[g][a][hh] * fmaxf(d[8 * a + hh], 0.f);
                sc[(4 * g + 2 * hi + a) * 2048 + key] = s;
            }
        }
    }
    __syncthreads();
    {
        const int t = t0 + wid, n = t + 1;
        LAS unsigned* hist = (LAS unsigned*)(lds + IX_HIST) + wid * 1024;
        LAS float* cand = (LAS float*)(lds + IX_CAND) + wid * 64;
        const LAS float* myv = sc + wid * 2048;
        float val[32];
#pragma unroll
        for (int i = 0; i < 32; ++i) { const int key = 64 * i + lane; val[i] = (key < n) ? myv[key] : -INFINITY; }
        float vmax = -INFINITY, vmin = INFINITY;
#pragma unroll
        for (int i = 0; i < 32; ++i) { vmax = fmaxf(vmax, val[i]); vmin = fminf(vmin, (64 * i + lane < n) ? val[i] : INFINITY); }
        float lo = wave_minf(vmin), hiv = wave_maxf(vmax);
        int k = 256; float vstar = lo; int rprime = 256;
        const unsigned long long ltmask = (lane == 0) ? 0ull : (~0ull >> (64 - lane));
        for (int iter = 0; iter < 64; ++iter) {
            if (!(hiv > lo)) { vstar = lo; rprime = k; break; }
            const float scale = 1024.f / (hiv - lo);
#pragma unroll
            for (int q = 0; q < 4; ++q) *(LAS u32x4*)(hist + 16 * lane + 4 * q) = (u32x4){0u, 0u, 0u, 0u};
#pragma unroll
            for (int i = 0; i < 32; ++i) {
                const float v = val[i];
                if (v >= lo && v <= hiv) { int bin = (int)((v - lo) * scale); bin = bin > 1023 ? 1023 : bin; __hip_atomic_fetch_add(hist + bin, 1u, __ATOMIC_RELAXED, __HIP_MEMORY_SCOPE_WORKGROUP); }
            }
            unsigned hb[16]; unsigned s = 0;
#pragma unroll
            for (int q = 0; q < 4; ++q) { const u32x4 x = *(const LAS u32x4*)(hist + 16 * lane + 4 * q); hb[4 * q] = x[0]; hb[4 * q + 1] = x[1]; hb[4 * q + 2] = x[2]; hb[4 * q + 3] = x[3]; s += x[0] + x[1] + x[2] + x[3]; }
            unsigned inc = s;
#pragma unroll
            for (int o = 1; o < 64; o <<= 1) { const unsigned tt = __shfl_down(inc, o); if (lane + o < 64) inc += tt; }
            const int above = (int)(inc - s);
            const bool here = (above < k) && (k <= above + (int)s);
            const unsigned long long hm = __ballot(here);
            const int L = hm ? (__ffsll((long long)hm) - 1) : 0;
            int a = above, bsel = -1, asel = 0, csel = 0;
#pragma unroll
            for (int jj = 15; jj >= 0; --jj) { if (bsel < 0 && a + (int)hb[jj] >= k) { bsel = jj; asel = a; csel = (int)hb[jj]; } a += (int)hb[jj]; }
            const int Bs = 16 * L + __shfl(bsel, L), ab = __shfl(asel, L), c = __shfl(csel, L);
            k -= ab;
            if (c <= 64) {
                int base = 0;
#pragma unroll
                for (int i = 0; i < 32; ++i) {
                    const float v = val[i]; bool isc = false;
                    if (v >= lo && v <= hiv) { int bin = (int)((v - lo) * scale); bin = bin > 1023 ? 1023 : bin; isc = (bin == Bs); }
                    const unsigned long long cm = __ballot(isc);
                    if (isc) cand[base + __popcll(cm & ltmask)] = v;
                    base += __popcll(cm);
                }
                const float mine = (lane < c) ? cand[lane] : -INFINITY;
                int gt = 0, ge = 0;
                for (int jj = 0; jj < c; ++jj) { const float x = cand[jj]; gt += (x > mine) ? 1 : 0; ge += (x >= mine) ? 1 : 0; }
                const bool ok = (lane < c) && (gt < k) && (k <= ge);
                const unsigned long long om = __ballot(ok);
                const int L2 = om ? (__ffsll((long long)om) - 1) : 0;
                vstar = __shfl(mine, L2); rprime = k - __shfl(gt, L2);
                break;
            } else {
                float cmin = INFINITY, cmax = -INFINITY;
#pragma unroll
                for (int i = 0; i < 32; ++i) {
                    const float v = val[i];
                    if (v >= lo && v <= hiv) { int bin = (int)((v - lo) * scale); bin = bin > 1023 ? 1023 : bin; if (bin == Bs) { cmin = fminf(cmin, v); cmax = fmaxf(cmax, v); } }
                }
                lo = wave_minf(cmin); hiv = wave_maxf(cmax);
                vstar = lo; rprime = k;
            }
        }
        unsigned* mrow = (unsigned*)(p.ws + WS_MASK) + (size_t)(rowbase + t) * 64;
        int run = 0;
#pragma unroll
        for (int i = 0; i < 32; ++i) {
            const float v = val[i];
            const bool eq = (v == vstar);
            const unsigned long long em = __ballot(eq);
            const bool sel = (v > vstar) || (eq && (run + __popcll(em & ltmask)) < rprime);
            run += __popcll(em);
            const unsigned long long sm = __ballot(sel);
            if (lane == 0) { mrow[2 * i] = (unsigned)sm; mrow[2 * i + 1] = (unsigned)(sm >> 32); }
        }
    }
    __syncthreads();
}

__device__ __forceinline__ void trivial_mask_rows(const Params& p) {
    unsigned* mask = (unsigned*)(p.ws + WS_MASK);
    const int G = gridDim.x;
    for (int i = blockIdx.x * 512 + threadIdx.x; i < BATCH * 256 * 64; i += G * 512) {
        const int w = i & 63, t = (i >> 6) & 255, b = i >> 14;
        unsigned v;
        if (32 * w + 31 <= t) v = 0xffffffffu; else if (32 * w > t) v = 0u; else v = (1u << (t - 32 * w + 1)) - 1u;
        mask[(size_t)(b * SEQ + t) * 64 + w] = v;
    }
}
constexpr int RT_LG = 0;
__device__ __forceinline__ void router_phase(const Params& p, LAS unsigned char* lds) {
    int tid_ = threadIdx.x; asm volatile("" : "+v"(tid_)); const int tid = tid_, lane = tid & 63, wid = __builtin_amdgcn_readfirstlane(tid >> 6), G = gridDim.x;
    const float* x1 = p.out; const float* x1ssq = (const float*)(p.ws + WS_X1SSQ); const float* mod2 = (const float*)(p.ws + WS_MOD2);
    bf16_t* H2 = (bf16_t*)(p.ws + WS_H);
    const bf16_t* wrh = (const bf16_t*)(p.ws + WS_WR); const bf16_t* wrl = wrh + 48 * 1024;
    unsigned* cnt = (unsigned*)(p.ws + WS_CNT); int* list = (int*)(p.ws + WS_LIST); float* rw = (float*)(p.ws + WS_RW);
    LAS float* lg = (LAS float*)(lds + RT_LG + wid * 3072);
    const int row = lane & 15, kq = lane >> 4;
    for (int wu = wid * G + blockIdx.x; wu < NTOK / 16; wu += 8 * G) {
        const int tok = 16 * wu + row, b = tok >> 11;
        float rstd;
        {
            const f32x4* s = (const f32x4*)(x1ssq + (size_t)tok * 16);
            const f32x4 a = s[0], c = s[1], d = s[2], e = s[3];
            const float q = ((a[0] + a[1]) + (a[2] + a[3])) + ((c[0] + c[1]) + (c[2] + c[3])) + ((d[0] + d[1]) + (d[2] + d[3])) + ((e[0] + e[1]) + (e[2] + e[3]));
            rstd = 1.f / sqrtf(q * (1.f / DM) + EPS);
        }
        f32x4 acc[3]; acc[0] = f32x4{}; acc[1] = f32x4{}; acc[2] = f32x4{};
        const float* xr = x1 + (size_t)tok * DM + 8 * kq;
        const float* ma = mod2 + (size_t)(b * 2) * 1024 + 8 * kq; const float* mc = ma + 1024;
        bf16_t* hr = H2 + (size_t)tok * DM + 8 * kq;
        const bf16_t* bh = wrh + (size_t)row * 1024 + 8 * kq; const bf16_t* bl = wrl + (size_t)row * 1024 + 8 * kq;
#pragma unroll 2
        for (int s = 0; s < 32; ++s) {
            const int k = 32 * s;
            const f32x4 xa = *(const f32x4*)(xr + k), xb = *(const f32x4*)(xr + k + 4);
            const f32x4 aa = *(const f32x4*)(ma + k), ab = *(const f32x4*)(ma + k + 4), ca = *(const f32x4*)(mc + k), cb = *(const f32x4*)(mc + k + 4);
            const f32x4 ha = xa * rstd * aa + ca, hb = xb * rstd * ab + cb;
            u32x4 w; w.x = pg8::cvt_pk_bf16(ha[0], ha[1]); w.y = pg8::cvt_pk_bf16(ha[2], ha[3]); w.z = pg8::cvt_pk_bf16(hb[0], hb[1]); w.w = pg8::cvt_pk_bf16(hb[2], hb[3]);
            *(u32x4*)(hr + k) = w;
            const bf16x8 af = __builtin_bit_cast(bf16x8, w);
#pragma unroll
            for (int nb = 0; nb < 3; ++nb) {
                const bf16x8 fh = *(const bf16x8*)(bh + (size_t)nb * 16 * 1024 + k), fl = *(const bf16x8*)(bl + (size_t)nb * 16 * 1024 + k);
                acc[nb] = __builtin_amdgcn_mfma_f32_16x16x32_bf16(af, fh, acc[nb], 0, 0, 0);
                acc[nb] = __builtin_amdgcn_mfma_f32_16x16x32_bf16(af, fl, acc[nb], 0, 0, 0);
            }
        }
#pragma unroll
        for (int nb = 0; nb < 3; ++nb)
#pragma unroll
            for (int i = 0; i < 4; ++i) lg[(4 * kq + i) * 48 + 16 * nb + row] = acc[nb][i];
        if (lane < 16) {
            const int tk = 16 * wu + lane;
            float gl[4]; int gs = 0; float gmax;
#pragma unroll
            for (int j = 0; j < 4; ++j) gl[j] = lg[lane * 48 + j] + p.b_group[j];
            gmax = gl[0];
#pragma unroll
            for (int j = 1; j < 4; ++j) if (gl[j] > gmax) { gmax = gl[j]; gs = j; }
            float den = 0.f;
#pragma unroll
            for (int j = 0; j < 4; ++j) den += __expf(gl[j] - gmax);
            const float pg = 1.f / den;
            float v1 = -INFINITY, v2 = -INFINITY; int i1 = 0, i2 = 0;
#pragma unroll
            for (int j = 0; j < 8; ++j) {
                const float ev = lg[lane * 48 + 16 + 8 * gs + j] + p.b_router[gs * 8 + j];
                if (ev > v1) { v2 = v1; i2 = i1; v1 = ev; i1 = j; } else if (ev > v2) { v2 = ev; i2 = j; }
            }
            const float e2 = __expf(v2 - v1);
            const float w1 = pg / (1.f + e2), w2 = pg * e2 / (1.f + e2);
            const int ea = gs * 8 + i1, eb = gs * 8 + i2;
            const unsigned sa = atomicAdd(cnt + ea, 1u), sb = atomicAdd(cnt + eb, 1u);
            list[ea * 16384 + sa] = tk * 2; list[eb * 16384 + sb] = tk * 2 + 1;
            rw[tk * 2] = w1; rw[tk * 2 + 1] = w2;
        }
    }
}
__device__ __forceinline__ void phase1_inproj(const Params& p, LAS unsigned char* lds) {
    pg8::Gemm g{(const bf16_t*)(p.ws + WS_H), (const bf16_t*)(p.ws + WS_WIN), 1024};
    pg8::StaticOrder S; S.init(NTOK, NPROJ, 1024, gridDim.x, blockIdx.x);
    EpiProj E{(bf16_t*)(p.ws + WS_PROJ), (float*)(p.ws + WS_IW), (float*)(p.ws + WS_LOGF), p.b_forget};
    pg8::gemm_phase<EpiProj, pg8::StaticOrder, false>(lds, g, S, E);
}
__device__ __forceinline__ int vcu_of(int G) { const int bx = blockIdx.x; return (G % 8 == 0) ? (bx % 8) * (G / 8) + bx / 8 : bx; }
template <int MODE> __device__ __forceinline__ void attn_phase(const Params& p, LAS unsigned char* lds) {
    const int G = gridDim.x;
    for (int v = vcu_of(G); v < 256; v += G) {
        const int bh = v >> 2, s = v & 3;
        attn_unit<MODE>(p, bh >> 3, bh & 7, 7 - s, lds);
        attn_unit<MODE>(p, bh >> 3, bh & 7, s, lds);
    }
}
__device__ __forceinline__ void indexer_phase(const Params& p, LAS unsigned char* lds) {
    const int G = gridDim.x;
    for (int v = vcu_of(G); v < 256; v += G) {
        const int b = v >> 5, j = v & 31;
        for (int i = 6; i >= 0; --i) {
            const int qg = 32 + 32 * i + ((i & 1) ? 31 - j : j);
            indexer_unit(p, b, 8 * qg, lds);
        }
    }
    trivial_mask_rows(p);
}
__device__ __forceinline__ void phase4_outproj(const Params& p, LAS unsigned char* lds) {
    pg8::Gemm g{(const bf16_t*)(p.ws + WS_O), (const bf16_t*)(p.ws + WS_WOUT), 1024};
    pg8::StaticOrder S; S.init(NTOK, DM, 1024, gridDim.x, blockIdx.x);
    EpiOut E{p.x, p.out, (const float*)(p.ws + WS_MOD), (const float*)(p.ws + WS_SSQ), (float*)(p.ws + WS_X1SSQ)};
    pg8::gemm_phase<EpiOut, pg8::StaticOrder, false>(lds, g, S, E);
}
__device__ __forceinline__ void phase6_moe_up(const Params& p, LAS unsigned char* lds) {
    pg8::Gemm g{(const bf16_t*)(p.ws + WS_H), (const bf16_t*)(p.ws + WS_WGU), 1024};
    MoeOrder S{(const int*)(p.ws + WS_CNT), (const int*)(p.ws + WS_LIST), 2, (int)gridDim.x, (int)blockIdx.x, 0, (size_t)512 * 1024 * 2, (size_t)256 * 1024 * 2, true};
    EpiAct E{(bf16_t*)(p.ws + WS_ACT), (const int*)(p.ws + WS_LIST), (const float*)(p.ws + WS_RW)};
    pg8::gemm_phase<EpiAct, MoeOrder, true>(lds, g, S, E);
}
__device__ __forceinline__ void phase7_moe_down(const Params& p, LAS unsigned char* lds) {
    pg8::Gemm g{(const bf16_t*)(p.ws + WS_ACT), (const bf16_t*)(p.ws + WS_WD), 256};
    MoeOrder S{(const int*)(p.ws + WS_CNT), (const int*)(p.ws + WS_LIST), 4, (int)gridDim.x, (int)blockIdx.x, (size_t)256 * 256 * 2, (size_t)1024 * 256 * 2, (size_t)256 * 256 * 2, false};
    EpiDown E{(bf16_t*)(p.ws + WS_Y), (const int*)(p.ws + WS_LIST)};
    pg8::gemm_phase<EpiDown, MoeOrder, false>(lds, g, S, E);
}

__global__ void __launch_bounds__(512, 2) mega(Params p) {
    extern __shared__ __attribute__((aligned(16))) unsigned char lds_raw[];
    LAS unsigned char* lds = (LAS unsigned char*)lds_raw;
    cg::grid_group grid = cg::this_grid();
    phase0(p, lds);
    grid.sync();
    phase0b(p);
    grid.sync();
    phase1_inproj(p, lds);
    grid.sync();
    attn_phase<0>(p, lds);
    indexer_phase(p, lds);
    grid.sync();
    attn_phase<1>(p, lds);
    grid.sync();
    phase4_outproj(p, lds);
    grid.sync();
    router_phase(p, lds);
    grid.sync();
    phase6_moe_up(p, lds);
    grid.sync();
    phase7_moe_down(p, lds);
    grid.sync();
    phase_final(p, false);
}

extern "C" void kernel_launch(void* const* d_in, const int* in_sizes, int n_in, void* d_out, int out_size, void* d_ws, size_t ws_size, hipStream_t stream) {
    static int grid = 0;
    if (grid == 0) {
        if (n_in != 19 || out_size != NTOK * DM || ws_size < WS_END) { fprintf(stderr, "kernel_launch: unexpected problem (n_in %d out %d ws %zu)\n", n_in, out_size, ws_size); grid = -1; return; }
        int dev = 0, cus = 0, per_cu = 0;
        (void)hipGetDevice(&dev);
        (void)hipDeviceGetAttribute(&cus, hipDeviceAttributeMultiprocessorCount, dev);
        (void)hipFuncSetAttribute((const void*)mega, hipFuncAttributeMaxDynamicSharedMemorySize, LDS_BYTES);
        (void)hipOccupancyMaxActiveBlocksPerMultiprocessor(&per_cu, (const void*)mega, 512, LDS_BYTES);
        if (per_cu < 1) { fprintf(stderr, "kernel_launch: occupancy query says %d blocks per CU\n", per_cu); per_cu = 1; }
        grid = cus;
        if (grid % 8) grid -= grid % 8;
    }
    if (grid < 0) return;
    Params p{};
    const float** f = (const float**)&p;
    for (int i = 0; i < 19; ++i) f[i] = (const float*)d_in[i];
    p.out = (float*)d_out; p.ws = (unsigned char*)d_ws;
    void* args[] = {&p};
    hipError_t e = hipLaunchCooperativeKernel((const void*)mega, dim3(grid), dim3(512), args, LDS_BYTES, stream);
    if (e != hipSuccess) fprintf(stderr, "cooperative launch failed: %s (grid %d)\n", hipGetErrorString(e), grid);
}
```

```cpp
#include <hip/hip_runtime.h>
#include <hip/hip_cooperative_groups.h>
#include <cstdio>
#include <cstdint>
namespace cg = cooperative_groups;

#define LAS __attribute__((address_space(3)))
typedef unsigned short bf16_t;
typedef short bf16x8 __attribute__((ext_vector_type(8)));
typedef float f32x4 __attribute__((ext_vector_type(4)));
typedef float f32x16 __attribute__((ext_vector_type(16)));
typedef unsigned u32x4 __attribute__((ext_vector_type(4)));
typedef unsigned u32x2 __attribute__((ext_vector_type(2)));

constexpr int BATCH = 8, SEQ = 2048, DM = 1024, NTOK = BATCH * SEQ;
constexpr int NMOD = 6 * DM;
constexpr int IN_COLS = 2896, NPROJ = 3072;
constexpr int C_AQ = 0, C_BQ = 512, C_IQ = 1024, C_BK = 1536, C_BV = 2048, C_AK = 2560, C_AV = 2688, C_IK = 2816, C_IW = 2880, C_BF = 2888;
constexpr int NEXP = 32, DFF = 256;
constexpr float EPS = 1e-6f;
constexpr float LOG2E = 1.4426950408889634f;
constexpr float C2 = 0.125f * LOG2E;

constexpr size_t KiB = 1024, MiB = 1024 * 1024;
constexpr size_t WS_CNT = 0;
constexpr size_t WS_BAR = 16 * KiB;
constexpr size_t WS_ZERO_BYTES = 32 * KiB;
constexpr size_t WS_MOD = 64 * KiB;
constexpr size_t WS_MOD2 = 256 * KiB;
constexpr size_t WS_IW = 512 * KiB;
constexpr size_t WS_LOGF = 1 * MiB;
constexpr size_t WS_SSQ = 1 * MiB + 512 * KiB;
constexpr size_t WS_X1SSQ = 2 * MiB + 512 * KiB;
constexpr size_t WS_RW = 3 * MiB + 512 * KiB;
constexpr size_t WS_LIST = 4 * MiB;
constexpr size_t WS_WR = 6 * MiB;
constexpr size_t WS_WIN = 8 * MiB;
constexpr size_t WS_WOUT = 14 * MiB;
constexpr size_t WS_WGU = 16 * MiB;
constexpr size_t WS_WD = 48 * MiB;
constexpr size_t WS_PROJ = 64 * MiB;
constexpr size_t WS_Y = 64 * MiB;
constexpr size_t WS_ACT = 128 * MiB;
constexpr size_t WS_H = 160 * MiB;
constexpr size_t WS_O = 192 * MiB;
constexpr size_t WS_MASK = 224 * MiB;
constexpr size_t WS_END = 228 * MiB;

constexpr int LDS_BYTES = 147456;

struct Params {
    const float *x, *c, *w_ada, *b_ada, *g_mix, *w_in, *b_forget, *g_out_a, *g_out_b, *w_out, *g_ffn, *w_group, *b_group, *w_router, *b_router, *w_gate, *w_up, *w_down, *g_final;
    float* out;
    unsigned char* ws;
};

__device__ __forceinline__ unsigned f2bf(float f) { unsigned u = __builtin_bit_cast(unsigned, f); return (u + 0x7fffu + ((u >> 16) & 1u)) >> 16; }
__device__ __forceinline__ unsigned pk2(float lo, float hi) { return f2bf(lo) | (f2bf(hi) << 16); }
__device__ __forceinline__ float bf2f(unsigned short b) { return __builtin_bit_cast(float, (unsigned)b << 16); }
__device__ __forceinline__ float wave_sum(float v) {
#pragma unroll
    for (int o = 1; o < 64; o <<= 1) v += __shfl_xor(v, o);
    return v;
}
__device__ __forceinline__ float siluf(float v) { return v / (1.f + __expf(-v)); }

__device__ __forceinline__ int win_row(int n) {
    if (n < 512) return C_AQ + n;
    if (n < 640) return C_AK + (n - 512);
    if (n < 768) return C_AV + (n - 640);
    if (n < 1280) return C_IQ + (n - 768);
    if (n < 1344) return C_IK + (n - 1280);
    if (n < 1352) return C_IW + (n - 1344);
    if (n < 1864) return C_BQ + (n - 1352);
    if (n < 2376) return C_BK + (n - 1864);
    if (n < 2888) return C_BV + (n - 2376);
    return C_BF + (n - 2888);
}
template <int MAP> __device__ __forceinline__ void transpose_item(const float* W, int K, int N, bf16_t* WT, int k0, int n0, LAS float* scr, int lane, const float* kscale) {
    const int nn = n0 + (lane & 31);
#pragma unroll 8
    for (int i = 0; i < 32; ++i) {
        const int kk = 2 * i + (lane >> 5);
        float v = (nn < N) ? W[(size_t)(k0 + kk) * N + nn] : 0.f;
        if (kscale) v *= kscale[k0 + kk];
        scr[kk * 33 + (lane & 31)] = v;
    }
    asm volatile("s_waitcnt lgkmcnt(0)" ::: "memory");
    const int c = lane & 7;
#pragma unroll
    for (int j = 0; j < 4; ++j) {
        const int nl = (lane >> 3) + 8 * j, n = n0 + nl;
        const LAS float* s = scr + (8 * c) * 33 + nl;
        u32x4 o; o.x = pk2(s[0 * 33], s[1 * 33]); o.y = pk2(s[2 * 33], s[3 * 33]); o.z = pk2(s[4 * 33], s[5 * 33]); o.w = pk2(s[6 * 33], s[7 * 33]);
        int row;
        if (MAP == 0) row = n; else if (MAP == 1) row = win_row(n); else if (MAP == 2) row = (n >> 7) * 256 + (n & 127); else row = (n >> 7) * 256 + 128 + (n & 127);
        if (n < N) *(u32x4*)(WT + (size_t)row * K + k0 + 8 * c) = o;
    }
    asm volatile("s_waitcnt lgkmcnt(0)" ::: "memory");
}

__device__ __forceinline__ void phase0(const Params& p, LAS unsigned char* lds) {
    int tid_ = threadIdx.x; asm volatile("" : "+v"(tid_)); const int tid = tid_, lane = tid & 63, wave = tid >> 6, G = gridDim.x;
    unsigned char* ws = p.ws;
    if ((int)blockIdx.x < NMOD / 64) {
        LAS float* sc = (LAS float*)lds;
        LAS float* red = (LAS float*)(lds + 32768);
        for (int i = tid; i < BATCH * DM; i += 512) sc[i] = siluf(p.c[i]);
        __syncthreads();
        const int j0 = 64 * blockIdx.x, col = lane;
        float acc[8];
#pragma unroll
        for (int b = 0; b < 8; ++b) acc[b] = 0.f;
        const float* wp = p.w_ada + (size_t)(wave * 128) * NMOD + j0 + col;
        for (int k4 = 0; k4 < 128; k4 += 4) {
            float w[4];
#pragma unroll
            for (int u = 0; u < 4; ++u) w[u] = wp[(size_t)(k4 + u) * NMOD];
#pragma unroll
            for (int b = 0; b < 8; ++b) {
                const f32x4 s = *(const LAS f32x4*)(sc + b * 1024 + wave * 128 + k4);
                acc[b] += s[0] * w[0] + s[1] * w[1] + s[2] * w[2] + s[3] * w[3];
            }
        }
#pragma unroll
        for (int b = 0; b < 8; ++b) red[(wave * 8 + b) * 64 + col] = acc[b];
        __syncthreads();
        {
            const int b = tid >> 6; float s = 0.f;
#pragma unroll
            for (int w = 0; w < 8; ++w) s += red[(w * 8 + b) * 64 + col];
            ((float*)(ws + WS_MOD))[b * NMOD + j0 + col] = s + p.b_ada[j0 + col];
        }
        __syncthreads();
    }
    {
        bf16_t* wrh = (bf16_t*)(ws + WS_WR); bf16_t* wrl = wrh + 48 * 1024;
        for (int i = blockIdx.x * 512 + tid; i < 48 * 1024; i += G * 512) {
            const int o = i >> 10, k = i & 1023; float v = 0.f;
            if (o < 4) v = p.w_group[k * 4 + o];
            else if (o >= 16) { const int g = (o - 16) >> 3, e = (o - 16) & 7; v = p.w_router[((size_t)g * 1024 + k) * 8 + e]; }
            const unsigned hb = f2bf(v); const float hf = bf2f((unsigned short)hb);
            wrh[i] = (bf16_t)hb; wrl[i] = (bf16_t)f2bf(v - hf);
        }
    }
    {
        u32x4* z = (u32x4*)((bf16_t*)(ws + WS_WIN) + (size_t)IN_COLS * 1024);
        const int n16 = (NPROJ - IN_COLS) * 1024 * 2 / 16;
        for (int i = blockIdx.x * 512 + tid; i < n16; i += G * 512) z[i] = (u32x4){0u, 0u, 0u, 0u};
    }
    {
        LAS float* scr = (LAS float*)(lds + 49152 + wave * 8704);
        const int gw = blockIdx.x * 8 + wave, NGW = G * 8;
        constexpr int NB_IN = (IN_COLS + 31) / 32;
        constexpr int I_IN = 16 * NB_IN, I_OUT = 16 * 32, I_G = 32 * 16 * 8, I_U = I_G, I_D = 32 * 4 * 32;
        constexpr int NITEMS = I_IN + I_OUT + I_G + I_U + I_D;
        for (int it = gw; it < NITEMS; it += NGW) {
            int r = it;
            if (r < I_IN) { const int kb = r / NB_IN, nb = r % NB_IN; transpose_item<1>(p.w_in, 1024, IN_COLS, (bf16_t*)(ws + WS_WIN), 64 * kb, 32 * nb, scr, lane, nullptr); continue; } r -= I_IN;
            if (r < I_OUT) { const int kb = r / 32, nb = r % 32; const int k0 = 64 * kb;
                transpose_item<0>(p.w_out, 1024, 1024, (bf16_t*)(ws + WS_WOUT), k0, 32 * nb, scr, lane, k0 < 512 ? p.g_out_a : p.g_out_b - 512); continue; } r -= I_OUT;
            if (r < I_G) { const int e = r >> 7, q = r & 127, kb = q >> 3, nb = q & 7;
                transpose_item<2>(p.w_gate + (size_t)e * 1024 * 256, 1024, 256, (bf16_t*)(ws + WS_WGU) + (size_t)e * 512 * 1024, 64 * kb, 32 * nb, scr, lane, nullptr); continue; } r -= I_G;
            if (r < I_U) { const int e = r >> 7, q = r & 127, kb = q >> 3, nb = q & 7;
                transpose_item<3>(p.w_up + (size_t)e * 1024 * 256, 1024, 256, (bf16_t*)(ws + WS_WGU) + (size_t)e * 512 * 1024, 64 * kb, 32 * nb, scr, lane, nullptr); continue; } r -= I_U;
            { const int e = r >> 7, q = r & 127, kb = q >> 5, nb = q & 31;
                transpose_item<0>(p.w_down + (size_t)e * 256 * 1024, 256, 1024, (bf16_t*)(ws + WS_WD) + (size_t)e * 1024 * 256, 64 * kb, 32 * nb, scr, lane, nullptr); }
        }
    }
}

__device__ __forceinline__ void phase0b(const Params& p) {
    int tid_ = threadIdx.x; asm volatile("" : "+v"(tid_)); const int tid = tid_, lane = tid & 63, wave = tid >> 6, G = gridDim.x;
    const float* mod = (const float*)(p.ws + WS_MOD);
    float* mod2 = (float*)(p.ws + WS_MOD2);
    for (int i = blockIdx.x * 512 + tid; i < BATCH * DM; i += G * 512) {
        const int b = i >> 10, k = i & 1023;
        mod2[(b * 2 + 0) * 1024 + k] = p.g_ffn[k] * (1.f + mod[b * NMOD + 4 * DM + k]);
        mod2[(b * 2 + 1) * 1024 + k] = mod[b * NMOD + 3 * DM + k];
    }
    bf16_t* H = (bf16_t*)(p.ws + WS_H);
    const int gw = blockIdx.x * 8 + wave, NGW = G * 8;
    for (int m = gw; m < NTOK; m += NGW) {
        const int b = m >> 11;
        const f32x4* xr = (const f32x4*)(p.x + (size_t)m * DM) + lane;
        f32x4 v[4]; float s = 0.f;
#pragma unroll
        for (int j = 0; j < 4; ++j) { v[j] = xr[64 * j]; s += (v[j].x * v[j].x + v[j].y * v[j].y) + (v[j].z * v[j].z + v[j].w * v[j].w); }
        const float rstd = 1.f / sqrtf(wave_sum(s) * (1.f / DM) + EPS);
        unsigned long long* o8 = (unsigned long long*)(H + (size_t)m * DM) + lane;
#pragma unroll
        for (int j = 0; j < 4; ++j) {
            const int k = 4 * lane + 256 * j;
            const f32x4 g = *(const f32x4*)(p.g_mix + k), sh = *(const f32x4*)(mod + b * NMOD + k), sc = *(const f32x4*)(mod + b * NMOD + DM + k);
            const f32x4 h = v[j] * rstd * g * (1.f + sc) + sh;
            o8[64 * j] = (unsigned long long)pk2(h.x, h.y) | ((unsigned long long)pk2(h.z, h.w) << 32);
        }
    }
}

__device__ __forceinline__ void phase_final(const Params& p, bool skeleton) {
    int tid_ = threadIdx.x; asm volatile("" : "+v"(tid_)); const int tid = tid_, lane = tid & 63, wave = tid >> 6, G = gridDim.x;
    const float* mod = (const float*)(p.ws + WS_MOD);
    const bf16_t* Y = (const bf16_t*)(p.ws + WS_Y);
    const int gw = blockIdx.x * 8 + wave, NGW = G * 8;
    for (int m = gw; m < NTOK; m += NGW) {
        const int b = m >> 11;
        const f32x4* xr = (const f32x4*)((skeleton ? p.x : p.out) + (size_t)m * DM) + lane;
        f32x4 v[4]; float s = 0.f;
#pragma unroll
        for (int j = 0; j < 4; ++j) {
            v[j] = xr[64 * j];
            if (!skeleton) {
                const int k = 4 * lane + 256 * j;
                const f32x4 gf = *(const f32x4*)(mod + b * NMOD + 5 * DM + k);
                const u32x2 y0 = *(const u32x2*)(Y + ((size_t)m * 2 + 0) * DM + k), y1 = *(const u32x2*)(Y + ((size_t)m * 2 + 1) * DM + k);
                f32x4 ys;
                ys.x = bf2f((unsigned short)(y0.x & 0xffff)) + bf2f((unsigned short)(y1.x & 0xffff)); ys.y = bf2f((unsigned short)(y0.x >> 16)) + bf2f((unsigned short)(y1.x >> 16));
                ys.z = bf2f((unsigned short)(y0.y & 0xffff)) + bf2f((unsigned short)(y1.y & 0xffff)); ys.w = bf2f((unsigned short)(y0.y >> 16)) + bf2f((unsigned short)(y1.y >> 16));
                v[j] = v[j] + gf * ys;
            }
            s += (v[j].x * v[j].x + v[j].y * v[j].y) + (v[j].z * v[j].z + v[j].w * v[j].w);
        }
        const float rstd = 1.f / sqrtf(wave_sum(s) * (1.f / DM) + EPS);
        f32x4* o = (f32x4*)(p.out + (size_t)m * DM) + lane;
#pragma unroll
        for (int j = 0; j < 4; ++j) { const f32x4 g = *(const f32x4*)(p.g_final + 4 * lane + 256 * j); o[64 * j] = v[j] * rstd * g; }
    }
}

#define XB_TMO      128
#define XB_XCNT(j)  (256  + 64 * (j))
#define XB_XSUB(j)  (1280 + 64 * (j))
#define XB_XGEN(j)  (2304 + 64 * (j))
#define XB_TOP      3328
#define XB_TOPGEN   3392
#define XCD_BAR_WORDS 3456
#define XB_SPIN_CAP (1u << 18)
__device__ __forceinline__ unsigned xb_ld(unsigned* p)              { return __hip_atomic_load(p, __ATOMIC_RELAXED, __HIP_MEMORY_SCOPE_AGENT); }
__device__ __forceinline__ unsigned xb_add(unsigned* p, unsigned v) { return __hip_atomic_fetch_add(p, v, __ATOMIC_RELAXED, __HIP_MEMORY_SCOPE_AGENT); }
__device__ __forceinline__ unsigned xb_xcc_id() { return (unsigned)__builtin_amdgcn_s_getreg((3 << 11) | 20) & 0xFu; }
#define XB_SPIN(cond, bar) do { unsigned _sp = 0; while (cond) { __builtin_amdgcn_s_sleep(1); \
    if ((++_sp & 255u) == 0u) { if (xb_ld(&(bar)[XB_TMO])) break; if (_sp > XB_SPIN_CAP) { atomicAdd(&(bar)[XB_TMO], 1u); break; } } } } while (0)
struct XcdBarrier { unsigned* bar; unsigned x; volatile LAS unsigned* st; };
__device__ __forceinline__ XcdBarrier xcd_barrier_post(unsigned* bar, volatile LAS unsigned* st) {
    XcdBarrier b; b.bar = bar; b.x = xb_xcc_id(); b.st = st;
    if (threadIdx.x == 0) (void)xb_add(&bar[XB_XCNT(b.x)], 1u);
    return b;
}
__device__ __forceinline__ void xcd_barrier_complete(unsigned* bar, unsigned x, unsigned& nloc, unsigned& nx) {
    const unsigned G = gridDim.x * gridDim.y * gridDim.z;
    unsigned sum, cnt, mine, sp = 0u;
    for (;;) {
        sum = 0u; cnt = 0u; mine = 0u;
#pragma unroll
        for (unsigned j = 0; j < 16; ++j) { const unsigned c = xb_ld(&bar[XB_XCNT(j)]); sum += c; cnt += (c > 0u) ? 1u : 0u; mine = (j == x) ? c : mine; }
        if (sum == G) break;
        __builtin_amdgcn_s_sleep(1);
        if ((++sp & 255u) == 0u) { if (xb_ld(&bar[XB_TMO])) break; if (sp > XB_SPIN_CAP) { atomicAdd(&bar[XB_TMO], 1u); break; } }
    }
    nloc = mine > 0u ? mine : 1u; nx = cnt > 0u ? cnt : 1u;
}
__device__ __forceinline__ void xcd_barrier(const XcdBarrier& b) {
    asm volatile("s_waitcnt vmcnt(0)" ::: "memory");
    __syncthreads();
    if (threadIdx.x == 0) {
        unsigned* bar = b.bar;
        __builtin_amdgcn_s_waitcnt(0);
        unsigned nloc = b.st[0], nx = b.st[1];
        if (nloc == 0u) { xcd_barrier_complete(bar, b.x, nloc, nx); b.st[0] = nloc; b.st[1] = nx; }
        const unsigned old = xb_add(&bar[XB_XSUB(b.x)], 1u);
        const unsigned gen = old / nloc;
        if (old + 1u == (gen + 1u) * nloc) {
            __builtin_amdgcn_fence(__ATOMIC_RELEASE, "agent");
            asm volatile("s_waitcnt vmcnt(0)" ::: "memory");
            const unsigned og = xb_add(&bar[XB_TOP], 1u);
            const unsigned tg = og / nx;
            if (og + 1u == (tg + 1u) * nx) xb_add(&bar[XB_TOPGEN], 1u);
            else XB_SPIN(xb_ld(&bar[XB_TOPGEN]) == tg, bar);
            __builtin_amdgcn_fence(__ATOMIC_ACQUIRE, "agent");
            xb_add(&bar[XB_XGEN(b.x)], 1u);
            asm volatile("s_waitcnt vmcnt(0)" ::: "memory");
        } else {
            XB_SPIN(xb_ld(&bar[XB_XGEN(b.x)]) == gen, bar);
            __builtin_amdgcn_fence(__ATOMIC_ACQUIRE, "agent");
            asm volatile("s_waitcnt vmcnt(0)" ::: "memory");
        }
    }
    __syncthreads();
}
namespace pg8 {
constexpr int BM = 256, BK = 64, HALF = 128, HTB = HALF * BK * 2, STAGE_BYTES = 8 * HTB, NXCD = 8, WGM = 8;
__host__ __device__ __forceinline__ int lds_byte(int r, int c) { const int st = (r >> 4) * 2 + (c >> 5), rr = r & 15, cc = c & 31, ob = rr * 64 + cc * 2; return st * 1024 + (ob ^ (((ob >> 9) & 1) << 5)); }
__host__ __device__ __forceinline__ void stage_rc(int b, int& R, int& C) { const int st = b / 1024, sb = b % 1024, swz = sb ^ (((sb >> 9) & 1) << 5); R = (st >> 1) * 16 + swz / 64; C = (st & 1) * 32 + (swz % 64) / 2; }
__host__ __device__ __forceinline__ int perm32(int rho) { const int n = rho >> 4, i = rho & 15; return 8 * (i >> 2) + 4 * n + (i & 3); }

struct Unit { int pm, pn; size_t aoff, boff; int e, r0, cnt; };
struct Gemm { const bf16_t* A; const bf16_t* Bt; int K; };

struct StaticOrder {
    int nM, nN, nwg, G, c; size_t tstep;
    __device__ void init(int M, int N, int K, int G_, int c_) { nM = M / BM; nN = N / BM; nwg = nM * nN; G = G_; c = c_; tstep = (size_t)BM * K * 2; }
    __device__ bool next(int i, Unit& u) const {
        const long L = (long)i * G + c; if (L >= nwg) return false;
        int wgid = (int)L; { const int q = nwg / NXCD, r = nwg % NXCD, xcd = wgid % NXCD, off = wgid / NXCD; wgid = (xcd < r ? xcd * (q + 1) : r * (q + 1) + (xcd - r) * q) + off; }
        const int nig = WGM * nN, gid = wgid / nig, fm = gid * WGM, gsz = (nM - fm) < WGM ? (nM - fm) : WGM;
        u.pm = fm + ((wgid % nig) % gsz); u.pn = (wgid % nig) / gsz; u.aoff = (size_t)u.pm * tstep; u.boff = (size_t)u.pn * tstep; u.e = 0; u.r0 = 0; u.cnt = 0; return true;
    }
    __device__ __forceinline__ unsigned arow(const Unit&, int R) const { return 0u; }
};

__device__ __forceinline__ unsigned cvt_pk_bf16(float lo, float hi) { unsigned r; asm volatile("v_cvt_pk_bf16_f32 %0, %1, %2" : "=v"(r) : "v"(lo), "v"(hi)); return r; }

template <class Epi, class Sched, bool GATHER>
__device__ __forceinline__ void gemm_phase(LAS unsigned char* lds, const Gemm g, const Sched& S, const Epi& E) {
    int tid_ = threadIdx.x; asm volatile("" : "+v"(tid_)); const int tid = tid_, wid = __builtin_amdgcn_readfirstlane(tid >> 6), lane = tid & 63, wr = wid >> 2, wc = wid & 3, fr = lane & 15, fq = lane >> 4;
    const int K = g.K, nt = K / BK;
    int Rst[2], Cst[2]; unsigned voffB[2], cOA[2][2], nOA[2][2];
    const size_t kstep = (size_t)(BK * 2);
    const size_t hstep = (size_t)HALF * K * 2;
#pragma unroll
    for (int i = 0; i < 2; ++i) { int R, C; stage_rc(tid * 16 + i * 8192, R, C); Rst[i] = R; Cst[i] = C; const int Rb = Epi::PERM ? ((R & ~31) + perm32(R & 31)) : R; voffB[i] = (unsigned)(Rb * K + C) * 2u; }
    const unsigned ldsw = (unsigned)wid * 1024u;
    const int aoff = lds_byte(wr * 64 + fr, fq * 8), boff = lds_byte(wc * 32 + fr, fq * 8);
#define PG8_SA(b, h) (((b) * 2 + (h)) * HTB)
#define PG8_SB(b, h) ((4 + (b) * 2 + (h)) * HTB)
#define PG8_STAGE_B(bufoff, gbase) do { _Pragma("unroll") for (int _i = 0; _i < 2; ++_i) \
        __builtin_amdgcn_global_load_lds((const unsigned*)((const char*)(gbase) + voffB[_i]), (LAS unsigned*)(lds + (bufoff) + ldsw + _i * 8192), 16, 0, 0); } while (0)
#define PG8_STAGE_A(bufoff, gbase, o0, o1) do { \
        __builtin_amdgcn_global_load_lds((const unsigned*)((const char*)(gbase) + (o0)), (LAS unsigned*)(lds + (bufoff) + ldsw), 16, 0, 0); \
        __builtin_amdgcn_global_load_lds((const unsigned*)((const char*)(gbase) + (o1)), (LAS unsigned*)(lds + (bufoff) + ldsw + 8192), 16, 0, 0); } while (0)
#define PG8_LDA(dst, b, h) do { _Pragma("unroll") for (int m = 0; m < 4; ++m) _Pragma("unroll") for (int k = 0; k < 2; ++k) dst[m][k] = *(const LAS bf16x8*)(lds + PG8_SA(b, h) + aoff + m * 2048 + k * 1024); } while (0)
#define PG8_LDB(dst, b, h) do { _Pragma("unroll") for (int n = 0; n < 2; ++n) _Pragma("unroll") for (int k = 0; k < 2; ++k) dst[n][k] = *(const LAS bf16x8*)(lds + PG8_SB(b, h) + boff + n * 2048 + k * 1024); } while (0)
#define PG8_MMA(ai, bj, At, Bt) do { __builtin_amdgcn_s_setprio(1); _Pragma("unroll") for (int m = 0; m < 4; ++m) _Pragma("unroll") for (int n = 0; n < 2; ++n) _Pragma("unroll") for (int k = 0; k < 2; ++k) \
        acc[ai][bj][m][n] = __builtin_amdgcn_mfma_f32_16x16x32_bf16(Bt[n][k], At[m][k], acc[ai][bj][m][n], 0, 0, 0); __builtin_amdgcn_s_setprio(0); } while (0)
#define PG8_WAIT_V(n) asm volatile("s_waitcnt vmcnt(" #n ")" ::: "memory")
#define PG8_WAIT_L(n) asm volatile("s_waitcnt lgkmcnt(" #n ")" ::: "memory")
#define PG8_BAR __builtin_amdgcn_s_barrier()
#define PG8_SCHED __builtin_amdgcn_sched_barrier(0)
#define PG8_SETOFF(dst, u) do { _Pragma("unroll") for (int _h = 0; _h < 2; ++_h) _Pragma("unroll") for (int _i = 0; _i < 2; ++_i) { \
        if (GATHER) dst[_h][_i] = S.arow(u, Rst[_i] + HALF * _h) * (unsigned)(K * 2) + (unsigned)(Cst[_i] * 2); \
        else dst[_h][_i] = (unsigned)((Rst[_i] + HALF * _h) * K + Cst[_i]) * 2u; } } while (0)
    Unit cur, nxt; int ui = 0;
    if (!S.next(0, cur)) return;
    f32x4 acc[2][2][4][2];
#pragma unroll
    for (int a = 0; a < 2; ++a)
#pragma unroll
        for (int b = 0; b < 2; ++b)
#pragma unroll
            for (int m = 0; m < 4; ++m)
#pragma unroll
                for (int n = 0; n < 2; ++n) acc[a][b][m][n] = (f32x4){0.f, 0.f, 0.f, 0.f};
    bf16x8 At[4][2], B0[2][2], B1[2][2];
    const char* cA = (const char*)g.A + cur.aoff; const char* cB = (const char*)g.Bt + cur.boff;
    PG8_SETOFF(cOA, cur);
    PG8_STAGE_B(PG8_SB(0, 0), cB); PG8_STAGE_B(PG8_SB(0, 1), cB + hstep); PG8_STAGE_A(PG8_SA(0, 0), cA, cOA[0][0], cOA[0][1]); PG8_STAGE_A(PG8_SA(0, 1), cA, cOA[1][0], cOA[1][1]);
    if (wr == 1) PG8_BAR;
    PG8_WAIT_V(2); PG8_BAR;
    PG8_STAGE_B(PG8_SB(1, 0), cB + kstep); PG8_STAGE_A(PG8_SA(1, 0), cA + kstep, cOA[0][0], cOA[0][1]); PG8_STAGE_B(PG8_SB(1, 1), cB + hstep + kstep);
    PG8_WAIT_V(6); PG8_BAR;
    for (;;) {
        const bool has_next = S.next(ui + 1, nxt);
        const char* nA = has_next ? (const char*)g.A + nxt.aoff : cA; const char* nB = has_next ? (const char*)g.Bt + nxt.boff : cB;
        if (has_next) { PG8_SETOFF(nOA, nxt); } else {
#pragma unroll
            for (int _h = 0; _h < 2; ++_h)
#pragma unroll
                for (int _i = 0; _i < 2; ++_i) nOA[_h][_i] = cOA[_h][_i]; }
        for (int t = 0; t < nt; t += 2) {
            const bool last = (t == nt - 2);
            if constexpr (Epi::MID) { if (t == nt / 2) E.mid(acc, cur, wr, fr); }
            const char* a1 = cA + (size_t)(t + 1) * kstep;
            const char* a2 = last ? nA : cA + (size_t)(t + 2) * kstep; const char* b2 = last ? nB : cB + (size_t)(t + 2) * kstep;
            const char* a3 = a2 + kstep; const char* b3 = b2 + kstep;
            const unsigned x00 = last ? nOA[0][0] : cOA[0][0], x01 = last ? nOA[0][1] : cOA[0][1], x10 = last ? nOA[1][0] : cOA[1][0], x11 = last ? nOA[1][1] : cOA[1][1];
            PG8_LDB(B0, 0, 0); PG8_LDB(B1, 0, 1); PG8_SCHED; PG8_LDA(At, 0, 0); PG8_STAGE_A(PG8_SA(1, 1), a1, cOA[1][0], cOA[1][1]);
            PG8_WAIT_V(8); PG8_WAIT_L(0); PG8_BAR; PG8_MMA(0, 0, At, B0); PG8_MMA(0, 1, At, B1); PG8_BAR; PG8_SCHED;
            PG8_LDA(At, 0, 1); PG8_STAGE_B(PG8_SB(0, 0), b2); PG8_STAGE_B(PG8_SB(0, 1), b2 + hstep); PG8_STAGE_A(PG8_SA(0, 0), a2, x00, x01);
            PG8_WAIT_V(8); PG8_WAIT_L(0); PG8_BAR; PG8_MMA(1, 0, At, B0); PG8_MMA(1, 1, At, B1); PG8_BAR; PG8_SCHED;
            PG8_LDB(B0, 1, 0); PG8_LDB(B1, 1, 1); PG8_SCHED; PG8_LDA(At, 1, 0); PG8_STAGE_A(PG8_SA(0, 1), a2, x10, x11);
            PG8_WAIT_V(8); PG8_WAIT_L(0); PG8_BAR; PG8_MMA(0, 0, At, B0); PG8_MMA(0, 1, At, B1); PG8_BAR; PG8_SCHED;
            PG8_LDA(At, 1, 1); PG8_STAGE_B(PG8_SB(1, 0), b3); PG8_STAGE_B(PG8_SB(1, 1), b3 + hstep); PG8_STAGE_A(PG8_SA(1, 0), a3, x00, x01);
            PG8_WAIT_V(8); PG8_WAIT_L(0); PG8_BAR; PG8_MMA(1, 0, At, B0); PG8_MMA(1, 1, At, B1); PG8_BAR; PG8_SCHED;
        }
        if (wr == 0) PG8_BAR;
        E(acc, cur, wr, wc, fr, fq);
        if (!has_next) break;
#pragma unroll
        for (int a = 0; a < 2; ++a)
#pragma unroll
            for (int b = 0; b < 2; ++b)
#pragma unroll
                for (int m = 0; m < 4; ++m)
#pragma unroll
                    for (int n = 0; n < 2; ++n) acc[a][b][m][n] = (f32x4){0.f, 0.f, 0.f, 0.f};
        cur = nxt; cA = nA; cB = nB; ++ui;
#pragma unroll
        for (int _h = 0; _h < 2; ++_h)
#pragma unroll
            for (int _i = 0; _i < 2; ++_i) cOA[_h][_i] = nOA[_h][_i];
        if (wr == 1) PG8_BAR;
    }
    PG8_WAIT_V(0);
    PG8_BAR;
#undef PG8_SA
#undef PG8_SB
#undef PG8_STAGE_A
#undef PG8_STAGE_B
#undef PG8_LDA
#undef PG8_LDB
#undef PG8_MMA
#undef PG8_WAIT_V
#undef PG8_WAIT_L
#undef PG8_BAR
#undef PG8_SCHED
#undef PG8_SETOFF
}
}
typedef float f32x2 __attribute__((ext_vector_type(2)));
using pg8::cvt_pk_bf16;

struct EpiProj {
    static constexpr bool PERM = true, MID = false;
    bf16_t* O; float* iw; float* logf; const float* b_forget;
    __device__ __forceinline__ void operator()(const f32x4 (&acc)[2][2][4][2], const pg8::Unit& u, int wr, int wc, int fr_, int fq_) const {
        int fr = fr_, fq = fq_; asm volatile("" : "+v"(fr), "+v"(fq));
        const int row0 = u.pm * 256 + wr * 64 + fr, col0 = u.pn * 256 + wc * 32 + 8 * fq;
        const float sc = (u.pn < 4) ? C2 : 1.f;
#pragma unroll
        for (int ai = 0; ai < 2; ++ai)
#pragma unroll
            for (int m = 0; m < 4; ++m) {
                const int row = row0 + ai * 128 + m * 16;
                bf16_t* rowp = O + (size_t)row * NPROJ + col0;
#pragma unroll
                for (int bj = 0; bj < 2; ++bj) {
                    const f32x4 v0 = acc[ai][bj][m][0] * sc, v1 = acc[ai][bj][m][1] * sc;
                    u32x4 w; w.x = cvt_pk_bf16(v0[0], v0[1]); w.y = cvt_pk_bf16(v0[2], v0[3]); w.z = cvt_pk_bf16(v1[0], v1[1]); w.w = cvt_pk_bf16(v1[2], v1[3]);
                    *(u32x4*)(rowp + bj * 128) = w;
                }
                if (u.pn == 11 && wc == 2 && fq < 2) {
                    const f32x4 v0 = acc[ai][0][m][0], v1 = acc[ai][0][m][1];
                    if (fq == 0) { *(f32x4*)(iw + (size_t)row * 8) = v0; *(f32x4*)(iw + (size_t)row * 8 + 4) = v1; }
                    else {
                        f32x4 o0, o1;
#pragma unroll
                        for (int i = 0; i < 4; ++i) {
                            const float z0 = v0[i] + b_forget[i], z1 = v1[i] + b_forget[4 + i];
                            o0[i] = fminf(z0, 0.f) - log1pf(__expf(-fabsf(z0))); o1[i] = fminf(z1, 0.f) - log1pf(__expf(-fabsf(z1)));
                        }
                        *(f32x4*)(logf + (size_t)row * 8) = o0; *(f32x4*)(logf + (size_t)row * 8 + 4) = o1;
                    }
                }
            }
    }
};

struct EpiOut {
    static constexpr bool PERM = false, MID = true;
    const float* x; float* x1; const float* mod; const float* ssq; float* x1ssq;
    __device__ __forceinline__ void rowscale(int row, float& ra, float& rb) const {
        const f32x4* s = (const f32x4*)(ssq + (size_t)row * 16);
        const f32x4 a0 = s[0], a1 = s[1], b0 = s[2], b1 = s[3];
        const float sa = (a0[0] + a0[1]) + (a0[2] + a0[3]) + (a1[0] + a1[1]) + (a1[2] + a1[3]);
        const float sb = (b0[0] + b0[1]) + (b0[2] + b0[3]) + (b1[0] + b1[1]) + (b1[2] + b1[3]);
        ra = 1.f / sqrtf(sa * (1.f / 512.f) + EPS); rb = 1.f / sqrtf(sb * (1.f / 512.f) + EPS);
    }
    __device__ __forceinline__ void mid(f32x4 (&acc)[2][2][4][2], const pg8::Unit& u, int wr, int fr_) const {
        int fr = fr_; asm volatile("" : "+v"(fr));
#pragma unroll
        for (int ai = 0; ai < 2; ++ai)
#pragma unroll
            for (int m = 0; m < 4; ++m) {
                float ra, rb; rowscale(u.pm * 256 + ai * 128 + wr * 64 + m * 16 + fr, ra, rb);
                const float f = ra / rb;
#pragma unroll
                for (int bj = 0; bj < 2; ++bj)
#pragma unroll
                    for (int n = 0; n < 2; ++n) acc[ai][bj][m][n] = acc[ai][bj][m][n] * f;
            }
    }
    __device__ __forceinline__ void operator()(const f32x4 (&acc)[2][2][4][2], const pg8::Unit& u, int wr, int wc, int fr_, int fq_) const {
        int fr = fr_, fq = fq_; asm volatile("" : "+v"(fr), "+v"(fq));
        const int col0 = u.pn * 256 + wc * 32 + 4 * fq;
#pragma unroll
        for (int ai = 0; ai < 2; ++ai)
#pragma unroll
            for (int m = 0; m < 4; ++m) {
                const int row = u.pm * 256 + ai * 128 + wr * 64 + m * 16 + fr, b = row >> 11;
                float ra, rb; rowscale(row, ra, rb);
                float q = 0.f;
#pragma unroll
                for (int bj = 0; bj < 2; ++bj)
#pragma unroll
                    for (int n = 0; n < 2; ++n) {
                        const int col = col0 + bj * 128 + n * 16;
                        const f32x4 xv = *(const f32x4*)(x + (size_t)row * DM + col), gm = *(const f32x4*)(mod + b * NMOD + 2 * DM + col);
                        const f32x4 o = xv + gm * (acc[ai][bj][m][n] * rb);
                        *(f32x4*)(x1 + (size_t)row * DM + col) = o;
                        q += (o[0] * o[0] + o[1] * o[1]) + (o[2] * o[2] + o[3] * o[3]);
                    }
                q += __shfl_xor(q, 16); q += __shfl_xor(q, 32);
                if (fq == 0) x1ssq[(size_t)row * 16 + u.pn * 4 + wc] = q;
            }
    }
};

struct EpiAct {
    static constexpr bool PERM = true, MID = false;
    bf16_t* act; const int* list; const float* rw;
    __device__ __forceinline__ void operator()(const f32x4 (&acc)[2][2][4][2], const pg8::Unit& u, int wr, int wc, int fr_, int fq_) const {
        int fr = fr_, fq = fq_; asm volatile("" : "+v"(fr), "+v"(fq));
        const int col0 = u.pn * 128 + wc * 32 + 8 * fq;
#pragma unroll
        for (int ai = 0; ai < 2; ++ai)
#pragma unroll
            for (int m = 0; m < 4; ++m) {
                const int rl = ai * 128 + wr * 64 + m * 16 + fr;
                float w = 0.f;
                if (u.r0 + rl < u.cnt) w = rw[list[u.e * 16384 + u.r0 + rl]];
                f32x4 o[2];
#pragma unroll
                for (int n = 0; n < 2; ++n)
#pragma unroll
                    for (int i = 0; i < 4; ++i) { const float gv = acc[ai][0][m][n][i], uv = acc[ai][1][m][n][i]; o[n][i] = gv / (1.f + __expf(-gv)) * uv * w; }
                u32x4 pk; pk.x = cvt_pk_bf16(o[0][0], o[0][1]); pk.y = cvt_pk_bf16(o[0][2], o[0][3]); pk.z = cvt_pk_bf16(o[1][0], o[1][1]); pk.w = cvt_pk_bf16(o[1][2], o[1][3]);
                *(u32x4*)(act + ((size_t)u.pm * 256 + rl) * 256 + col0) = pk;
            }
    }
};

struct EpiDown {
    static constexpr bool PERM = true, MID = false;
    bf16_t* y; const int* list;
    __device__ __forceinline__ void operator()(const f32x4 (&acc)[2][2][4][2], const pg8::Unit& u, int wr, int wc, int fr_, int fq_) const {
        int fr = fr_, fq = fq_; asm volatile("" : "+v"(fr), "+v"(fq));
        const int col0 = u.pn * 256 + wc * 32 + 8 * fq;
#pragma unroll
        for (int ai = 0; ai < 2; ++ai)
#pragma unroll
            for (int m = 0; m < 4; ++m) {
                const int rl = ai * 128 + wr * 64 + m * 16 + fr;
                if (u.r0 + rl < u.cnt) {
                    const int slot = list[u.e * 16384 + u.r0 + rl];
#pragma unroll
                    for (int bj = 0; bj < 2; ++bj) {
                        const f32x4 v0 = acc[ai][bj][m][0], v1 = acc[ai][bj][m][1];
                        u32x4 pk; pk.x = cvt_pk_bf16(v0[0], v0[1]); pk.y = cvt_pk_bf16(v0[2], v0[3]); pk.z = cvt_pk_bf16(v1[0], v1[1]); pk.w = cvt_pk_bf16(v1[2], v1[3]);
                        *(u32x4*)(y + (size_t)slot * DM + col0 + bj * 128) = pk;
                    }
                }
            }
    }
};

struct MoeOrder {
    const int* cnt; const int* list; int NN, G, c; size_t a_tile, b_exp, b_tile; bool gather;
    __device__ bool next(int i, pg8::Unit& u) const {
        const int L = i * G + c, tau = L / NN, pn = L - tau * NN;
        int base = 0, e = 0, ce = 0;
        for (; e < NEXP; ++e) { ce = cnt[e * 64]; const int nt_ = (ce + 255) >> 8; if (tau < base + nt_) break; base += nt_; }
        if (e >= NEXP) return false;
        u.pm = tau; u.pn = pn; u.e = e; u.r0 = (tau - base) * 256; u.cnt = ce;
        u.aoff = gather ? 0 : (size_t)tau * a_tile; u.boff = (size_t)e * b_exp + (size_t)pn * b_tile; return true;
    }
    __device__ __forceinline__ unsigned arow(const pg8::Unit& u, int R) const {
        int r = u.r0 + R; if (r >= u.cnt) r = u.cnt - 1;
        return (unsigned)(list[u.e * 16384 + r] >> 1);
    }
};
constexpr int AT_K = 0, AT_V = 16384, AT_CUM = 32768, AT_WSF = 40960, AT_OST = 43008, AT_END = 43008 + 32768;
__device__ __forceinline__ int crow(int r, int hi) { return (r & 3) + 8 * (r >> 2) + 4 * hi; }
typedef short v4i16_t __attribute__((ext_vector_type(4)));
__device__ __forceinline__ v4i16_t vtr(const LAS unsigned char* p) { return __builtin_amdgcn_ds_read_tr16_b64_v4i16((LAS v4i16_t*)p); }

template <int MODE>
__device__ __forceinline__ void attn_unit(const Params& p, int b, int h, int qb, LAS unsigned char* lds) {
    int tid_ = threadIdx.x; asm volatile("" : "+v"(tid_)); const int tid = tid_, lane = tid & 63, r32 = lane & 31, hi = lane >> 5, wid = __builtin_amdgcn_readfirstlane(tid >> 6);
    const bf16_t* proj = (const bf16_t*)(p.ws + WS_PROJ);
    const int rowbase = b * SEQ, q0 = qb * 256;
    const int qcol = (MODE == 0 ? C_BQ : C_AQ) + h * 64;
    const int kcol = (MODE == 0 ? C_BK + h * 64 : C_AK + (h >> 2) * 64);
    const int vcol = (MODE == 0 ? C_BV + h * 64 : C_AV + (h >> 2) * 64);
    const int NT = (q0 + 256) / 64;
    LAS float* cumk = (LAS float*)(lds + AT_CUM);
    LAS float* wsf = (LAS float*)(lds + AT_WSF) + wid * 64;
    if (MODE == 0) {
        const float* lf = (const float*)(p.ws + WS_LOGF);
        const int NK = q0 + 256;
        float v[4]; float run = 0.f;
#pragma unroll
        for (int i = 0; i < 4; ++i) { const int s = 4 * tid + i; const float x = (s < NK) ? lf[(size_t)(rowbase + s) * 8 + h] : 0.f; run += x; v[i] = run; }
        float inc = run;
#pragma unroll
        for (int o = 1; o < 64; o <<= 1) { const float t = __shfl_up(inc, o); if (lane >= o) inc += t; }
        LAS float* wt = (LAS float*)(lds + AT_WSF);
        if (lane == 63) wt[wid] = inc;
        __syncthreads();
        float pre = inc - run;
        for (int w = 0; w < wid; ++w) pre += wt[w];
#pragma unroll
        for (int i = 0; i < 4; ++i) cumk[4 * tid + i] = -(pre + v[i]) * LOG2E;
        __syncthreads();
    }
    const float slope2 = (MODE == 1) ? exp2f(-(float)(h + 1)) * LOG2E : 0.f;
    const bf16_t* ksrc = proj + (size_t)(rowbase + lane) * NPROJ + kcol + wid * 8;
    const bf16_t* vsrc = proj + (size_t)(rowbase + 16 * (wid & 3) + (lane >> 2)) * NPROJ + vcol + (wid >> 2) * 32 + (lane & 3) * 8;
    const int stoff = wid * 1024 + lane * 16;
    u32x4 kreg = *(const u32x4*)ksrc, vreg = *(const u32x4*)vsrc;
    const int qrow = q0 + wid * 32 + r32;
    bf16x8 qr[4];
    {
        const bf16_t* qp = proj + (size_t)(rowbase + qrow) * NPROJ + qcol + hi * 8;
#pragma unroll
        for (int d0 = 0; d0 < 4; ++d0) qr[d0] = *(const bf16x8*)(qp + d0 * 16);
    }
    const unsigned* mrow = (const unsigned*)(p.ws + WS_MASK) + (size_t)(rowbase + qrow) * 64;
    *(LAS u32x4*)(lds + AT_K + stoff) = kreg; *(LAS u32x4*)(lds + AT_V + stoff) = vreg;
    __syncthreads();
    float m_run = -1e30f, l_run = 0.f;
    f32x16 o[2]; o[0] = f32x16{}; o[1] = f32x16{};
    const int wq_lo = q0 + wid * 32;
    for (int t = 0; t < NT; ++t) {
        const int cur = t & 1;
        if (t + 1 < NT) { kreg = *(const u32x4*)(ksrc + (size_t)(t + 1) * 64 * NPROJ); vreg = *(const u32x4*)(vsrc + (size_t)(t + 1) * 64 * NPROJ); }
        const int kv0 = 64 * t;
        if (kv0 <= wq_lo + 31) {
            u32x2 mw = (u32x2){0u, 0u};
            if (MODE == 1) mw = *(const u32x2*)(mrow + 2 * t);
            const LAS unsigned char* kb = lds + AT_K + cur * 8192 + hi * 1024 + r32 * 16;
            f32x16 p0 = f32x16{}, p1 = f32x16{};
#pragma unroll
            for (int d0 = 0; d0 < 4; ++d0) {
                const bf16x8 b0 = *(const LAS bf16x8*)(kb + d0 * 2048), b1 = *(const LAS bf16x8*)(kb + d0 * 2048 + 512);
                p0 = __builtin_amdgcn_mfma_f32_32x32x16_bf16(b0, qr[d0], p0, 0, 0, 0);
                p1 = __builtin_amdgcn_mfma_f32_32x32x16_bf16(b1, qr[d0], p1, 0, 0, 0);
            }
            if (MODE == 0) {
#pragma unroll
                for (int g4 = 0; g4 < 4; ++g4) {
                    const f32x4 c0 = *(const LAS f32x4*)(cumk + kv0 + 8 * g4 + 4 * hi), c1 = *(const LAS f32x4*)(cumk + kv0 + 32 + 8 * g4 + 4 * hi);
#pragma unroll
                    for (int i = 0; i < 4; ++i) { p0[4 * g4 + i] += c0[i]; p1[4 * g4 + i] += c1[i]; }
                }
                if (kv0 + 63 > wq_lo) {
#pragma unroll
                    for (int r = 0; r < 16; ++r) { const int kv = kv0 + crow(r, hi); if (kv > qrow) p0[r] = -INFINITY; if (kv + 32 > qrow) p1[r] = -INFINITY; }
                }
            } else {
#pragma unroll
                for (int r = 0; r < 16; ++r) {
                    const int cr = crow(r, hi);
                    p0[r] = ((mw.x >> cr) & 1u) ? p0[r] + slope2 * (float)(kv0 + cr) : -INFINITY;
                    p1[r] = ((mw.y >> cr) & 1u) ? p1[r] + slope2 * (float)(kv0 + 32 + cr) : -INFINITY;
                }
            }
            float rm = fmaxf(p0[0], p1[0]);
#pragma unroll
            for (int r = 1; r < 16; ++r) rm = fmaxf(rm, fmaxf(p0[r], p1[r]));
            rm = fmaxf(rm, __shfl_xor(rm, 32));
            const float m_new = fmaxf(m_run, rm);
            const float f = exp2f(m_run - m_new);
            m_run = m_new;
            float ls = 0.f;
#pragma unroll
            for (int r = 0; r < 16; ++r) { p0[r] = __builtin_amdgcn_exp2f(p0[r] - m_new); p1[r] = __builtin_amdgcn_exp2f(p1[r] - m_new); ls += p0[r] + p1[r]; }
            l_run = l_run * f + ls;
            if (__any(f != 1.f)) {
                if (hi == 0) wsf[r32] = f;
#pragma unroll
                for (int g4 = 0; g4 < 4; ++g4) {
                    const f32x4 fv = *(const LAS f32x4*)(wsf + 8 * g4 + 4 * hi);
#pragma unroll
                    for (int i = 0; i < 4; ++i) { o[0][4 * g4 + i] *= fv[i]; o[1][4 * g4 + i] *= fv[i]; }
                }
            }
            bf16x8 pa[4];
#pragma unroll
            for (int s = 0; s < 4; ++s) {
                u32x4 w;
                if (s < 2) { w.x = pg8::cvt_pk_bf16(p0[8 * s + 0], p0[8 * s + 1]); w.y = pg8::cvt_pk_bf16(p0[8 * s + 2], p0[8 * s + 3]); w.z = pg8::cvt_pk_bf16(p0[8 * s + 4], p0[8 * s + 5]); w.w = pg8::cvt_pk_bf16(p0[8 * s + 6], p0[8 * s + 7]); }
                else { const int q = s - 2; w.x = pg8::cvt_pk_bf16(p1[8 * q + 0], p1[8 * q + 1]); w.y = pg8::cvt_pk_bf16(p1[8 * q + 2], p1[8 * q + 3]); w.z = pg8::cvt_pk_bf16(p1[8 * q + 4], p1[8 * q + 5]); w.w = pg8::cvt_pk_bf16(p1[8 * q + 6], p1[8 * q + 7]); }
                pa[s] = __builtin_bit_cast(bf16x8, w);
            }
            const LAS unsigned char* vp = lds + AT_V + cur * 8192 + ((lane >> 4) & 1) * 32 + (lane & 3) * 8 + (4 * hi + ((lane & 15) >> 2)) * 64;
#pragma unroll
            for (int d0 = 0; d0 < 2; ++d0)
#pragma unroll
                for (int ks = 0; ks < 4; ++ks) {
                    const v4i16_t lo = vtr(vp + d0 * 4096 + ks * 1024), hh = vtr(vp + d0 * 4096 + ks * 1024 + 512);
                    const bf16x8 vf = (bf16x8){lo[0], lo[1], lo[2], lo[3], hh[0], hh[1], hh[2], hh[3]};
                    o[d0] = __builtin_amdgcn_mfma_f32_32x32x16_bf16(pa[ks], vf, o[d0], 0, 0, 0);
                }
        }
        if (t + 1 < NT) { *(LAS u32x4*)(lds + AT_K + (cur ^ 1) * 8192 + stoff) = kreg; *(LAS u32x4*)(lds + AT_V + (cur ^ 1) * 8192 + stoff) = vreg; }
        __syncthreads();
    }
    l_run += __shfl_xor(l_run, 32);
    if (hi == 0) wsf[32 + r32] = l_run;
    float rli[16];
#pragma unroll
    for (int g4 = 0; g4 < 4; ++g4) {
        const f32x4 lv = *(const LAS f32x4*)(wsf + 32 + 8 * g4 + 4 * hi);
#pragma unroll
        for (int i = 0; i < 4; ++i) rli[4 * g4 + i] = 1.f / lv[i];
    }
    LAS bf16_t* stg = (LAS bf16_t*)(lds + AT_OST) + wid * 2048;
#pragma unroll
    for (int r = 0; r < 16; ++r) {
        const int orow = crow(r, hi);
#pragma unroll
        for (int d0 = 0; d0 < 2; ++d0) stg[orow * 64 + d0 * 32 + r32] = (bf16_t)f2bf(o[d0][r] * rli[r]);
    }
    bf16_t* O = (bf16_t*)(p.ws + WS_O);
    float* ssq = (float*)(p.ws + WS_SSQ);
    const int ocol = (MODE == 1 ? 0 : 512) + h * 64, slot = (MODE == 1 ? 0 : 8) + h;
#pragma unroll
    for (int i = 0; i < 4; ++i) {
        const int row = i * 8 + (lane >> 3), ch = lane & 7;
        const u32x4 v = *(const LAS u32x4*)(stg + row * 64 + ch * 8);
        const size_t grow = (size_t)(rowbase + q0 + wid * 32 + row);
        *(u32x4*)(O + grow * DM + ocol + ch * 8) = v;
        float q = 0.f;
#pragma unroll
        for (int j = 0; j < 4; ++j) { const float a = bf2f((unsigned short)(v[j] & 0xffff)), c = bf2f((unsigned short)(v[j] >> 16)); q += a * a + c * c; }
        q += __shfl_xor(q, 1); q += __shfl_xor(q, 2); q += __shfl_xor(q, 4);
        if (ch == 0) ssq[grow * 16 + slot] = q;
    }
    __syncthreads();
}
constexpr int IX_SC = 0, IX_HIST = 65536, IX_CAND = 98304, IX_END = 98304 + 2048;
__device__ __forceinline__ float wave_maxf(float v) {
#pragma unroll
    for (int o = 1; o < 64; o <<= 1) v = fmaxf(v, __shfl_xor(v, o));
    return v;
}
__device__ __forceinline__ float wave_minf(float v) {
#pragma unroll
    for (int o = 1; o < 64; o <<= 1) v = fminf(v, __shfl_xor(v, o));
    return v;
}
__device__ __forceinline__ void indexer_unit(const Params& p, int b, int t0, LAS unsigned char* lds) {
    int tid_ = threadIdx.x; asm volatile("" : "+v"(tid_)); const int tid = tid_, lane = tid & 63, r32 = lane & 31, hi = lane >> 5, wid = __builtin_amdgcn_readfirstlane(tid >> 6);
    const bf16_t* proj = (const bf16_t*)(p.ws + WS_PROJ);
    const float* iwp = (const float*)(p.ws + WS_IW);
    const int rowbase = b * SEQ;
    LAS float* sc = (LAS float*)(lds + IX_SC);
    bf16x8 aq[2][4]; float wq[2][2][8];
    {
        const int i = r32, qi = 2 * ((i >> 2) & 1) + (i >> 4), head = 4 * ((i >> 3) & 1) + (i & 3);
#pragma unroll
        for (int g = 0; g < 2; ++g) {
            const bf16_t* ap = proj + (size_t)(rowbase + t0 + 4 * g + qi) * NPROJ + C_IQ + head * 64 + hi * 8;
#pragma unroll
            for (int d0 = 0; d0 < 4; ++d0) aq[g][d0] = *(const bf16x8*)(ap + d0 * 16);
#pragma unroll
            for (int a = 0; a < 2; ++a) {
                const float* wp = iwp + (size_t)(rowbase + t0 + 4 * g + 2 * hi + a) * 8;
                const f32x4 w0 = *(const f32x4*)wp, w1 = *(const f32x4*)(wp + 4);
#pragma unroll
                for (int j = 0; j < 4; ++j) { wq[g][a][j] = w0[j]; wq[g][a][4 + j] = w1[j]; }
            }
        }
    }
    const int NTI = (t0 + 7) / 32 + 1;
    for (int j = wid; j < NTI; j += 8) {
        const int key = 32 * j + r32;
        const bf16_t* kp = proj + (size_t)(rowbase + key) * NPROJ + C_IK + hi * 8;
        bf16x8 kf[4];
#pragma unroll
        for (int d0 = 0; d0 < 4; ++d0) kf[d0] = *(const bf16x8*)(kp + d0 * 16);
#pragma unroll
        for (int g = 0; g < 2; ++g) {
            f32x16 d = f32x16{};
#pragma unroll
            for (int d0 = 0; d0 < 4; ++d0) d = __builtin_amdgcn_mfma_f32_32x32x16_bf16(aq[g][d0], kf[d0], d, 0, 0, 0);
#pragma unroll
            for (int a = 0; a < 2; ++a) {
                float s = 0.f;
#pragma unroll
                for (int hh = 0; hh < 8; ++hh) s += wq[g][a][hh] * fmaxf(d[8 * a + hh], 0.f);
                sc[(4 * g + 2 * hi + a) * 2048 + key] = s;
            }
        }
    }
    __syncthreads();
    {
        const int t = t0 + wid, n = t + 1;
        LAS unsigned* hist = (LAS unsigned*)(lds + IX_HIST) + wid * 1024;
        LAS float* cand = (LAS float*)(lds + IX_CAND) + wid * 64;
        const LAS float* myv = sc + wid * 2048;
        float val[32];
#pragma unroll
        for (int i = 0; i < 32; ++i) { const int key = 64 * i + lane; val[i] = (key < n) ? myv[key] : -INFINITY; }
        float vmax = -INFINITY, vmin = INFINITY;
#pragma unroll
        for (int i = 0; i < 32; ++i) { vmax = fmaxf(vmax, val[i]); vmin = fminf(vmin, (64 * i + lane < n) ? val[i] : INFINITY); }
        float lo = wave_minf(vmin), hiv = wave_maxf(vmax);
        int k = 256; float vstar = lo; int rprime = 256;
        const unsigned long long ltmask = (lane == 0) ? 0ull : (~0ull >> (64 - lane));
        for (int iter = 0; iter < 64; ++iter) {
            if (!(hiv > lo)) { vstar = lo; rprime = k; break; }
            const float scale = 1024.f / (hiv - lo);
#pragma unroll
            for (int q = 0; q < 4; ++q) *(LAS u32x4*)(hist + 16 * lane + 4 * q) = (u32x4){0u, 0u, 0u, 0u};
#pragma unroll
            for (int i = 0; i < 32; ++i) {
                const float v = val[i];
                if (v >= lo && v <= hiv) { int bin = (int)((v - lo) * scale); bin = bin > 1023 ? 1023 : bin; __hip_atomic_fetch_add(hist + bin, 1u, __ATOMIC_RELAXED, __HIP_MEMORY_SCOPE_WORKGROUP); }
            }
            unsigned hb[16]; unsigned s = 0;
#pragma unroll
            for (int q = 0; q < 4; ++q) { const u32x4 x = *(const LAS u32x4*)(hist + 16 * lane + 4 * q); hb[4 * q] = x[0]; hb[4 * q + 1] = x[1]; hb[4 * q + 2] = x[2]; hb[4 * q + 3] = x[3]; s += x[0] + x[1] + x[2] + x[3]; }
            unsigned inc = s;
#pragma unroll
            for (int o = 1; o < 64; o <<= 1) { const unsigned tt = __shfl_down(inc, o); if (lane + o < 64) inc += tt; }
            const int above = (int)(inc - s);
            const bool here = (above < k) && (k <= above + (int)s);
            const unsigned long long hm = __ballot(here);
            const int L = hm ? (__ffsll((long long)hm) - 1) : 0;
            int a = above, bsel = -1, asel = 0, csel = 0;
#pragma unroll
            for (int jj = 15; jj >= 0; --jj) { if (bsel < 0 && a + (int)hb[jj] >= k) { bsel = jj; asel = a; csel = (int)hb[jj]; } a += (int)hb[jj]; }
            const int Bs = 16 * L + __shfl(bsel, L), ab = __shfl(asel, L), c = __shfl(csel, L);
            k -= ab;
            if (c <= 64) {
                int base = 0;
#pragma unroll
                for (int i = 0; i < 32; ++i) {
                    const float v = val[i]; bool isc = false;
                    if (v >= lo && v <= hiv) { int bin = (int)((v - lo) * scale); bin = bin > 1023 ? 1023 : bin; isc = (bin == Bs); }
                    const unsigned long long cm = __ballot(isc);
                    if (isc) cand[base + __popcll(cm & ltmask)] = v;
                    base += __popcll(cm);
                }
                const float mine = (lane < c) ? cand[lane] : -INFINITY;
                int gt = 0, ge = 0;
                for (int jj = 0; jj < c; ++jj) { const float x = cand[jj]; gt += (x > mine) ? 1 : 0; ge += (x >= mine) ? 1 : 0; }
                const bool ok = (lane < c) && (gt < k) && (k <= ge);
                const unsigned long long om = __ballot(ok);
                const int L2 = om ? (__ffsll((long long)om) - 1) : 0;
                vstar = __shfl(mine, L2); rprime = k - __shfl(gt, L2);
                break;
            } else {
                float cmin = INFINITY, cmax = -INFINITY;
#pragma unroll
                for (int i = 0; i < 32; ++i) {
                    const float v = val[i];
                    if (v >= lo && v <= hiv) { int bin = (int)((v - lo) * scale); bin = bin > 1023 ? 1023 : bin; if (bin == Bs) { cmin = fminf(cmin, v); cmax = fmaxf(cmax, v); } }
                }
                lo = wave_minf(cmin); hiv = wave_maxf(cmax);
                vstar = lo; rprime = k;
            }
        }
        unsigned* mrow = (unsigned*)(p.ws + WS_MASK) + (size_t)(rowbase + t) * 64;
        int run = 0;
#pragma unroll
        for (int i = 0; i < 32; ++i) {
            const float v = val[i];
            const bool eq = (v == vstar);
            const unsigned long long em = __ballot(eq);
            const bool sel = (v > vstar) || (eq && (run + __popcll(em & ltmask)) < rprime);
            run += __popcll(em);
            const unsigned long long sm = __ballot(sel);
            if (lane == 0) { mrow[2 * i] = (unsigned)sm; mrow[2 * i + 1] = (unsigned)(sm >> 32); }
        }
    }
    __syncthreads();
}

__device__ __forceinline__ void trivial_mask_rows(const Params& p) {
    unsigned* mask = (unsigned*)(p.ws + WS_MASK);
    const int G = gridDim.x;
    for (int i = blockIdx.x * 512 + threadIdx.x; i < BATCH * 256 * 64; i += G * 512) {
        const int w = i & 63, t = (i >> 6) & 255, b = i >> 14;
        unsigned v;
        if (32 * w + 31 <= t) v = 0xffffffffu; else if (32 * w > t) v = 0u; else v = (1u << (t - 32 * w + 1)) - 1u;
        mask[(size_t)(b * SEQ + t) * 64 + w] = v;
    }
}
constexpr int RT_LG = 0;
__device__ __forceinline__ void router_phase(const Params& p, LAS unsigned char* lds) {
    int tid_ = threadIdx.x; asm volatile("" : "+v"(tid_)); const int tid = tid_, lane = tid & 63, wid = __builtin_amdgcn_readfirstlane(tid >> 6), G = gridDim.x;
    const float* x1 = p.out; const float* x1ssq = (const float*)(p.ws + WS_X1SSQ); const float* mod2 = (const float*)(p.ws + WS_MOD2);
    bf16_t* H2 = (bf16_t*)(p.ws + WS_H);
    const bf16_t* wrh = (const bf16_t*)(p.ws + WS_WR); const bf16_t* wrl = wrh + 48 * 1024;
    unsigned* cnt = (unsigned*)(p.ws + WS_CNT); int* list = (int*)(p.ws + WS_LIST); float* rw = (float*)(p.ws + WS_RW);
    LAS float* lg = (LAS float*)(lds + RT_LG + wid * 3072);
    const int row = lane & 15, kq = lane >> 4;
    for (int wu = wid * G + blockIdx.x; wu < NTOK / 16; wu += 8 * G) {
        const int tok = 16 * wu + row, b = tok >> 11;
        float rstd;
        {
            const f32x4* s = (const f32x4*)(x1ssq + (size_t)tok * 16);
            const f32x4 a = s[0], c = s[1], d = s[2], e = s[3];
            const float q = ((a[0] + a[1]) + (a[2] + a[3])) + ((c[0] + c[1]) + (c[2] + c[3])) + ((d[0] + d[1]) + (d[2] + d[3])) + ((e[0] + e[1]) + (e[2] + e[3]));
            rstd = 1.f / sqrtf(q * (1.f / DM) + EPS);
        }
        f32x4 acc[3]; acc[0] = f32x4{}; acc[1] = f32x4{}; acc[2] = f32x4{};
        const float* xr = x1 + (size_t)tok * DM + 8 * kq;
        const float* ma = mod2 + (size_t)(b * 2) * 1024 + 8 * kq; const float* mc = ma + 1024;
        bf16_t* hr = H2 + (size_t)tok * DM + 8 * kq;
        const bf16_t* bh = wrh + (size_t)row * 1024 + 8 * kq; const bf16_t* bl = wrl + (size_t)row * 1024 + 8 * kq;
#pragma unroll 2
        for (int s = 0; s < 32; ++s) {
            const int k = 32 * s;
            const f32x4 xa = *(const f32x4*)(xr + k), xb = *(const f32x4*)(xr + k + 4);
            const f32x4 aa = *(const f32x4*)(ma + k), ab = *(const f32x4*)(ma + k + 4), ca = *(const f32x4*)(mc + k), cb = *(const f32x4*)(mc + k + 4);
            const f32x4 ha = xa * rstd * aa + ca, hb = xb * rstd * ab + cb;
            u32x4 w; w.x = pg8::cvt_pk_bf16(ha[0], ha[1]); w.y = pg8::cvt_pk_bf16(ha[2], ha[3]); w.z = pg8::cvt_pk_bf16(hb[0], hb[1]); w.w = pg8::cvt_pk_bf16(hb[2], hb[3]);
            *(u32x4*)(hr + k) = w;
            const bf16x8 af = __builtin_bit_cast(bf16x8, w);
#pragma unroll
            for (int nb = 0; nb < 3; ++nb) {
                const bf16x8 fh = *(const bf16x8*)(bh + (size_t)nb * 16 * 1024 + k), fl = *(const bf16x8*)(bl + (size_t)nb * 16 * 1024 + k);
                acc[nb] = __builtin_amdgcn_mfma_f32_16x16x32_bf16(af, fh, acc[nb], 0, 0, 0);
                acc[nb] = __builtin_amdgcn_mfma_f32_16x16x32_bf16(af, fl, acc[nb], 0, 0, 0);
            }
        }
#pragma unroll
        for (int nb = 0; nb < 3; ++nb)
#pragma unroll
            for (int i = 0; i < 4; ++i) lg[(4 * kq + i) * 48 + 16 * nb + row] = acc[nb][i];
        if (lane < 16) {
            const int tk = 16 * wu + lane;
            float gl[4]; int gs = 0; float gmax;
#pragma unroll
            for (int j = 0; j < 4; ++j) gl[j] = lg[lane * 48 + j] + p.b_group[j];
            gmax = gl[0];
#pragma unroll
            for (int j = 1; j < 4; ++j) if (gl[j] > gmax) { gmax = gl[j]; gs = j; }
            float den = 0.f;
#pragma unroll
            for (int j = 0; j < 4; ++j) den += __expf(gl[j] - gmax);
            const float pg = 1.f / den;
            float v1 = -INFINITY, v2 = -INFINITY; int i1 = 0, i2 = 0;
#pragma unroll
            for (int j = 0; j < 8; ++j) {
                const float ev = lg[lane * 48 + 16 + 8 * gs + j] + p.b_router[gs * 8 + j];
                if (ev > v1) { v2 = v1; i2 = i1; v1 = ev; i1 = j; } else if (ev > v2) { v2 = ev; i2 = j; }
            }
            const float e2 = __expf(v2 - v1);
            const float w1 = pg / (1.f + e2), w2 = pg * e2 / (1.f + e2);
            const int ea = gs * 8 + i1, eb = gs * 8 + i2;
            const unsigned sa = atomicAdd(cnt + ea * 64, 1u), sb = atomicAdd(cnt + eb * 64, 1u);
            list[ea * 16384 + sa] = tk * 2; list[eb * 16384 + sb] = tk * 2 + 1;
            rw[tk * 2] = w1; rw[tk * 2 + 1] = w2;
        }
    }
}
__device__ __forceinline__ void phase1_inproj(const Params& p, LAS unsigned char* lds) {
    pg8::Gemm g{(const bf16_t*)(p.ws + WS_H), (const bf16_t*)(p.ws + WS_WIN), 1024};
    pg8::StaticOrder S; S.init(NTOK, NPROJ, 1024, gridDim.x, blockIdx.x);
    EpiProj E{(bf16_t*)(p.ws + WS_PROJ), (float*)(p.ws + WS_IW), (float*)(p.ws + WS_LOGF), p.b_forget};
    pg8::gemm_phase<EpiProj, pg8::StaticOrder, false>(lds, g, S, E);
}
__device__ __forceinline__ int vcu_of(int G) { const int bx = blockIdx.x; return (G % 8 == 0) ? (bx % 8) * (G / 8) + bx / 8 : bx; }
template <int MODE> __device__ __forceinline__ void attn_phase(const Params& p, LAS unsigned char* lds) {
    const int G = gridDim.x;
    for (int v = vcu_of(G); v < 256; v += G) {
        const int bh = v >> 2, s = v & 3;
        attn_unit<MODE>(p, bh >> 3, bh & 7, 7 - s, lds);
        attn_unit<MODE>(p, bh >> 3, bh & 7, s, lds);
    }
}
__device__ __forceinline__ void indexer_phase(const Params& p, LAS unsigned char* lds) {
    const int G = gridDim.x;
    for (int v = vcu_of(G); v < 256; v += G) {
        const int b = v >> 5, j = v & 31;
        for (int i = 6; i >= 0; --i) {
            const int qg = 32 + 32 * i + ((i & 1) ? 31 - j : j);
            indexer_unit(p, b, 8 * qg, lds);
        }
    }
    trivial_mask_rows(p);
}
__device__ __forceinline__ void phase4_outproj(const Params& p, LAS unsigned char* lds) {
    pg8::Gemm g{(const bf16_t*)(p.ws + WS_O), (const bf16_t*)(p.ws + WS_WOUT), 1024};
    pg8::StaticOrder S; S.init(NTOK, DM, 1024, gridDim.x, blockIdx.x);
    EpiOut E{p.x, p.out, (const float*)(p.ws + WS_MOD), (const float*)(p.ws + WS_SSQ), (float*)(p.ws + WS_X1SSQ)};
    pg8::gemm_phase<EpiOut, pg8::StaticOrder, false>(lds, g, S, E);
}
__device__ __forceinline__ void phase6_moe_up(const Params& p, LAS unsigned char* lds) {
    pg8::Gemm g{(const bf16_t*)(p.ws + WS_H), (const bf16_t*)(p.ws + WS_WGU), 1024};
    MoeOrder S{(const int*)(p.ws + WS_CNT), (const int*)(p.ws + WS_LIST), 2, (int)gridDim.x, (int)blockIdx.x, 0, (size_t)512 * 1024 * 2, (size_t)256 * 1024 * 2, true};
    EpiAct E{(bf16_t*)(p.ws + WS_ACT), (const int*)(p.ws + WS_LIST), (const float*)(p.ws + WS_RW)};
    pg8::gemm_phase<EpiAct, MoeOrder, true>(lds, g, S, E);
}
__device__ __forceinline__ void phase7_moe_down(const Params& p, LAS unsigned char* lds) {
    pg8::Gemm g{(const bf16_t*)(p.ws + WS_ACT), (const bf16_t*)(p.ws + WS_WD), 256};
    MoeOrder S{(const int*)(p.ws + WS_CNT), (const int*)(p.ws + WS_LIST), 4, (int)gridDim.x, (int)blockIdx.x, (size_t)256 * 256 * 2, (size_t)1024 * 256 * 2, (size_t)256 * 256 * 2, false};
    EpiDown E{(bf16_t*)(p.ws + WS_Y), (const int*)(p.ws + WS_LIST)};
    pg8::gemm_phase<EpiDown, MoeOrder, false>(lds, g, S, E);
}

__global__ void __launch_bounds__(512, 2) mega(Params p) {
    extern __shared__ __attribute__((aligned(16))) unsigned char lds_raw[];
    LAS unsigned char* lds = (LAS unsigned char*)lds_raw;
    cg::grid_group grid = cg::this_grid();
    if (p.ws == nullptr) grid.sync();
    volatile LAS unsigned* st = (volatile LAS unsigned*)(lds + LDS_BYTES - 64);
    if (threadIdx.x < 2) st[threadIdx.x] = 0u;
    __syncthreads();
    const XcdBarrier bar = xcd_barrier_post((unsigned*)(p.ws + WS_BAR), st);
#define GSYNC() xcd_barrier(bar)
#ifndef REP_MASK
#define REP_MASK 0
#endif
#define REP(bit) for (int rep_ = 0; rep_ < (((REP_MASK) & (bit)) ? 2 : 1); ++rep_)
    REP(1) phase0(p, lds);
    GSYNC();
    REP(2) phase0b(p);
    GSYNC();
#if (REP_MASK) & 512
    for (int q_ = 0; q_ < 9; ++q_) GSYNC();
#endif
    REP(4) phase1_inproj(p, lds);
    GSYNC();
    REP(8) attn_phase<0>(p, lds);
    REP(16) indexer_phase(p, lds);
    GSYNC();
    REP(32) attn_phase<1>(p, lds);
    GSYNC();
    REP(64) phase4_outproj(p, lds);
    GSYNC();
    router_phase(p, lds);
    GSYNC();
    REP(128) phase6_moe_up(p, lds);
    GSYNC();
    REP(256) phase7_moe_down(p, lds);
    GSYNC();
    phase_final(p, false);
}

extern "C" void kernel_launch(void* const* d_in, const int* in_sizes, int n_in, void* d_out, int out_size, void* d_ws, size_t ws_size, hipStream_t stream) {
    static int grid = 0;
    if (grid == 0) {
        if (n_in != 19 || out_size != NTOK * DM || ws_size < WS_END) { fprintf(stderr, "kernel_launch: unexpected problem (n_in %d out %d ws %zu)\n", n_in, out_size, ws_size); grid = -1; return; }
        int dev = 0, cus = 0, per_cu = 0;
        (void)hipGetDevice(&dev);
        (void)hipDeviceGetAttribute(&cus, hipDeviceAttributeMultiprocessorCount, dev);
        (void)hipFuncSetAttribute((const void*)mega, hipFuncAttributeMaxDynamicSharedMemorySize, LDS_BYTES);
        (void)hipOccupancyMaxActiveBlocksPerMultiprocessor(&per_cu, (const void*)mega, 512, LDS_BYTES);
        if (per_cu < 1) { fprintf(stderr, "kernel_launch: occupancy query says %d blocks per CU\n", per_cu); per_cu = 1; }
        grid = cus;
        if (grid % 8) grid -= grid % 8;
    }
    if (grid < 0) return;
    Params p{};
    const float** f = (const float**)&p;
    for (int i = 0; i < 19; ++i) f[i] = (const float*)d_in[i];
    p.out = (float*)d_out; p.ws = (unsigned char*)d_ws;
    (void)hipMemsetAsync(d_ws, 0, WS_ZERO_BYTES, stream);
    void* args[] = {&p};
    hipError_t e = hipLaunchCooperativeKernel((const void*)mega, dim3(grid), dim3(512), args, LDS_BYTES, stream);
    if (e != hipSuccess) fprintf(stderr, "cooperative launch failed: %s (grid %d)\n", hipGetErrorString(e), grid);
}
```

```cpp
#include <hip/hip_runtime.h>
#include <hip/hip_cooperative_groups.h>
#include <cstdio>
#include <cstdint>
namespace cg = cooperative_groups;

#define LAS __attribute__((address_space(3)))
typedef unsigned short bf16_t;
typedef short bf16x8 __attribute__((ext_vector_type(8)));
typedef float f32x4 __attribute__((ext_vector_type(4)));
typedef float f32x2 __attribute__((ext_vector_type(2)));
typedef float f32x16 __attribute__((ext_vector_type(16)));
typedef unsigned u32x4 __attribute__((ext_vector_type(4)));
typedef unsigned u32x2 __attribute__((ext_vector_type(2)));

constexpr int BATCH = 8, SEQ = 2048, DM = 1024, NTOK = BATCH * SEQ;
constexpr int NMOD = 6 * DM;
constexpr int IN_COLS = 2896, NPROJ = 3072;
constexpr int C_AQ = 0, C_BQ = 512, C_IQ = 1024, C_BK = 1536, C_BV = 2048, C_AK = 2560, C_AV = 2688, C_IK = 2816, C_IW = 2880, C_BF = 2888;
constexpr int NEXP = 32, DFF = 256;
constexpr float EPS = 1e-6f;
constexpr float LOG2E = 1.4426950408889634f;
constexpr float C2 = 0.125f * LOG2E;

constexpr size_t KiB = 1024, MiB = 1024 * 1024;
constexpr size_t WS_CNT = 0;
constexpr size_t WS_FLAG = 12 * KiB;
constexpr size_t WS_BAR = 16 * KiB;
constexpr size_t WS_TFLAG = 32 * KiB;
constexpr size_t WS_ZERO_BYTES = 64 * KiB;
constexpr size_t WS_MOD = 64 * KiB;
constexpr size_t WS_MOD2 = 256 * KiB;
constexpr size_t WS_IW = 512 * KiB;
constexpr size_t WS_LOGF = 1 * MiB;
constexpr size_t WS_SSQ = 1 * MiB + 512 * KiB;
constexpr size_t WS_X1SSQ = 2 * MiB + 512 * KiB;
constexpr size_t WS_RW = 3 * MiB + 512 * KiB;
constexpr size_t WS_LIST = 4 * MiB;
constexpr size_t WS_WR = 6 * MiB;
constexpr size_t WS_WIN = 8 * MiB;
constexpr size_t WS_WOUT = 14 * MiB;
constexpr size_t WS_WGU = 16 * MiB;
constexpr size_t WS_WD = 48 * MiB;
constexpr size_t WS_PROJ = 64 * MiB;
constexpr size_t WS_Y = 64 * MiB;
constexpr size_t WS_ACT = 128 * MiB;
constexpr size_t WS_H = 160 * MiB;
constexpr size_t WS_O = 192 * MiB;
constexpr size_t WS_MASK = 224 * MiB;
constexpr size_t WS_IKF = 228 * MiB;
constexpr size_t WS_END = 230 * MiB;

constexpr int LDS_BYTES = 147456;

struct Params {
    const float *x, *c, *w_ada, *b_ada, *g_mix, *w_in, *b_forget, *g_out_a, *g_out_b, *w_out, *g_ffn, *w_group, *b_group, *w_router, *b_router, *w_gate, *w_up, *w_down, *g_final;
    float* out;
    unsigned char* ws;
};

__device__ __forceinline__ unsigned f2bf(float f) { unsigned u = __builtin_bit_cast(unsigned, f); return (u + 0x7fffu + ((u >> 16) & 1u)) >> 16; }
__device__ __forceinline__ unsigned pk2(float lo, float hi) { return f2bf(lo) | (f2bf(hi) << 16); }
__device__ __forceinline__ float bf2f(unsigned short b) { return __builtin_bit_cast(float, (unsigned)b << 16); }
__device__ __forceinline__ float wave_sum(float v) {
#pragma unroll
    for (int o = 1; o < 64; o <<= 1) v += __shfl_xor(v, o);
    return v;
}
#define LDS_BARRIER() do { asm volatile("s_waitcnt lgkmcnt(0)" ::: "memory"); __builtin_amdgcn_s_barrier(); asm volatile("" ::: "memory"); } while (0)
__device__ __forceinline__ float siluf(float v) { return v / (1.f + __expf(-v)); }

__device__ __forceinline__ int win_row(int n) {
    if (n < 512) return C_AQ + n;
    if (n < 640) return C_AK + (n - 512);
    if (n < 768) return C_AV + (n - 640);
    if (n < 1280) return C_IQ + (n - 768);
    if (n < 1344) return C_IK + (n - 1280);
    if (n < 1352) return C_IW + (n - 1344);
    if (n < 1864) return C_BQ + (n - 1352);
    if (n < 2376) return C_BK + (n - 1864);
    if (n < 2888) return C_BV + (n - 2376);
    return C_BF + (n - 2888);
}
struct TItem { const float* W; bf16_t* WT; const float* kscale; int K, N, k0, n0, map; };
constexpr int NB_IN = (IN_COLS + 31) / 32;
constexpr int I_IN = 16 * NB_IN, I_OUT = 16 * 32, I_G = 32 * 16 * 8, I_U = I_G, I_D = 32 * 4 * 32;
constexpr int NITEMS = I_IN + I_OUT;
constexpr int NXITEMS = I_G + I_U + I_D;
__device__ __forceinline__ TItem titem(const Params& p, int r) {
    TItem t; unsigned char* ws = p.ws; t.kscale = nullptr;
    if (r < I_IN) { const int kb = r / NB_IN, nb = r % NB_IN; t.W = p.w_in; t.WT = (bf16_t*)(ws + WS_WIN); t.K = 1024; t.N = IN_COLS; t.k0 = 64 * kb; t.n0 = 32 * nb; t.map = 1; return t; } r -= I_IN;
    { const int kb = r / 32, nb = r % 32; t.W = p.w_out; t.WT = (bf16_t*)(ws + WS_WOUT); t.K = 1024; t.N = 1024; t.k0 = 64 * kb; t.n0 = 32 * nb; t.map = 0; t.kscale = t.k0 < 512 ? p.g_out_a : p.g_out_b - 512; return t; }
}
__device__ __forceinline__ TItem txitem(const Params& p, int r) {
    TItem t; unsigned char* ws = p.ws; t.kscale = nullptr;
    if (r < I_G) { const int e = r >> 7, q = r & 127, kb = q >> 3, nb = q & 7; t.W = p.w_gate + (size_t)e * 1024 * 256; t.WT = (bf16_t*)(ws + WS_WGU) + (size_t)e * 512 * 1024; t.K = 1024; t.N = 256; t.k0 = 64 * kb; t.n0 = 32 * nb; t.map = 2; return t; } r -= I_G;
    if (r < I_U) { const int e = r >> 7, q = r & 127, kb = q >> 3, nb = q & 7; t.W = p.w_up + (size_t)e * 1024 * 256; t.WT = (bf16_t*)(ws + WS_WGU) + (size_t)e * 512 * 1024; t.K = 1024; t.N = 256; t.k0 = 64 * kb; t.n0 = 32 * nb; t.map = 3; return t; } r -= I_U;
    { const int e = r >> 7, q = r & 127, kb = q >> 5, nb = q & 31; t.W = p.w_down + (size_t)e * 256 * 1024; t.WT = (bf16_t*)(ws + WS_WD) + (size_t)e * 1024 * 256; t.K = 256; t.N = 1024; t.k0 = 64 * kb; t.n0 = 32 * nb; t.map = 0; return t; }
}
__device__ __forceinline__ void titem_load(const TItem& t, int lane, float (&v)[32]) {
    const int nn = t.n0 + (lane & 31);
    const float* src = t.W + (size_t)(t.k0 + (lane >> 5)) * t.N + nn;
    const bool ok = nn < t.N;
    const size_t step = (size_t)2 * t.N;
#pragma unroll
    for (int i = 0; i < 32; ++i) { v[i] = ok ? __builtin_nontemporal_load(src) : 0.f; src += step; }
    if (t.kscale) {
        const float* ks = t.kscale + t.k0 + (lane >> 5);
#pragma unroll
        for (int i = 0; i < 32; ++i) v[i] *= ks[2 * i];
    }
}
__device__ __forceinline__ void titem_store(const TItem& t, int lane, const float (&v)[32], LAS float* scr) {
#pragma unroll
    for (int i = 0; i < 32; ++i) scr[(2 * i + (lane >> 5)) * 33 + (lane & 31)] = v[i];
    asm volatile("s_waitcnt lgkmcnt(0)" ::: "memory");
    const int c = lane & 7;
#pragma unroll
    for (int j = 0; j < 4; ++j) {
        const int nl = (lane >> 3) + 8 * j, n = t.n0 + nl;
        const LAS float* s = scr + (8 * c) * 33 + nl;
        u32x4 o; o.x = pk2(s[0 * 33], s[1 * 33]); o.y = pk2(s[2 * 33], s[3 * 33]); o.z = pk2(s[4 * 33], s[5 * 33]); o.w = pk2(s[6 * 33], s[7 * 33]);
        int row;
        if (t.map == 0) row = n; else if (t.map == 1) row = win_row(n); else if (t.map == 2) row = (n >> 7) * 256 + (n & 127); else row = (n >> 7) * 256 + 128 + (n & 127);
        if (n < t.N) *(u32x4*)(t.WT + (size_t)row * t.K + t.k0 + 8 * c) = o;
    }
    asm volatile("s_waitcnt lgkmcnt(0)" ::: "memory");
}

__device__ __forceinline__ void titem_dma_issue(const TItem& t, int lane, LAS float* scr) {
    const float* src = t.W + (size_t)(t.k0 + (lane >> 3)) * t.N + t.n0 + 4 * (lane & 7);
    const size_t step = (size_t)8 * t.N;
#pragma unroll
    for (int i = 0; i < 8; ++i) { __builtin_amdgcn_global_load_lds((const unsigned*)src, (LAS unsigned*)(scr + i * 256), 16, 0, 2); src += step; }
}
__device__ __forceinline__ void titem_dma_finish(const TItem& t, int lane, const LAS float* scr) {
    const int c = lane & 7;
#pragma unroll
    for (int j = 0; j < 4; ++j) {
        const int nl = (lane >> 3) + 8 * j, n = t.n0 + nl;
        const LAS float* s = scr + (8 * c) * 32 + nl;
        u32x4 o; o.x = pk2(s[0 * 32], s[1 * 32]); o.y = pk2(s[2 * 32], s[3 * 32]); o.z = pk2(s[4 * 32], s[5 * 32]); o.w = pk2(s[6 * 32], s[7 * 32]);
        int row;
        if (t.map == 0) row = n; else if (t.map == 2) row = (n >> 7) * 256 + (n & 127); else row = (n >> 7) * 256 + 128 + (n & 127);
        *(u32x4*)(t.WT + (size_t)row * t.K + t.k0 + 8 * c) = o;
    }
}

__device__ __forceinline__ void phase0b_issue(const Params& p, f32x4 (&vx)[8][4]) {
    int tid_ = threadIdx.x; asm volatile("" : "+v"(tid_)); const int tid = tid_, lane = tid & 63, wave = tid >> 6, G = gridDim.x;
    const int gw = blockIdx.x * 8 + wave, NGW = G * 8;
    if (NTOK == 8 * NGW) {
#pragma unroll
        for (int r = 0; r < 8; ++r) {
            const f32x4* xr = (const f32x4*)(p.x + (size_t)(8 * gw + r) * DM) + lane;
#pragma unroll
            for (int j = 0; j < 4; ++j) vx[r][j] = __builtin_nontemporal_load(xr + 64 * j);
        }
    }
}
__device__ __forceinline__ void phase0(const Params& p, LAS unsigned char* lds, f32x4 (&vx)[8][4]) {
    int tid_ = threadIdx.x; asm volatile("" : "+v"(tid_)); const int tid = tid_, lane = tid & 63, wave = tid >> 6, G = gridDim.x;
    unsigned char* ws = p.ws;
    const int nA = NMOD / 32;
    const bool split = (G >= nA + 32), helper = split && ((int)blockIdx.x >= nA);
    if (helper) phase0b_issue(p, vx);
    else {
    for (int item = blockIdx.x; item < NMOD / 32; item += G) {
        LAS float* sc = (LAS float*)lds;
        LAS float* red = (LAS float*)(lds + 32768);
        const int j0 = 32 * item, col = lane & 31, kr = lane >> 5;
        const int kb = wave * 128 + 64 * kr;
        const unsigned loff = (unsigned)(kb * NMOD + j0 + col);
        const __amdgpu_buffer_rsrc_t wrs = __builtin_amdgcn_make_buffer_rsrc((void*)p.w_ada, 0, 0x7fffffff, 0x00020000);
        float w[32];
#pragma unroll
        for (int u = 0; u < 32; ++u) w[u] = __builtin_bit_cast(float, __builtin_amdgcn_raw_buffer_load_b32(wrs, loff * 4u, u * (NMOD * 4), 2));
        for (int i = tid; i < BATCH * DM; i += 512) sc[i] = siluf(p.c[i]);
        __syncthreads();
        float acc[8];
#pragma unroll
        for (int b = 0; b < 8; ++b) acc[b] = 0.f;
#pragma unroll 1
        for (int i0 = 0; i0 < 64; i0 += 32) {
            if (i0) {
#pragma unroll
                for (int u = 0; u < 32; ++u) w[u] = __builtin_bit_cast(float, __builtin_amdgcn_raw_buffer_load_b32(wrs, loff * 4u, (32 + u) * (NMOD * 4), 2));
            }
#pragma unroll
            for (int b = 0; b < 8; ++b) {
#pragma unroll
                for (int u4 = 0; u4 < 32; u4 += 4) {
                    const f32x4 s = *(const LAS f32x4*)(sc + b * 1024 + kb + i0 + u4);
                    acc[b] += (s[0] * w[u4] + s[1] * w[u4 + 1]) + (s[2] * w[u4 + 2] + s[3] * w[u4 + 3]);
                }
            }
        }
#pragma unroll
        for (int b = 0; b < 8; ++b) { acc[b] += __shfl_xor(acc[b], 32); if (kr == 0) red[(wave * 8 + b) * 32 + col] = acc[b]; }
        __syncthreads();
        if (wave == 0) {
#pragma unroll
            for (int q = 0; q < 4; ++q) {
                const int o = lane + 64 * q, b = o >> 5, cc = o & 31; float s = 0.f;
#pragma unroll
                for (int w8 = 0; w8 < 8; ++w8) s += red[(w8 * 8 + b) * 32 + cc];
                __hip_atomic_store((float*)(ws + WS_MOD) + b * NMOD + j0 + cc, s + p.b_ada[j0 + cc], __ATOMIC_RELAXED, __HIP_MEMORY_SCOPE_AGENT);
            }
            asm volatile("s_waitcnt vmcnt(0)" ::: "memory");
            if (tid == 0) __hip_atomic_fetch_add((unsigned*)(ws + WS_FLAG), 1u, __ATOMIC_RELAXED, __HIP_MEMORY_SCOPE_AGENT);
        }
        __syncthreads();
    }
    phase0b_issue(p, vx);
    }
    if (split && !helper) return;
    const int hb = helper ? (int)blockIdx.x - nA : (int)blockIdx.x, HG = helper ? G - nA : G;
    {
        bf16_t* wrh = (bf16_t*)(ws + WS_WR); bf16_t* wrl = wrh + 48 * 1024;
        for (int i = hb * 512 + tid; i < 48 * 1024; i += HG * 512) {
            const int o = i >> 10, k = i & 1023; float v = 0.f;
            if (o < 4) v = p.w_group[k * 4 + o];
            else if (o >= 16) { const int g = (o - 16) >> 3, e = (o - 16) & 7; v = p.w_router[((size_t)g * 1024 + k) * 8 + e]; }
            const unsigned hb = f2bf(v); const float hf = bf2f((unsigned short)hb);
            wrh[i] = (bf16_t)hb; wrl[i] = (bf16_t)f2bf(v - hf);
        }
    }
    {
        u32x4* z = (u32x4*)((bf16_t*)(ws + WS_WIN) + (size_t)IN_COLS * 1024);
        const int n16 = (NPROJ - IN_COLS) * 1024 * 2 / 16;
        for (int i = hb * 512 + tid; i < n16; i += HG * 512) z[i] = (u32x4){0u, 0u, 0u, 0u};
    }
    {
        LAS float* scr = (LAS float*)(lds + 49152 + wave * 8704);
        const int gw = hb * 8 + wave, NGW = HG * 8;
        float va[32], vb[32];
        int it = gw;
        if (it < NITEMS) { const TItem t0 = titem(p, it); titem_load(t0, lane, va); }
        while (it < NITEMS) {
            const TItem tc = titem(p, it);
            const int nx = it + NGW;
            if (nx < NITEMS) { const TItem tn = titem(p, nx); titem_load(tn, lane, vb); }
            titem_store(tc, lane, va, scr);
#pragma unroll
            for (int i = 0; i < 32; ++i) va[i] = vb[i];
            it = nx;
        }
    }
}

__device__ __forceinline__ void phase0b(const Params& p, f32x4 (&vx)[8][4]) {
    int tid_ = threadIdx.x; asm volatile("" : "+v"(tid_)); const int tid = tid_, lane = tid & 63, wave = tid >> 6, G = gridDim.x;
    const float* mod = (const float*)(p.ws + WS_MOD);
    float* mod2 = (float*)(p.ws + WS_MOD2);
    const int gw = blockIdx.x * 8 + wave, NGW = G * 8;
    const bool fast = (NTOK == 8 * NGW);
    if (tid == 0) {
        unsigned* flag = (unsigned*)(p.ws + WS_FLAG); unsigned sp = 0;
        while (__hip_atomic_load(flag, __ATOMIC_RELAXED, __HIP_MEMORY_SCOPE_AGENT) < (unsigned)(NMOD / 32)) { __builtin_amdgcn_s_sleep(2); if (++sp > (1u << 22)) break; }
        __builtin_amdgcn_fence(__ATOMIC_ACQUIRE, "agent");
        asm volatile("s_waitcnt vmcnt(0)" ::: "memory");
    }
    __syncthreads();
    for (int i = blockIdx.x * 512 + tid; i < BATCH * DM; i += G * 512) {
        const int b = i >> 10, k = i & 1023;
        mod2[(b * 2 + 0) * 1024 + k] = p.g_ffn[k] * (1.f + mod[b * NMOD + 4 * DM + k]);
        mod2[(b * 2 + 1) * 1024 + k] = mod[b * NMOD + 3 * DM + k];
    }
    bf16_t* H = (bf16_t*)(p.ws + WS_H);
    if (fast) {
        const int b = (8 * gw) >> 11;
        f32x4 A4[4], S4[4];
#pragma unroll
        for (int j = 0; j < 4; ++j) {
            const int k = 4 * lane + 256 * j;
            const f32x4 g = *(const f32x4*)(p.g_mix + k), sh = *(const f32x4*)(mod + b * NMOD + k), sc = *(const f32x4*)(mod + b * NMOD + DM + k);
            A4[j] = g * (1.f + sc); S4[j] = sh;
        }
#pragma unroll
        for (int r = 0; r < 8; ++r) {
            const int m = 8 * gw + r;
            float s = 0.f;
#pragma unroll
            for (int j = 0; j < 4; ++j) s += (vx[r][j].x * vx[r][j].x + vx[r][j].y * vx[r][j].y) + (vx[r][j].z * vx[r][j].z + vx[r][j].w * vx[r][j].w);
            const float rstd = 1.f / sqrtf(wave_sum(s) * (1.f / DM) + EPS);
            unsigned long long* o8 = (unsigned long long*)(H + (size_t)m * DM) + lane;
#pragma unroll
            for (int j = 0; j < 4; ++j) {
                const f32x4 h = vx[r][j] * rstd * A4[j] + S4[j];
                o8[64 * j] = (unsigned long long)pk2(h.x, h.y) | ((unsigned long long)pk2(h.z, h.w) << 32);
            }
        }
        return;
    }
    for (int m = gw; m < NTOK; m += NGW) {
        const int b = m >> 11;
        const f32x4* xr = (const f32x4*)(p.x + (size_t)m * DM) + lane;
        f32x4 v[4]; float s = 0.f;
#pragma unroll
        for (int j = 0; j < 4; ++j) { v[j] = __builtin_nontemporal_load(xr + 64 * j); s += (v[j].x * v[j].x + v[j].y * v[j].y) + (v[j].z * v[j].z + v[j].w * v[j].w); }
        const float rstd = 1.f / sqrtf(wave_sum(s) * (1.f / DM) + EPS);
        unsigned long long* o8 = (unsigned long long*)(H + (size_t)m * DM) + lane;
#pragma unroll
        for (int j = 0; j < 4; ++j) {
            const int k = 4 * lane + 256 * j;
            const f32x4 g = *(const f32x4*)(p.g_mix + k), sh = *(const f32x4*)(mod + b * NMOD + k), sc = *(const f32x4*)(mod + b * NMOD + DM + k);
            const f32x4 h = v[j] * rstd * g * (1.f + sc) + sh;
            o8[64 * j] = (unsigned long long)pk2(h.x, h.y) | ((unsigned long long)pk2(h.z, h.w) << 32);
        }
    }
}

__device__ __forceinline__ void phase_final(const Params& p, bool skeleton) {
    int tid_ = threadIdx.x; asm volatile("" : "+v"(tid_)); const int tid = tid_, lane = tid & 63, wave = tid >> 6, G = gridDim.x;
    const float* mod = (const float*)(p.ws + WS_MOD);
    const bf16_t* Y = (const bf16_t*)(p.ws + WS_Y);
    const int gw = blockIdx.x * 8 + wave, NGW = G * 8;
    if (!skeleton && NTOK == 8 * NGW) {
        const int b = (8 * gw) >> 11;
        f32x4 GF[4], GN[4];
#pragma unroll
        for (int j = 0; j < 4; ++j) { const int k = 4 * lane + 256 * j; GF[j] = *(const f32x4*)(mod + b * NMOD + 5 * DM + k); GN[j] = *(const f32x4*)(p.g_final + k); }
#pragma unroll 2
        for (int r = 0; r < 8; ++r) {
            const int m = 8 * gw + r;
            const u32x2* xb16 = (const u32x2*)((const bf16_t*)p.out + (size_t)m * (2 * DM)) + lane;
            f32x4 v[4]; float s = 0.f;
#pragma unroll
            for (int j = 0; j < 4; ++j) {
                const int k = 4 * lane + 256 * j;
                const u32x2 w = __builtin_nontemporal_load(xb16 + 64 * j);
                const u32x2 y0 = __builtin_nontemporal_load((const u32x2*)(Y + ((size_t)m * 2 + 0) * DM + k)), y1 = __builtin_nontemporal_load((const u32x2*)(Y + ((size_t)m * 2 + 1) * DM + k));
                v[j] = (f32x4){__builtin_bit_cast(float, w.x << 16), __builtin_bit_cast(float, w.x & 0xffff0000u), __builtin_bit_cast(float, w.y << 16), __builtin_bit_cast(float, w.y & 0xffff0000u)};
                f32x4 ys;
                ys.x = bf2f((unsigned short)(y0.x & 0xffff)) + bf2f((unsigned short)(y1.x & 0xffff)); ys.y = bf2f((unsigned short)(y0.x >> 16)) + bf2f((unsigned short)(y1.x >> 16));
                ys.z = bf2f((unsigned short)(y0.y & 0xffff)) + bf2f((unsigned short)(y1.y & 0xffff)); ys.w = bf2f((unsigned short)(y0.y >> 16)) + bf2f((unsigned short)(y1.y >> 16));
                v[j] = v[j] + GF[j] * ys;
                s += (v[j].x * v[j].x + v[j].y * v[j].y) + (v[j].z * v[j].z + v[j].w * v[j].w);
            }
            const float rstd = 1.f / sqrtf(wave_sum(s) * (1.f / DM) + EPS);
            f32x4* o = (f32x4*)(p.out + (size_t)m * DM) + lane;
#pragma unroll
            for (int j = 0; j < 4; ++j) o[64 * j] = v[j] * rstd * GN[j];
        }
        return;
    }
    for (int m = gw; m < NTOK; m += NGW) {
        const int b = m >> 11;
        const f32x4* xr = (const f32x4*)(p.x + (size_t)m * DM) + lane;
        const u32x2* xb16 = (const u32x2*)((const bf16_t*)p.out + (size_t)m * (2 * DM)) + lane;
        f32x4 v[4]; float s = 0.f;
#pragma unroll
        for (int j = 0; j < 4; ++j) {
            if (skeleton) v[j] = xr[64 * j];
            else { const u32x2 w = __builtin_nontemporal_load(xb16 + 64 * j); v[j] = (f32x4){__builtin_bit_cast(float, w.x << 16), __builtin_bit_cast(float, w.x & 0xffff0000u), __builtin_bit_cast(float, w.y << 16), __builtin_bit_cast(float, w.y & 0xffff0000u)}; }
            if (!skeleton) {
                const int k = 4 * lane + 256 * j;
                const f32x4 gf = *(const f32x4*)(mod + b * NMOD + 5 * DM + k);
                const u32x2 y0 = __builtin_nontemporal_load((const u32x2*)(Y + ((size_t)m * 2 + 0) * DM + k)), y1 = __builtin_nontemporal_load((const u32x2*)(Y + ((size_t)m * 2 + 1) * DM + k));
                f32x4 ys;
                ys.x = bf2f((unsigned short)(y0.x & 0xffff)) + bf2f((unsigned short)(y1.x & 0xffff)); ys.y = bf2f((unsigned short)(y0.x >> 16)) + bf2f((unsigned short)(y1.x >> 16));
                ys.z = bf2f((unsigned short)(y0.y & 0xffff)) + bf2f((unsigned short)(y1.y & 0xffff)); ys.w = bf2f((unsigned short)(y0.y >> 16)) + bf2f((unsigned short)(y1.y >> 16));
                v[j] = v[j] + gf * ys;
            }
            s += (v[j].x * v[j].x + v[j].y * v[j].y) + (v[j].z * v[j].z + v[j].w * v[j].w);
        }
        const float rstd = 1.f / sqrtf(wave_sum(s) * (1.f / DM) + EPS);
        f32x4* o = (f32x4*)(p.out + (size_t)m * DM) + lane;
#pragma unroll
        for (int j = 0; j < 4; ++j) { const f32x4 g = *(const f32x4*)(p.g_final + 4 * lane + 256 * j); o[64 * j] = v[j] * rstd * g; }
    }
}

#define XB_TMO      128
#define XB_XCNT(j)  (256  + 64 * (j))
#define XB_XSUB(j)  (1280 + 64 * (j))
#define XB_XGEN(j)  (2304 + 64 * (j))
#define XB_TOP      3328
#define XB_TOPGEN   3392
#define XCD_BAR_WORDS 3456
#define XB_SPIN_CAP (1u << 18)
__device__ __forceinline__ unsigned xb_ld(unsigned* p)              { return __hip_atomic_load(p, __ATOMIC_RELAXED, __HIP_MEMORY_SCOPE_AGENT); }
__device__ __forceinline__ unsigned xb_add(unsigned* p, unsigned v) { return __hip_atomic_fetch_add(p, v, __ATOMIC_RELAXED, __HIP_MEMORY_SCOPE_AGENT); }
__device__ __forceinline__ unsigned xb_xcc_id() { return (unsigned)__builtin_amdgcn_s_getreg((3 << 11) | 20) & 0xFu; }
#define XB_SPIN(cond, bar) do { unsigned _sp = 0; while (cond) { __builtin_amdgcn_s_sleep(1); \
    if ((++_sp & 255u) == 0u) { if (xb_ld(&(bar)[XB_TMO])) break; if (_sp > XB_SPIN_CAP) { atomicAdd(&(bar)[XB_TMO], 1u); break; } } } } while (0)
struct XcdBarrier { unsigned* bar; unsigned x; volatile LAS unsigned* st; };
__device__ __forceinline__ XcdBarrier xcd_barrier_post(unsigned* bar, volatile LAS unsigned* st) {
    XcdBarrier b; b.bar = bar; b.x = xb_xcc_id(); b.st = st;
    if (threadIdx.x == 0) st[2] = xb_add(&bar[XB_XCNT(b.x)], 1u);
    return b;
}
__device__ __forceinline__ void xcd_barrier_complete(unsigned* bar, unsigned x, unsigned& nloc, unsigned& nx) {
    const unsigned G = gridDim.x * gridDim.y * gridDim.z;
    unsigned sum, cnt, mine, sp = 0u;
    for (;;) {
        sum = 0u; cnt = 0u; mine = 0u;
#pragma unroll
        for (unsigned j = 0; j < 16; ++j) { const unsigned c = xb_ld(&bar[XB_XCNT(j)]); sum += c; cnt += (c > 0u) ? 1u : 0u; mine = (j == x) ? c : mine; }
        if (sum == G) break;
        __builtin_amdgcn_s_sleep(1);
        if ((++sp & 255u) == 0u) { if (xb_ld(&bar[XB_TMO])) break; if (sp > XB_SPIN_CAP) { atomicAdd(&bar[XB_TMO], 1u); break; } }
    }
    nloc = mine > 0u ? mine : 1u; nx = cnt > 0u ? cnt : 1u;
}
__device__ __forceinline__ void xcd_barrier(const XcdBarrier& b) {
    asm volatile("s_waitcnt vmcnt(0)" ::: "memory");
    __syncthreads();
    if (threadIdx.x == 0) {
        unsigned* bar = b.bar;
        __builtin_amdgcn_s_waitcnt(0);
        unsigned nloc = b.st[0], nx = b.st[1];
        if (nloc == 0u) { xcd_barrier_complete(bar, b.x, nloc, nx); b.st[0] = nloc; b.st[1] = nx; }
        const unsigned old = xb_add(&bar[XB_XSUB(b.x)], 1u);
        const unsigned gen = old / nloc;
        if (old + 1u == (gen + 1u) * nloc) {
            __builtin_amdgcn_fence(__ATOMIC_RELEASE, "agent");
            asm volatile("s_waitcnt vmcnt(0)" ::: "memory");
            const unsigned og = xb_add(&bar[XB_TOP], 1u);
            const unsigned tg = og / nx;
            if (og + 1u == (tg + 1u) * nx) xb_add(&bar[XB_TOPGEN], 1u);
            else XB_SPIN(xb_ld(&bar[XB_TOPGEN]) == tg, bar);
            __builtin_amdgcn_fence(__ATOMIC_ACQUIRE, "agent");
            xb_add(&bar[XB_XGEN(b.x)], 1u);
            asm volatile("s_waitcnt vmcnt(0)" ::: "memory");
        } else {
            XB_SPIN(xb_ld(&bar[XB_XGEN(b.x)]) == gen, bar);
            __builtin_amdgcn_fence(__ATOMIC_ACQUIRE, "agent");
            asm volatile("s_waitcnt vmcnt(0)" ::: "memory");
        }
    }
    __syncthreads();
}
namespace pg8 {
constexpr int BM = 256, BK = 64, HALF = 128, HTB = HALF * BK * 2, STAGE_BYTES = 8 * HTB, NXCD = 8, WGM = 8;
__host__ __device__ __forceinline__ int lds_byte(int r, int c) { const int st = (r >> 4) * 2 + (c >> 5), rr = r & 15, cc = c & 31, ob = rr * 64 + cc * 2; return st * 1024 + (ob ^ (((ob >> 9) & 1) << 5)); }
__host__ __device__ __forceinline__ void stage_rc(int b, int& R, int& C) { const int st = b / 1024, sb = b % 1024, swz = sb ^ (((sb >> 9) & 1) << 5); R = (st >> 1) * 16 + swz / 64; C = (st & 1) * 32 + (swz % 64) / 2; }
__host__ __device__ __forceinline__ int perm32(int rho) { const int n = rho >> 4, i = rho & 15; return 8 * (i >> 2) + 4 * n + (i & 3); }

struct Unit { int pm, pn; size_t aoff, boff; int e, r0, cnt; };
struct Gemm { const bf16_t* A; const bf16_t* Bt; int K; };

struct StaticOrder {
    int nM, nN, nwg, G, c; size_t tstep;
    __device__ void init(int M, int N, int K, int G_, int c_) { nM = M / BM; nN = N / BM; nwg = nM * nN; G = G_; c = c_; tstep = (size_t)BM * K * 2; }
    __device__ bool next(int i, Unit& u) const {
        const long L = (long)i * G + c; if (L >= nwg) return false;
        int wgid = (int)L; { const int q = nwg / NXCD, r = nwg % NXCD, xcd = wgid % NXCD, off = wgid / NXCD; wgid = (xcd < r ? xcd * (q + 1) : r * (q + 1) + (xcd - r) * q) + off; }
        const int nig = WGM * nN, gid = wgid / nig, fm = gid * WGM, gsz = (nM - fm) < WGM ? (nM - fm) : WGM;
        u.pm = fm + ((wgid % nig) % gsz); u.pn = (wgid % nig) / gsz; u.aoff = (size_t)u.pm * tstep; u.boff = (size_t)u.pn * tstep; u.e = 0; u.r0 = 0; u.cnt = 0; return true;
    }
    __device__ __forceinline__ unsigned arow(const Unit&, int R) const { return 0u; }
    __device__ __forceinline__ void a_ready(const Unit&) const {}
    __device__ __forceinline__ void done(const Unit&) const {}
};

__device__ __forceinline__ unsigned cvt_pk_bf16(float lo, float hi) { unsigned r; asm volatile("v_cvt_pk_bf16_f32 %0, %1, %2" : "=v"(r) : "v"(lo), "v"(hi)); return r; }

template <class Epi, class Sched, bool GATHER>
__device__ __forceinline__ void gemm_phase(LAS unsigned char* lds, const Gemm g, const Sched& S, const Epi& E) {
    int tid_ = threadIdx.x; asm volatile("" : "+v"(tid_)); const int tid = tid_, wid = __builtin_amdgcn_readfirstlane(tid >> 6), lane = tid & 63, wr = wid >> 2, wc = wid & 3, fr = lane & 15, fq = lane >> 4;
    const int K = g.K, nt = K / BK;
    int Rst[2], Cst[2]; unsigned voffB[2], voffA[2], cOA[2][2], nOA[2][2];
    const size_t kstep = (size_t)(BK * 2);
    const size_t hstep = (size_t)HALF * K * 2;
#pragma unroll
    for (int i = 0; i < 2; ++i) { int R, C; stage_rc(tid * 16 + i * 8192, R, C); Rst[i] = R; Cst[i] = C; const int Rb = Epi::PERM ? ((R & ~31) + perm32(R & 31)) : R; voffB[i] = (unsigned)(Rb * K + C) * 2u; voffA[i] = (unsigned)(R * K + C) * 2u; }
    const unsigned ldsw = (unsigned)wid * 1024u;
    const int aoff = lds_byte(wr * 64 + fr, fq * 8), boff = lds_byte(wc * 32 + fr, fq * 8);
#define PG8_SA(b, h) (((b) * 2 + (h)) * HTB)
#define PG8_SB(b, h) ((4 + (b) * 2 + (h)) * HTB)
#define PG8_STAGE_B(bufoff, gbase) do { _Pragma("unroll") for (int _i = 0; _i < 2; ++_i) \
        __builtin_amdgcn_global_load_lds((const unsigned*)((const char*)(gbase) + voffB[_i]), (LAS unsigned*)(lds + (bufoff) + ldsw + _i * 8192), 16, 0, 0); } while (0)
#define PG8_STAGE_A(bufoff, gbase, H, o0, o1) do { \
        const char* _gb = GATHER ? (const char*)(gbase) : (const char*)(gbase) + (H) * hstep; \
        const unsigned _o0 = GATHER ? (o0) : voffA[0], _o1 = GATHER ? (o1) : voffA[1]; \
        __builtin_amdgcn_global_load_lds((const unsigned*)(_gb + _o0), (LAS unsigned*)(lds + (bufoff) + ldsw), 16, 0, 0); \
        __builtin_amdgcn_global_load_lds((const unsigned*)(_gb + _o1), (LAS unsigned*)(lds + (bufoff) + ldsw + 8192), 16, 0, 0); } while (0)
#define PG8_LDA(dst, b, h) do { _Pragma("unroll") for (int m = 0; m < 4; ++m) _Pragma("unroll") for (int k = 0; k < 2; ++k) dst[m][k] = *(const LAS bf16x8*)(lds + PG8_SA(b, h) + aoff + m * 2048 + k * 1024); } while (0)
#define PG8_LDB(dst, b, h) do { _Pragma("unroll") for (int n = 0; n < 2; ++n) _Pragma("unroll") for (int k = 0; k < 2; ++k) dst[n][k] = *(const LAS bf16x8*)(lds + PG8_SB(b, h) + boff + n * 2048 + k * 1024); } while (0)
#define PG8_MMA(ai, bj, At, Bt) do { __builtin_amdgcn_s_setprio(1); _Pragma("unroll") for (int m = 0; m < 4; ++m) _Pragma("unroll") for (int n = 0; n < 2; ++n) _Pragma("unroll") for (int k = 0; k < 2; ++k) \
        acc[ai][bj][m][n] = __builtin_amdgcn_mfma_f32_16x16x32_bf16(Bt[n][k], At[m][k], acc[ai][bj][m][n], 0, 0, 0); __builtin_amdgcn_s_setprio(0); } while (0)
#define PG8_WAIT_V(n) asm volatile("s_waitcnt vmcnt(" #n ")" ::: "memory")
#define PG8_WAIT_L(n) asm volatile("s_waitcnt lgkmcnt(" #n ")" ::: "memory")
#define PG8_BAR __builtin_amdgcn_s_barrier()
#define PG8_SCHED __builtin_amdgcn_sched_barrier(0)
#define PG8_SETOFF(dst, u) do { if (GATHER) { _Pragma("unroll") for (int _h = 0; _h < 2; ++_h) _Pragma("unroll") for (int _i = 0; _i < 2; ++_i) \
        dst[_h][_i] = S.arow(u, Rst[_i] + HALF * _h) * (unsigned)(K * 2) + (unsigned)(Cst[_i] * 2); } } while (0)
    Unit cur, nxt; int ui = 0;
    if (!S.next(0, cur)) return;
    f32x4 acc[2][2][4][2];
#pragma unroll
    for (int a = 0; a < 2; ++a)
#pragma unroll
        for (int b = 0; b < 2; ++b)
#pragma unroll
            for (int m = 0; m < 4; ++m)
#pragma unroll
                for (int n = 0; n < 2; ++n) acc[a][b][m][n] = (f32x4){0.f, 0.f, 0.f, 0.f};
    bf16x8 At[4][2], B0[2][2], B1[2][2];
    const char* cA = (const char*)g.A + cur.aoff; const char* cB = (const char*)g.Bt + cur.boff;
    S.a_ready(cur);
    PG8_SETOFF(cOA, cur);
    PG8_STAGE_B(PG8_SB(0, 0), cB); PG8_STAGE_B(PG8_SB(0, 1), cB + hstep); PG8_STAGE_A(PG8_SA(0, 0), cA, 0, cOA[0][0], cOA[0][1]); PG8_STAGE_A(PG8_SA(0, 1), cA, 1, cOA[1][0], cOA[1][1]);
    if (wr == 1) PG8_BAR;
    PG8_WAIT_V(2); PG8_BAR;
    PG8_STAGE_B(PG8_SB(1, 0), cB + kstep); PG8_STAGE_A(PG8_SA(1, 0), cA + kstep, 0, cOA[0][0], cOA[0][1]); PG8_STAGE_B(PG8_SB(1, 1), cB + hstep + kstep);
    PG8_WAIT_V(6); PG8_BAR;
    for (;;) {
        const bool has_next = S.next(ui + 1, nxt);
        if (has_next) S.a_ready(nxt);
        const char* nA = has_next ? (const char*)g.A + nxt.aoff : cA; const char* nB = has_next ? (const char*)g.Bt + nxt.boff : cB;
        if constexpr (GATHER) { if (has_next) { PG8_SETOFF(nOA, nxt); } else {
#pragma unroll
            for (int _h = 0; _h < 2; ++_h)
#pragma unroll
                for (int _i = 0; _i < 2; ++_i) nOA[_h][_i] = cOA[_h][_i]; } }
        for (int t = 0; t < nt; t += 2) {
            const bool last = (t == nt - 2);
            if constexpr (Epi::MID) { if (t == nt / 2) E.mid(acc, cur, wr); }
            const char* a1 = cA + (size_t)(t + 1) * kstep;
            const char* a2 = last ? nA : cA + (size_t)(t + 2) * kstep; const char* b2 = last ? nB : cB + (size_t)(t + 2) * kstep;
            const char* a3 = a2 + kstep; const char* b3 = b2 + kstep;
            unsigned x00 = 0, x01 = 0, x10 = 0, x11 = 0;
            if constexpr (GATHER) { x00 = last ? nOA[0][0] : cOA[0][0]; x01 = last ? nOA[0][1] : cOA[0][1]; x10 = last ? nOA[1][0] : cOA[1][0]; x11 = last ? nOA[1][1] : cOA[1][1]; }
            PG8_LDB(B0, 0, 0); PG8_LDB(B1, 0, 1); PG8_SCHED; PG8_LDA(At, 0, 0); PG8_STAGE_A(PG8_SA(1, 1), a1, 1, cOA[1][0], cOA[1][1]);
            PG8_WAIT_V(8); PG8_WAIT_L(0); PG8_BAR; PG8_MMA(0, 0, At, B0); PG8_MMA(0, 1, At, B1); PG8_BAR; PG8_SCHED;
            PG8_LDA(At, 0, 1); PG8_STAGE_B(PG8_SB(0, 0), b2); PG8_STAGE_B(PG8_SB(0, 1), b2 + hstep); PG8_STAGE_A(PG8_SA(0, 0), a2, 0, x00, x01);
            PG8_WAIT_V(8); PG8_WAIT_L(0); PG8_BAR; PG8_MMA(1, 0, At, B0); PG8_MMA(1, 1, At, B1); PG8_BAR; PG8_SCHED;
            PG8_LDB(B0, 1, 0); PG8_LDB(B1, 1, 1); PG8_SCHED; PG8_LDA(At, 1, 0); PG8_STAGE_A(PG8_SA(0, 1), a2, 1, x10, x11);
            PG8_WAIT_V(8); PG8_WAIT_L(0); PG8_BAR; PG8_MMA(0, 0, At, B0); PG8_MMA(0, 1, At, B1); PG8_BAR; PG8_SCHED;
            PG8_LDA(At, 1, 1); PG8_STAGE_B(PG8_SB(1, 0), b3); PG8_STAGE_B(PG8_SB(1, 1), b3 + hstep); PG8_STAGE_A(PG8_SA(1, 0), a3, 0, x00, x01);
            PG8_WAIT_V(8); PG8_WAIT_L(0); PG8_BAR; PG8_MMA(1, 0, At, B0); PG8_MMA(1, 1, At, B1); PG8_BAR; PG8_SCHED;
        }
        if (wr == 0) PG8_BAR;
        E(acc, cur, wr, wc);
        S.done(cur);
        if (!has_next) break;
#pragma unroll
        for (int a = 0; a < 2; ++a)
#pragma unroll
            for (int b = 0; b < 2; ++b)
#pragma unroll
                for (int m = 0; m < 4; ++m)
#pragma unroll
                    for (int n = 0; n < 2; ++n) acc[a][b][m][n] = (f32x4){0.f, 0.f, 0.f, 0.f};
        cur = nxt; cA = nA; cB = nB; ++ui;
        if constexpr (GATHER) {
#pragma unroll
            for (int _h = 0; _h < 2; ++_h)
#pragma unroll
                for (int _i = 0; _i < 2; ++_i) cOA[_h][_i] = nOA[_h][_i]; }
        if (wr == 1) PG8_BAR;
    }
    PG8_WAIT_V(0);
    PG8_BAR;
#undef PG8_SA
#undef PG8_SB
#undef PG8_STAGE_A
#undef PG8_STAGE_B
#undef PG8_LDA
#undef PG8_LDB
#undef PG8_MMA
#undef PG8_WAIT_V
#undef PG8_WAIT_L
#undef PG8_BAR
#undef PG8_SCHED
#undef PG8_SETOFF
}
}
typedef float f32x2 __attribute__((ext_vector_type(2)));
using pg8::cvt_pk_bf16;

struct EpiProj {
    static constexpr bool PERM = true, MID = false;
    bf16_t* O; float* iw; float* logf; const float* b_forget; unsigned char* ikf;
    __device__ __forceinline__ void operator()(const f32x4 (&acc)[2][2][4][2], const pg8::Unit& u, int wr, int wc) const {
        int ln_ = threadIdx.x & 63; asm volatile("" : "+v"(ln_)); const int fr = ln_ & 15, fq = ln_ >> 4;
        const int row0 = u.pm * 256 + wr * 64 + fr, col0 = u.pn * 256 + wc * 32 + 8 * fq;
        const float sc = (u.pn < 4) ? C2 : 1.f;
#pragma unroll
        for (int ai = 0; ai < 2; ++ai)
#pragma unroll
            for (int m = 0; m < 4; ++m) {
                const int row = row0 + ai * 128 + m * 16;
                bf16_t* rowp = O + (size_t)row * NPROJ + col0;
#pragma unroll
                for (int bj = 0; bj < 2; ++bj) {
                    const f32x4 v0 = acc[ai][bj][m][0] * sc, v1 = acc[ai][bj][m][1] * sc;
                    u32x4 w; w.x = cvt_pk_bf16(v0[0], v0[1]); w.y = cvt_pk_bf16(v0[2], v0[3]); w.z = cvt_pk_bf16(v1[0], v1[1]); w.w = cvt_pk_bf16(v1[2], v1[3]);
                    *(u32x4*)(rowp + bj * 128) = w;
                    if (u.pn == 11 && bj == 0 && wc < 2)
                        *(u32x4*)(ikf + ((size_t)(row >> 5) << 12) + (wc * 2 + (fq >> 1)) * 1024 + (row & 31) * 32 + (fq & 1) * 16) = w;
                }
                if (u.pn == 11 && wc == 2 && fq < 2) {
                    const f32x4 v0 = acc[ai][0][m][0], v1 = acc[ai][0][m][1];
                    if (fq == 0) { *(f32x4*)(iw + (size_t)row * 8) = v0; *(f32x4*)(iw + (size_t)row * 8 + 4) = v1; }
                    else {
                        f32x4 o0, o1;
#pragma unroll
                        for (int i = 0; i < 4; ++i) {
                            const float z0 = v0[i] + b_forget[i], z1 = v1[i] + b_forget[4 + i];
                            o0[i] = fminf(z0, 0.f) - log1pf(__expf(-fabsf(z0))); o1[i] = fminf(z1, 0.f) - log1pf(__expf(-fabsf(z1)));
                        }
                        *(f32x4*)(logf + (size_t)row * 8) = o0; *(f32x4*)(logf + (size_t)row * 8 + 4) = o1;
                    }
                }
            }
    }
};

struct EpiOut {
    static constexpr bool PERM = false, MID = true;
    const float* x; float* x1; const float* mod; const float* ssq; float* x1ssq;
    __device__ __forceinline__ void rowscale(int row, int fq, float& ra, float& rb) const {
        const f32x4 a = *((const f32x4*)(ssq + (size_t)row * 16) + fq);
        const float t = (a[0] + a[1]) + (a[2] + a[3]);
        const float u2 = t + __shfl_xor(t, 16), v2 = __shfl_xor(u2, 32);
        const float sa = (fq < 2) ? u2 : v2, sb = (fq < 2) ? v2 : u2;
        ra = 1.f / sqrtf(sa * (1.f / 512.f) + EPS); rb = 1.f / sqrtf(sb * (1.f / 512.f) + EPS);
    }
    __device__ __forceinline__ void mid(f32x4 (&acc)[2][2][4][2], const pg8::Unit& u, int wr) const {
        int ln_ = threadIdx.x & 63; asm volatile("" : "+v"(ln_)); const int fr = ln_ & 15, fq = ln_ >> 4;
#pragma unroll
        for (int ai = 0; ai < 2; ++ai)
#pragma unroll
            for (int m = 0; m < 4; ++m) {
                float ra, rb; rowscale(u.pm * 256 + ai * 128 + wr * 64 + m * 16 + fr, fq, ra, rb);
                const float f = ra / rb;
#pragma unroll
                for (int bj = 0; bj < 2; ++bj)
#pragma unroll
                    for (int n = 0; n < 2; ++n) acc[ai][bj][m][n] = acc[ai][bj][m][n] * f;
            }
    }
    __device__ __forceinline__ void operator()(const f32x4 (&acc)[2][2][4][2], const pg8::Unit& u, int wr, int wc) const {
        int ln_ = threadIdx.x & 63; asm volatile("" : "+v"(ln_)); const int fr = ln_ & 15, fq = ln_ >> 4;
        const int col0 = u.pn * 256 + wc * 32 + 4 * fq;
        bf16_t* x1b = (bf16_t*)x1;
        f32x4 gmv[2][2];
        {
            const int b0 = (u.pm * 256) >> 11;
#pragma unroll
            for (int bj = 0; bj < 2; ++bj)
#pragma unroll
                for (int n = 0; n < 2; ++n) gmv[bj][n] = *(const f32x4*)(mod + b0 * NMOD + 2 * DM + col0 + bj * 128 + n * 16);
        }
#pragma unroll
        for (int ai = 0; ai < 2; ++ai)
#pragma unroll
            for (int m = 0; m < 4; ++m) {
                const int row = u.pm * 256 + ai * 128 + wr * 64 + m * 16 + fr;
                float ra, rb; rowscale(row, fq, ra, rb);
                float q = 0.f;
#pragma unroll
                for (int bj = 0; bj < 2; ++bj)
#pragma unroll
                    for (int n = 0; n < 2; ++n) {
                        const int col = col0 + bj * 128 + n * 16;
                        const f32x4 xv = __builtin_nontemporal_load((const f32x4*)(x + (size_t)row * DM + col)), gm = gmv[bj][n];
                        const f32x4 o = xv + gm * (acc[ai][bj][m][n] * rb);
                        u32x2 w; w.x = cvt_pk_bf16(o[0], o[1]); w.y = cvt_pk_bf16(o[2], o[3]);
                        *(u32x2*)(x1b + (size_t)row * (2 * DM) + col) = w;
                        q += (o[0] * o[0] + o[1] * o[1]) + (o[2] * o[2] + o[3] * o[3]);
                    }
                q += __shfl_xor(q, 16); q += __shfl_xor(q, 32);
                if (fq == 0) x1ssq[(size_t)row * 16 + u.pn * 4 + wc] = q;
            }
    }
};

struct EpiAct {
    static constexpr bool PERM = true, MID = false;
    bf16_t* act; const int* list; const float* rw;
    __device__ __forceinline__ void operator()(const f32x4 (&acc)[2][2][4][2], const pg8::Unit& u, int wr, int wc) const {
        int ln_ = threadIdx.x & 63; asm volatile("" : "+v"(ln_)); const int fr = ln_ & 15, fq = ln_ >> 4;
        const int col0 = u.pn * 128 + wc * 32 + 8 * fq;
#pragma unroll
        for (int ai = 0; ai < 2; ++ai)
#pragma unroll
            for (int m = 0; m < 4; ++m) {
                const int rl = ai * 128 + wr * 64 + m * 16 + fr;
                float w = 0.f;
                if (u.r0 + rl < u.cnt) w = rw[list[u.e * 16384 + u.r0 + rl]];
                f32x4 o[2];
#pragma unroll
                for (int n = 0; n < 2; ++n)
#pragma unroll
                    for (int i = 0; i < 4; ++i) { const float gv = acc[ai][0][m][n][i], uv = acc[ai][1][m][n][i]; o[n][i] = gv / (1.f + __expf(-gv)) * uv * w; }
                u32x4 pk; pk.x = cvt_pk_bf16(o[0][0], o[0][1]); pk.y = cvt_pk_bf16(o[0][2], o[0][3]); pk.z = cvt_pk_bf16(o[1][0], o[1][1]); pk.w = cvt_pk_bf16(o[1][2], o[1][3]);
                *(u32x4*)(act + ((size_t)u.pm * 256 + rl) * 256 + col0) = pk;
            }
    }
};

struct EpiDown {
    static constexpr bool PERM = true, MID = false;
    bf16_t* y; const int* list;
    __device__ __forceinline__ void operator()(const f32x4 (&acc)[2][2][4][2], const pg8::Unit& u, int wr, int wc) const {
        int ln_ = threadIdx.x & 63; asm volatile("" : "+v"(ln_)); const int fr = ln_ & 15, fq = ln_ >> 4;
        const int col0 = u.pn * 256 + wc * 32 + 8 * fq;
#pragma unroll
        for (int ai = 0; ai < 2; ++ai)
#pragma unroll
            for (int m = 0; m < 4; ++m) {
                const int rl = ai * 128 + wr * 64 + m * 16 + fr;
                if (u.r0 + rl < u.cnt) {
                    const int slot = list[u.e * 16384 + u.r0 + rl];
#pragma unroll
                    for (int bj = 0; bj < 2; ++bj) {
                        const f32x4 v0 = acc[ai][bj][m][0], v1 = acc[ai][bj][m][1];
                        u32x4 pk; pk.x = cvt_pk_bf16(v0[0], v0[1]); pk.y = cvt_pk_bf16(v0[2], v0[3]); pk.z = cvt_pk_bf16(v1[0], v1[1]); pk.w = cvt_pk_bf16(v1[2], v1[3]);
                        *(u32x4*)(y + (size_t)slot * DM + col0 + bj * 128) = pk;
                    }
                }
            }
    }
};

constexpr int MOE_TAB_OFF = 131072 + 1024;
__device__ __forceinline__ void moe_order_setup(const unsigned* cnt, LAS int* tab) {
    const int tid = threadIdx.x;
    if (tid < 64) {
        const int e = tid & 31;
        const int c = (int)cnt[e * 64];
        const int nt_ = (c + 255) >> 8;
        int inc = nt_;
#pragma unroll
        for (int o = 1; o < 32; o <<= 1) { const int t = __shfl_up(inc, o, 32); if (e >= o) inc += t; }
        if (tid < 32) { tab[e] = c; tab[32 + e] = inc - nt_; if (e == 31) tab[64] = inc; }
    }
    __syncthreads();
}
struct MoeOrder {
    const LAS int* tab; const int* list; unsigned* flags; int NN, G, c; size_t a_tile, b_exp, b_tile; bool gather; int mode; int c0;
    __device__ bool next(int i, pg8::Unit& u) const {
        const int L = (i == 0) ? c0 : i * G + c, tau = L / NN, pn = L - tau * NN;
        if (tau >= __builtin_amdgcn_readfirstlane(tab[64])) return false;
        int e = 0;
#pragma unroll 1
        for (int s = 16; s >= 1; s >>= 1) if (__builtin_amdgcn_readfirstlane(tab[32 + e + s]) <= tau) e += s;
        u.pm = tau; u.pn = pn; u.e = e; u.r0 = (tau - __builtin_amdgcn_readfirstlane(tab[32 + e])) * 256; u.cnt = __builtin_amdgcn_readfirstlane(tab[e]);
        u.aoff = gather ? 0 : (size_t)tau * a_tile; u.boff = (size_t)e * b_exp + (size_t)pn * b_tile; return true;
    }
    __device__ __forceinline__ unsigned arow(const pg8::Unit& u, int R) const {
        int r = u.r0 + R; if (r >= u.cnt) r = u.cnt - 1;
        return (unsigned)(list[u.e * 16384 + r] >> 1);
    }
    __device__ __forceinline__ void a_ready(const pg8::Unit& u) const {
        if (mode == 1) {
            unsigned* f = flags + 32 * u.pm; unsigned sp = 0;
            while (__hip_atomic_load(f, __ATOMIC_RELAXED, __HIP_MEMORY_SCOPE_AGENT) < 2u) { __builtin_amdgcn_s_sleep(4); if (++sp > (1u << 20)) break; }
            asm volatile("" ::: "memory");
        }
    }
    __device__ __forceinline__ void done(const pg8::Unit& u) const {
        if (mode == 0) {
            asm volatile("s_waitcnt vmcnt(0)" ::: "memory");
            __builtin_amdgcn_s_barrier();
            if (threadIdx.x == 0) {
                __builtin_amdgcn_fence(__ATOMIC_RELEASE, "agent");
                asm volatile("s_waitcnt vmcnt(0)" ::: "memory");
                __hip_atomic_fetch_add(flags + 32 * u.pm, 1u, __ATOMIC_RELAXED, __HIP_MEMORY_SCOPE_AGENT);
            }
        }
    }
};
constexpr int AT_K = 0, AT_V = 16384, AT_CUM = 32768, AT_WSF = 40960, AT_OST = 43008, AT_END = 43008 + 32768;
constexpr float ATT_THR = 6.0f;
__device__ __forceinline__ int crow(int r, int hi) { return (r & 3) + 8 * (r >> 2) + 4 * hi; }
typedef short v4i16_t __attribute__((ext_vector_type(4)));
__device__ __forceinline__ v4i16_t vtr(const LAS unsigned char* p) { return __builtin_amdgcn_ds_read_tr16_b64_v4i16((LAS v4i16_t*)p); }
__device__ __forceinline__ float max3f(float a, float b, float c) { return fmaxf(fmaxf(a, b), c); }

template <int MODE> __device__ __forceinline__ void att_cinit(f32x16& c0, f32x16& c1, const LAS float* cumk, int kv0, int hi, float m_run, float slope2, u32x2 mw, int qrow, bool band) {
    if (MODE == 0) {
#pragma unroll
        for (int g4 = 0; g4 < 4; ++g4) {
            const f32x4 a = *(const LAS f32x4*)(cumk + kv0 + 8 * g4 + 4 * hi), c = *(const LAS f32x4*)(cumk + kv0 + 32 + 8 * g4 + 4 * hi);
#pragma unroll
            for (int i = 0; i < 4; ++i) { c0[4 * g4 + i] = a[i] - m_run; c1[4 * g4 + i] = c[i] - m_run; }
        }
        if (band) {
#pragma unroll
            for (int r = 0; r < 16; ++r) { const int kv = kv0 + crow(r, hi); if (kv > qrow) c0[r] = -INFINITY; if (kv + 32 > qrow) c1[r] = -INFINITY; }
        }
    } else {
        const float base0 = slope2 * (float)(kv0 + 4 * hi) - m_run, base1 = base0 + slope2 * 32.f;
        const unsigned w0 = mw.x >> (4 * hi), w1 = mw.y >> (4 * hi);
#pragma unroll
        for (int r = 0; r < 16; ++r) {
            const int cr = (r & 3) + 8 * (r >> 2);
            const float v0 = fmaf(slope2, (float)cr, base0), v1 = fmaf(slope2, (float)cr, base1);
            const int t0 = ((int)(w0 << (31 - cr))) >> 31, t1 = ((int)(w1 << (31 - cr))) >> 31;
            c0[r] = __builtin_bit_cast(float, (__builtin_bit_cast(int, v0) & t0) | (int)(0xff800000u & ~(unsigned)t0));
            c1[r] = __builtin_bit_cast(float, (__builtin_bit_cast(int, v1) & t1) | (int)(0xff800000u & ~(unsigned)t1));
        }
    }
}
__device__ __forceinline__ void att_kload(bf16x8 (&kf)[8], const LAS unsigned char* kb) {
#pragma unroll
    for (int d0 = 0; d0 < 4; ++d0) { kf[2 * d0] = *(const LAS bf16x8*)(kb + d0 * 2048); kf[2 * d0 + 1] = *(const LAS bf16x8*)(kb + d0 * 2048 + 512); }
}
struct AttState { float m_run, l_run; bool started, resc; };

template <int MODE, bool FIRST, bool HAS_NEXT>
__device__ __forceinline__ void att_step(f32x16& X0, f32x16& X1, f32x16& Y0, f32x16& Y1, f32x16 (&o)[2], const bf16x8 (&qr)[4], bf16x8 (&kf)[8], AttState& st,
                                         const LAS unsigned char* vprev, const LAS unsigned char* knext, int kv0_next, u32x2 mw_next, bool band_next,
                                         const LAS float* cumk, LAS float* wsf, int r32, int hi, float slope2, int qrow) {
#pragma unroll
    for (int d0 = 0; d0 < 4; ++d0) {
        X0 = __builtin_amdgcn_mfma_f32_32x32x16_bf16(kf[2 * d0], qr[d0], X0, 0, 0, 0);
        X1 = __builtin_amdgcn_mfma_f32_32x32x16_bf16(kf[2 * d0 + 1], qr[d0], X1, 0, 0, 0);
    }
    bf16x8 pa[4];
    if (!FIRST) {
        float s0 = 0.f, s1 = 0.f, s2 = 0.f, s3 = 0.f;
#pragma unroll
        for (int r = 0; r < 16; r += 4) { s0 += Y0[r] + Y1[r]; s1 += Y0[r + 1] + Y1[r + 1]; s2 += Y0[r + 2] + Y1[r + 2]; s3 += Y0[r + 3] + Y1[r + 3]; }
        st.l_run += (s0 + s1) + (s2 + s3);
#pragma unroll
        for (int s = 0; s < 2; ++s) {
            u32x4 w0, w1;
            w0.x = pg8::cvt_pk_bf16(Y0[8 * s + 0], Y0[8 * s + 1]); w0.y = pg8::cvt_pk_bf16(Y0[8 * s + 2], Y0[8 * s + 3]); w0.z = pg8::cvt_pk_bf16(Y0[8 * s + 4], Y0[8 * s + 5]); w0.w = pg8::cvt_pk_bf16(Y0[8 * s + 6], Y0[8 * s + 7]);
            w1.x = pg8::cvt_pk_bf16(Y1[8 * s + 0], Y1[8 * s + 1]); w1.y = pg8::cvt_pk_bf16(Y1[8 * s + 2], Y1[8 * s + 3]); w1.z = pg8::cvt_pk_bf16(Y1[8 * s + 4], Y1[8 * s + 5]); w1.w = pg8::cvt_pk_bf16(Y1[8 * s + 6], Y1[8 * s + 7]);
            pa[s] = __builtin_bit_cast(bf16x8, w0); pa[2 + s] = __builtin_bit_cast(bf16x8, w1);
        }
    }
    {
        float a = max3f(X0[0], X0[1], X1[0]), c = max3f(X0[2], X0[3], X1[1]); a = max3f(a, X1[2], X1[3]);
#pragma unroll
        for (int r = 4; r < 16; r += 4) { a = max3f(a, X0[r], X0[r + 1]); c = max3f(c, X0[r + 2], X0[r + 3]); a = max3f(a, X1[r], X1[r + 1]); c = max3f(c, X1[r + 2], X1[r + 3]); }
        float rm = fmaxf(a, c); rm = fmaxf(rm, __shfl_xor(rm, 32));
        const bool bump = st.started ? (rm > ATT_THR) : (rm > -INFINITY);
        if (__any(bump)) {
            const float dl = bump ? rm : 0.f;
#pragma unroll
            for (int r = 0; r < 16; ++r) { X0[r] -= dl; X1[r] -= dl; }
            st.m_run += dl;
            const float f = (bump && st.started) ? __builtin_amdgcn_exp2f(-dl) : 1.f;
            st.l_run *= f; if (hi == 0) wsf[r32] = f; st.resc = true; st.started = st.started || bump;
        }
    }
    if (!FIRST) {
#pragma unroll
        for (int ks = 0; ks < 4; ++ks)
#pragma unroll
            for (int d0 = 0; d0 < 2; ++d0) {
                const v4i16_t lo = vtr(vprev + d0 * 4096 + ks * 1024), hh = vtr(vprev + d0 * 4096 + ks * 1024 + 512);
                const bf16x8 vf = (bf16x8){lo[0], lo[1], lo[2], lo[3], hh[0], hh[1], hh[2], hh[3]};
                o[d0] = __builtin_amdgcn_mfma_f32_32x32x16_bf16(pa[ks], vf, o[d0], 0, 0, 0);
            }
    }
#pragma unroll
    for (int r = 0; r < 16; ++r) { X0[r] = __builtin_amdgcn_exp2f(X0[r]); X1[r] = __builtin_amdgcn_exp2f(X1[r]); }
    if (HAS_NEXT) { att_kload(kf, knext); att_cinit<MODE>(Y0, Y1, cumk, kv0_next, hi, st.m_run, slope2, mw_next, qrow, band_next); }
    if (st.resc) {
#pragma unroll
        for (int g4 = 0; g4 < 4; ++g4) {
            const f32x4 fv = *(const LAS f32x4*)(wsf + 8 * g4 + 4 * hi);
#pragma unroll
            for (int i = 0; i < 4; ++i) { o[0][4 * g4 + i] *= fv[i]; o[1][4 * g4 + i] *= fv[i]; }
        }
        st.resc = false;
    }
}

template <int MODE>
__device__ __forceinline__ void attn_unit(const Params& p, int b, int h, int qb, LAS unsigned char* lds, bool do_scan) {
    int tid_ = threadIdx.x; asm volatile("" : "+v"(tid_)); const int tid = tid_, lane = tid & 63, r32 = lane & 31, hi = lane >> 5, wid = __builtin_amdgcn_readfirstlane(tid >> 6);
    const bf16_t* proj = (const bf16_t*)(p.ws + WS_PROJ);
    const int rowbase = b * SEQ, q0 = qb * 256;
    const int qcol = (MODE == 0 ? C_BQ : C_AQ) + h * 64;
    const int kcol = (MODE == 0 ? C_BK + h * 64 : C_AK + (h >> 2) * 64);
    const int vcol = (MODE == 0 ? C_BV + h * 64 : C_AV + (h >> 2) * 64);
    const int NT = (q0 + 256) / 64;
    LAS float* cumk = (LAS float*)(lds + AT_CUM);
    LAS float* wsf = (LAS float*)(lds + AT_WSF) + wid * 64;
    if (MODE == 0 && do_scan) {
        const float* lf = (const float*)(p.ws + WS_LOGF);
        const int NK = q0 + 256;
        float v[4]; float run = 0.f;
#pragma unroll
        for (int i = 0; i < 4; ++i) { const int s = 4 * tid + i; const float x = (s < NK) ? lf[(size_t)(rowbase + s) * 8 + h] : 0.f; run += x; v[i] = run; }
        float inc = run;
#pragma unroll
        for (int o = 1; o < 64; o <<= 1) { const float t = __shfl_up(inc, o); if (lane >= o) inc += t; }
        LAS float* wt = (LAS float*)(lds + AT_WSF);
        if (lane == 63) wt[wid] = inc;
        __syncthreads();
        float pre = inc - run;
        for (int w = 0; w < wid; ++w) pre += wt[w];
#pragma unroll
        for (int i = 0; i < 4; ++i) cumk[4 * tid + i] = -(pre + v[i]) * LOG2E;
        __syncthreads();
    }
    const float slope2 = (MODE == 1) ? exp2f(-(float)(h + 1)) * LOG2E : 0.f;
    const bf16_t* ksrc = proj + (size_t)(rowbase + lane) * NPROJ + kcol + wid * 8;
    const bf16_t* vsrc = proj + (size_t)(rowbase + 16 * (wid & 3) + (lane >> 2)) * NPROJ + vcol + (wid >> 2) * 32 + (lane & 3) * 8;
    const int stoff = wid * 1024 + lane * 16;
    const size_t tstride = (size_t)64 * NPROJ;
    {
        const u32x4 k0 = *(const u32x4*)(ksrc + (size_t)(NT - 1) * tstride), k1 = *(const u32x4*)(ksrc + (size_t)(NT - 2) * tstride);
        *(LAS u32x4*)(lds + AT_K + stoff) = k0; *(LAS u32x4*)(lds + AT_K + 8192 + stoff) = k1;
    }
    const int qrow = q0 + wid * 32 + r32;
    bf16x8 qr[4];
    {
        const bf16_t* qp = proj + (size_t)(rowbase + qrow) * NPROJ + qcol + hi * 8;
#pragma unroll
        for (int d0 = 0; d0 < 4; ++d0) qr[d0] = *(const bf16x8*)(qp + d0 * 16);
    }
    const unsigned* mrow = (const unsigned*)(p.ws + WS_MASK) + ((size_t)b * 32 * 2048 + qrow) * 2;
    __syncthreads();
    AttState st; st.m_run = 0.f; st.l_run = 0.f; st.started = false; st.resc = false;
    f32x16 o[2]; o[0] = f32x16{}; o[1] = f32x16{};
    f32x16 A0, A1, B0, B1; A0 = f32x16{}; A1 = f32x16{}; B0 = f32x16{}; B1 = f32x16{};
    bf16x8 kf[8];
    const int wq_lo = q0 + wid * 32;
    const LAS unsigned char* kfrag = lds + AT_K + hi * 1024 + r32 * 16;
    const LAS unsigned char* vfrag = lds + AT_V + ((lane >> 4) & 1) * 32 + (lane & 3) * 8 + (4 * hi + ((lane & 15) >> 2)) * 64;
    {
        att_kload(kf, kfrag);
        u32x2 mw = (u32x2){0u, 0u}; if (MODE == 1) mw = *(const u32x2*)(mrow + (size_t)(NT - 1) * 4096);
        att_cinit<MODE>(A0, A1, cumk, 64 * (NT - 1), hi, 0.f, slope2, mw, qrow, true);
    }
    LDS_BARRIER();
#define ATT_ITER(U, FIRST_, NEXT_, X0, X1, Y0, Y1) do { const int u = (U); \
        int tk = NT - 3 - u; tk = tk < 0 ? 0 : tk; \
        const u32x4 kreg = *(const u32x4*)(ksrc + (size_t)tk * tstride); \
        const u32x4 vreg = *(const u32x4*)(vsrc + (size_t)(NT - 1 - u) * tstride); \
        int tn = NT - 2 - u; tn = tn < 0 ? 0 : tn; \
        u32x2 mwn = (u32x2){0u, 0u}; \
        if (MODE == 1) mwn = *(const u32x2*)(mrow + (size_t)tn * 4096); \
        const LAS unsigned char* vprev = vfrag + ((u - 1) & 1) * 8192; \
        const LAS unsigned char* knext = kfrag + ((u + 1) & 1) * 8192; \
        att_step<MODE, FIRST_, NEXT_>(X0, X1, Y0, Y1, o, qr, kf, st, vprev, knext, 64 * tn, mwn, (64 * tn + 63 > wq_lo), cumk, wsf, r32, hi, slope2, qrow); \
        *(LAS u32x4*)(lds + AT_K + (u & 1) * 8192 + stoff) = kreg; \
        *(LAS u32x4*)(lds + AT_V + (u & 1) * 8192 + stoff) = vreg; \
        LDS_BARRIER(); } while (0)
    ATT_ITER(0, true, true, A0, A1, B0, B1);
    for (int uu = 1; uu < NT - 1; uu += 2) {
        ATT_ITER(uu, false, true, B0, B1, A0, A1);
        ATT_ITER(uu + 1, false, true, A0, A1, B0, B1);
    }
    ATT_ITER(NT - 1, false, false, B0, B1, A0, A1);
#undef ATT_ITER
    {
        const f32x16 Y0 = B0, Y1 = B1;
        float s0 = 0.f, s1 = 0.f;
#pragma unroll
        for (int r = 0; r < 16; r += 2) { s0 += Y0[r] + Y1[r]; s1 += Y0[r + 1] + Y1[r + 1]; }
        st.l_run += s0 + s1;
        const LAS unsigned char* vprev = vfrag + ((NT - 1) & 1) * 8192;
#pragma unroll
        for (int s = 0; s < 4; ++s) {
            u32x4 w;
            if (s < 2) { w.x = pg8::cvt_pk_bf16(Y0[8 * s + 0], Y0[8 * s + 1]); w.y = pg8::cvt_pk_bf16(Y0[8 * s + 2], Y0[8 * s + 3]); w.z = pg8::cvt_pk_bf16(Y0[8 * s + 4], Y0[8 * s + 5]); w.w = pg8::cvt_pk_bf16(Y0[8 * s + 6], Y0[8 * s + 7]); }
            else { const int q = s - 2; w.x = pg8::cvt_pk_bf16(Y1[8 * q + 0], Y1[8 * q + 1]); w.y = pg8::cvt_pk_bf16(Y1[8 * q + 2], Y1[8 * q + 3]); w.z = pg8::cvt_pk_bf16(Y1[8 * q + 4], Y1[8 * q + 5]); w.w = pg8::cvt_pk_bf16(Y1[8 * q + 6], Y1[8 * q + 7]); }
            const bf16x8 pa = __builtin_bit_cast(bf16x8, w);
#pragma unroll
            for (int d0 = 0; d0 < 2; ++d0) {
                const v4i16_t lo = vtr(vprev + d0 * 4096 + s * 1024), hh = vtr(vprev + d0 * 4096 + s * 1024 + 512);
                const bf16x8 vf = (bf16x8){lo[0], lo[1], lo[2], lo[3], hh[0], hh[1], hh[2], hh[3]};
                o[d0] = __builtin_amdgcn_mfma_f32_32x32x16_bf16(pa, vf, o[d0], 0, 0, 0);
            }
        }
    }
    float l_run = st.l_run;
    l_run += __shfl_xor(l_run, 32);
    if (hi == 0) wsf[32 + r32] = l_run;
    float rli[16];
#pragma unroll
    for (int g4 = 0; g4 < 4; ++g4) {
        const f32x4 lv = *(const LAS f32x4*)(wsf + 32 + 8 * g4 + 4 * hi);
#pragma unroll
        for (int i = 0; i < 4; ++i) rli[4 * g4 + i] = 1.f / lv[i];
    }
    LAS bf16_t* stg = (LAS bf16_t*)(lds + AT_OST) + wid * 2048;
#pragma unroll
    for (int r = 0; r < 16; ++r) {
        const int orow = crow(r, hi);
#pragma unroll
        for (int d0 = 0; d0 < 2; ++d0) stg[orow * 64 + d0 * 32 + r32] = (bf16_t)f2bf(o[d0][r] * rli[r]);
    }
    bf16_t* O = (bf16_t*)(p.ws + WS_O);
    float* ssq = (float*)(p.ws + WS_SSQ);
    const int ocol = (MODE == 1 ? 0 : 512) + h * 64, slot = (MODE == 1 ? 0 : 8) + h;
#pragma unroll
    for (int i = 0; i < 4; ++i) {
        const int row = i * 8 + (lane >> 3), ch = lane & 7;
        const u32x4 v = *(const LAS u32x4*)(stg + row * 64 + ch * 8);
        const size_t grow = (size_t)(rowbase + q0 + wid * 32 + row);
        *(u32x4*)(O + grow * DM + ocol + ch * 8) = v;
        float q = 0.f;
#pragma unroll
        for (int j = 0; j < 4; ++j) { const float a = bf2f((unsigned short)(v[j] & 0xffff)), c = bf2f((unsigned short)(v[j] >> 16)); q += a * a + c * c; }
        q += __shfl_xor(q, 1); q += __shfl_xor(q, 2); q += __shfl_xor(q, 4);
        if (ch == 0) ssq[grow * 16 + slot] = q;
    }
    LDS_BARRIER();
}
constexpr int IX_SC = 0, IX_HIST = 131072, IX_CAND = 131072 + 2048, IX_END = 131072 + 4096;
#define IX_DPP(OP, ctrl, rm) v = OP(v, __builtin_bit_cast(float, __builtin_amdgcn_update_dpp(__builtin_bit_cast(int, v), __builtin_bit_cast(int, v), ctrl, rm, 0xf, false)))
__device__ __forceinline__ float wave_maxf(float v) {
    IX_DPP(fmaxf, 0x111, 0xf); IX_DPP(fmaxf, 0x112, 0xf); IX_DPP(fmaxf, 0x114, 0xf); IX_DPP(fmaxf, 0x118, 0xf); IX_DPP(fmaxf, 0x142, 0xa); IX_DPP(fmaxf, 0x143, 0xc);
    return __builtin_bit_cast(float, __builtin_amdgcn_readlane(__builtin_bit_cast(int, v), 63));
}
__device__ __forceinline__ float wave_minf(float v) {
    IX_DPP(fminf, 0x111, 0xf); IX_DPP(fminf, 0x112, 0xf); IX_DPP(fminf, 0x114, 0xf); IX_DPP(fminf, 0x118, 0xf); IX_DPP(fminf, 0x142, 0xa); IX_DPP(fminf, 0x143, 0xc);
    return __builtin_bit_cast(float, __builtin_amdgcn_readlane(__builtin_bit_cast(int, v), 63));
}
#undef IX_DPP
struct IxOps { bf16x8 aq[2][4]; bf16x8 kf[2][4]; };
__device__ __forceinline__ void ix_prefetch(IxOps& X, const bf16_t* proj, const unsigned char* ikf, int rowbase, int t0, int wid, int r32, int hi) {
    const int i = r32, qi = 2 * ((i >> 2) & 1) + (i >> 4), head = 4 * ((i >> 3) & 1) + (i & 3);
#pragma unroll
    for (int g = 0; g < 2; ++g) {
        const bf16_t* ap = proj + (size_t)(rowbase + t0 + 4 * g + qi) * NPROJ + C_IQ + head * 64 + hi * 8;
#pragma unroll
        for (int d0 = 0; d0 < 4; ++d0) X.aq[g][d0] = *(const bf16x8*)(ap + d0 * 16);
    }
    const int NTI = (t0 + 7) / 32 + 1;
#pragma unroll
    for (int q = 0; q < 2; ++q) {
        const int j = wid + 8 * q;
        if (j < NTI) {
            const unsigned char* kp = ikf + ((size_t)((rowbase >> 5) + j) << 12) + r32 * 32 + hi * 16;
#pragma unroll
            for (int d0 = 0; d0 < 4; ++d0) X.kf[q][d0] = *(const bf16x8*)(kp + d0 * 1024);
        }
    }
}
__device__ __forceinline__ void ix_tile(const bf16x8 (&aq)[2][4], const bf16x8 (&kf)[4], const float (&wq)[2][2][8], LAS float* sc, int key, int hi) {
#pragma unroll
    for (int g = 0; g < 2; ++g) {
        f32x16 d = f32x16{};
#pragma unroll
        for (int d0 = 0; d0 < 4; ++d0) d = __builtin_amdgcn_mfma_f32_32x32x16_bf16(aq[g][d0], kf[d0], d, 0, 0, 0);
#pragma unroll
        for (int a = 0; a < 2; ++a) {
            float sv = 0.f;
#pragma unroll
            for (int hh = 0; hh < 8; ++hh) sv += wq[g][a][hh] * fmaxf(d[8 * a + hh], 0.f);
            sc[(4 * g + 2 * hi + a) * 2048 + key] = sv;
        }
    }
}
__device__ __forceinline__ void ix_score(const IxOps& X, const Params& p, int rowbase, int t0, LAS float* sc, int wid, int r32, int hi) {
    const unsigned char* ikf = p.ws + WS_IKF;
    const float* iwp = (const float*)(p.ws + WS_IW);
    const int NTI = (t0 + 7) / 32 + 1;
    float wq[2][2][8];
#pragma unroll
    for (int g = 0; g < 2; ++g)
#pragma unroll
        for (int a = 0; a < 2; ++a) {
            const float* wp = iwp + (size_t)(rowbase + t0 + 4 * g + 2 * hi + a) * 8;
            const f32x4 w0 = *(const f32x4*)wp, w1 = *(const f32x4*)(wp + 4);
#pragma unroll
            for (int j = 0; j < 4; ++j) { wq[g][a][j] = w0[j]; wq[g][a][4 + j] = w1[j]; }
        }
    bf16x8 cur[2][4], nxt[2][4];
#pragma unroll
    for (int q = 0; q < 2; ++q)
#pragma unroll
        for (int d0 = 0; d0 < 4; ++d0) { cur[q][d0] = X.kf[q][d0]; nxt[q][d0] = X.kf[q][d0]; }
#pragma unroll 1
    for (int bb = 0; bb < 4; ++bb) {
        if (wid + 16 * bb >= NTI) break;
#pragma unroll
        for (int q = 0; q < 2; ++q) {
            const int j = wid + 16 * (bb + 1) + 8 * q;
            if (bb < 3 && j < NTI) {
                const unsigned char* kp = ikf + ((size_t)((rowbase >> 5) + j) << 12) + r32 * 32 + hi * 16;
#pragma unroll
                for (int d0 = 0; d0 < 4; ++d0) nxt[q][d0] = *(const bf16x8*)(kp + d0 * 1024);
            }
        }
#pragma unroll
        for (int q = 0; q < 2; ++q) { const int j = wid + 16 * bb + 8 * q; if (j < NTI) ix_tile(X.aq, cur[q], wq, sc, 32 * j + r32, hi); }
#pragma unroll
        for (int q = 0; q < 2; ++q)
#pragma unroll
            for (int d0 = 0; d0 < 4; ++d0) cur[q][d0] = nxt[q][d0];
    }
}

template <int NR>
__device__ __forceinline__ int ix_count_ge(const float (&val)[NR], float piv, unsigned& accw) {
    unsigned acc = 0u;
    f32x2 pp; pp.x = piv; pp.y = piv;
#pragma unroll
    for (int i = 0; i < NR; i += 2) {
        f32x2 a; a.x = val[i]; a.y = val[i + 1];
        const f32x2 d = a - pp; const float dx = d.x, dy = d.y;
        acc = __builtin_amdgcn_alignbit(acc, __builtin_bit_cast(unsigned, dx), 31);
        acc = __builtin_amdgcn_alignbit(acc, __builtin_bit_cast(unsigned, dy), 31);
    }
    accw = acc;
    const int cl = NR - __popc(acc);
    int tot = 0;
#pragma unroll
    for (int b = 0; b < 6; ++b) tot += __popcll(__ballot((cl >> b) & 1)) << b;
    return tot;
}
template <int NR>
__device__ __forceinline__ void ix_select_impl(const LAS float* myv, LAS unsigned* hist, LAS float* cand, unsigned* mrow, int n, int lane) {
    float val[NR];
#pragma unroll
    for (int i = 0; i < NR; ++i) { const int key = 64 * i + lane; const float x = myv[key]; val[i] = (key < n) ? x : -INFINITY; }
    float vmax = -INFINITY, vmin = INFINITY;
#pragma unroll
    for (int i = 0; i < NR; ++i) { vmax = fmaxf(vmax, val[i]); vmin = fminf(vmin, (val[i] == -INFINITY) ? INFINITY : val[i]); }
    float lo = wave_minf(vmin); const float top0 = wave_maxf(vmax);
    float ub = INFINITY;
    const int k = 256;
    int cge_lo = n, cge_ub = 0;
    const int nv = (n - lane + 63) >> 6;
    unsigned acc_lo = (1u << (NR - nv)) - 1u, acc_ub = (NR == 32) ? 0xffffffffu : ((1u << (NR & 31)) - 1u);
    float vstar = lo; int rprime = k; bool ties = true;
    const unsigned long long ltmask = (lane == 0) ? 0ull : (~0ull >> (64 - lane));
#pragma unroll 1
    for (int iter = 0; iter < 200; ++iter) {
        const int c = cge_lo - cge_ub;
        if (c <= 64) {
            const int kr = k - cge_ub;
            unsigned B = ~acc_lo & acc_ub;
            const int pc = __popc(B);
            int slot = 0;
#pragma unroll
            for (int b = 0; b < 6; ++b) {
                const unsigned long long bm = __ballot((pc >> b) & 1);
                slot += (int)__builtin_amdgcn_mbcnt_hi((unsigned)(bm >> 32), __builtin_amdgcn_mbcnt_lo((unsigned)bm, 0u)) << b;
            }
            cand[lane] = -INFINITY;
            while (__any(B != 0u)) {
                if (B != 0u) { const int j = __ffs((int)B) - 1; cand[slot] = myv[64 * (NR - 1 - j) + lane]; ++slot; B &= B - 1u; }
            }
            const float mine = cand[lane];
            int gt = 0, ge = 0;
#pragma unroll 1
            for (int jj = 0; jj < c; jj += 16) {
                f32x4 x[4];
#pragma unroll
                for (int q = 0; q < 4; ++q) x[q] = *(const LAS f32x4*)(cand + jj + 4 * q);
#pragma unroll
                for (int q = 0; q < 4; ++q)
#pragma unroll
                    for (int e = 0; e < 4; ++e) { gt += (x[q][e] > mine) ? 1 : 0; ge += (x[q][e] >= mine) ? 1 : 0; }
            }
            const bool ok = (lane < c) && (gt < kr) && (kr <= ge);
            const unsigned long long om = __ballot(ok);
            const int L2 = om ? (__ffsll((long long)om) - 1) : 0;
            vstar = __builtin_bit_cast(float, __builtin_amdgcn_readlane(__builtin_bit_cast(int, mine), L2));
            const int gtl = __builtin_amdgcn_readlane(gt, L2), gel = __builtin_amdgcn_readlane(ge, L2);
            rprime = kr - gtl; ties = (gel - gtl) != rprime;
            break;
        }
        const float top = (ub == INFINITY) ? top0 : ub;
        const float mid = lo + (top - lo) * 0.5f;
        if (!(mid > lo) || !(mid < top)) {
            unsigned dummy;
            if (ub == INFINITY && top0 > lo) {
                const int m = ix_count_ge<NR>(val, top0, dummy);
                if (m >= k) { vstar = top0; rprime = k; } else { vstar = lo; rprime = k - m; }
            } else { vstar = lo; rprime = k - cge_ub; }
            ties = true;
            break;
        }
        unsigned aw;
        const int cnt = ix_count_ge<NR>(val, mid, aw);
        if (cnt >= k) { lo = mid; cge_lo = cnt; acc_lo = aw; } else { ub = mid; cge_ub = cnt; acc_ub = aw; }
    }
    LAS unsigned long long* mw = (LAS unsigned long long*)hist;
    unsigned wlo = 0u, whi = 0u;
    if (!ties) {
#define IX_WL(i) if (i < NR) { const unsigned long long sm = __ballot(val[i < NR ? i : 0] >= vstar); \
            asm volatile("s_nop 1\n\tv_writelane_b32 %0, %1, " #i : "+v"(wlo) : "s"((unsigned)sm)); asm volatile("v_writelane_b32 %0, %1, " #i : "+v"(whi) : "s"((unsigned)(sm >> 32))); }
        IX_WL(0) IX_WL(1) IX_WL(2) IX_WL(3) IX_WL(4) IX_WL(5) IX_WL(6) IX_WL(7) IX_WL(8) IX_WL(9) IX_WL(10) IX_WL(11) IX_WL(12) IX_WL(13) IX_WL(14) IX_WL(15)
        IX_WL(16) IX_WL(17) IX_WL(18) IX_WL(19) IX_WL(20) IX_WL(21) IX_WL(22) IX_WL(23) IX_WL(24) IX_WL(25) IX_WL(26) IX_WL(27) IX_WL(28) IX_WL(29) IX_WL(30) IX_WL(31)
#undef IX_WL
    } else {
        int run = 0;
#pragma unroll
        for (int i = 0; i < NR; ++i) {
            const float v = val[i];
            const bool eq = (v == vstar);
            const unsigned long long em = __ballot(eq);
            const bool sel = (v > vstar) || (eq && (run + __popcll(em & ltmask)) < rprime);
            run += __popcll(em);
            const unsigned long long sm = __ballot(sel);
            if (lane == 0) mw[i] = sm;
        }
    }
    if (ties && lane < NR) { const unsigned long long w = mw[lane < NR ? lane : 0]; wlo = (unsigned)w; whi = (unsigned)(w >> 32); }
    if (lane < 32) *(unsigned long long*)(mrow + (size_t)lane * 4096) = ((unsigned long long)whi << 32) | wlo;
}
__device__ __forceinline__ void ix_select(const LAS float* myv, LAS unsigned* hist, LAS float* cand, unsigned* mrow, int n, int lane) {
    const int nact = (n + 63) >> 6;
    if (nact <= 8) ix_select_impl<8>(myv, hist, cand, mrow, n, lane);
    else if (nact <= 16) ix_select_impl<16>(myv, hist, cand, mrow, n, lane);
    else if (nact <= 24) ix_select_impl<24>(myv, hist, cand, mrow, n, lane);
    else ix_select_impl<32>(myv, hist, cand, mrow, n, lane);
}

__device__ __forceinline__ int ix_unit_t0(int i, int j) { return 8 * (32 + 32 * i + ((i & 1) ? 31 - j : j)); }
__device__ __forceinline__ void indexer_wg(const Params& p, int b, int j, LAS unsigned char* lds) {
    int tid_ = threadIdx.x; asm volatile("" : "+v"(tid_)); const int tid = tid_, lane = tid & 63, r32 = lane & 31, hi = lane >> 5, wid = __builtin_amdgcn_readfirstlane(tid >> 6);
    const bf16_t* proj = (const bf16_t*)(p.ws + WS_PROJ);
    const int rowbase = b * SEQ;
    LAS unsigned* hist = (LAS unsigned*)(lds + IX_HIST) + wid * 64;
    LAS float* cand = (LAS float*)(lds + IX_CAND) + wid * 64;
    IxOps X;
    ix_prefetch(X, proj, p.ws + WS_IKF, rowbase, ix_unit_t0(6, j), wid, r32, hi);
    const int xstride = (int)gridDim.x * 8; int xr = (int)blockIdx.x * 8 + wid; int xleft = 7;
    for (int i = 6; i >= 0; --i) {
        const int t0 = ix_unit_t0(i, j);
        LAS float* sc = (LAS float*)(lds + IX_SC) + (i & 1) * (8 * 2048);
        LAS float* sco = (LAS float*)(lds + IX_SC) + ((i + 1) & 1) * (8 * 2048);
        const bool xi = (xleft > 0) && (xr < NXITEMS);
        const TItem xt = txitem(p, xi ? xr : 0);
        if (xi) titem_dma_issue(xt, lane, sco + wid * 2048);
        ix_score(X, p, rowbase, t0, sc, wid, r32, hi);
        if (xi) { asm volatile("s_waitcnt vmcnt(0)" ::: "memory"); titem_dma_finish(xt, lane, sco + wid * 2048); xr += xstride; --xleft; }
        LDS_BARRIER();
        if (i > 0) ix_prefetch(X, proj, p.ws + WS_IKF, rowbase, ix_unit_t0(i - 1, j), wid, r32, hi);
        const int t = t0 + wid;
        ix_select(sc + wid * 2048, hist, cand, (unsigned*)(p.ws + WS_MASK) + ((size_t)b * 32 * 2048 + t) * 2, t + 1, lane);
    }
    __syncthreads();
}

__device__ __forceinline__ void trivial_mask_rows(const Params& p) {
    unsigned* mask = (unsigned*)(p.ws + WS_MASK);
    const int G = gridDim.x;
    for (int i = blockIdx.x * 512 + threadIdx.x; i < BATCH * 256 * 64; i += G * 512) {
        const int t = i & 255, w = (i >> 8) & 63, b = i >> 14;
        unsigned v;
        if (32 * w + 31 <= t) v = 0xffffffffu; else if (32 * w > t) v = 0u; else v = (1u << (t - 32 * w + 1)) - 1u;
        mask[((size_t)(b * 32 + (w >> 1)) * 2048 + t) * 2 + (w & 1)] = v;
    }
}
constexpr int RT_LG = 0;
constexpr int RT_CNT = 98304;
struct RtStage { f32x4 aa, ab, ca, cb; bf16x8 fh[3], fl[3]; };
__device__ __forceinline__ void rt_load(RtStage& S, const float* ma, const float* mc, const bf16_t* bh, const bf16_t* bl, int k) {
    S.aa = *(const f32x4*)(ma + k); S.ab = *(const f32x4*)(ma + k + 4); S.ca = *(const f32x4*)(mc + k); S.cb = *(const f32x4*)(mc + k + 4);
#pragma unroll
    for (int nb = 0; nb < 3; ++nb) { S.fh[nb] = *(const bf16x8*)(bh + (size_t)nb * 16 * 1024 + k); S.fl[nb] = *(const bf16x8*)(bl + (size_t)nb * 16 * 1024 + k); }
}
__device__ __forceinline__ void router_phase(const Params& p, LAS unsigned char* lds) {
    int tid_ = threadIdx.x; asm volatile("" : "+v"(tid_)); const int tid = tid_, lane = tid & 63, wid = __builtin_amdgcn_readfirstlane(tid >> 6), G = gridDim.x;
    const float* x1 = p.out; const float* x1ssq = (const float*)(p.ws + WS_X1SSQ); const float* mod2 = (const float*)(p.ws + WS_MOD2);
    bf16_t* H2 = (bf16_t*)(p.ws + WS_H);
    const bf16_t* wrh = (const bf16_t*)(p.ws + WS_WR); const bf16_t* wrl = wrh + 48 * 1024;
    unsigned* cnt = (unsigned*)(p.ws + WS_CNT); int* list = (int*)(p.ws + WS_LIST); float* rw = (float*)(p.ws + WS_RW);
    const int iters = (NTOK / 64 + G - 1) / G;
    for (int it = 0; it < iters; ++it) {
        int ln_ = lane; asm volatile("" : "+v"(ln_)); const int row = ln_ & 15, kq = ln_ >> 4;
        const int wu = it * G + blockIdx.x;
        const bool active = wu < NTOK / 64;
        if (active) {
            const int tok0 = 64 * wu, b = tok0 >> 11, kw = 128 * wid + 8 * kq;
            const bf16_t* xr = (const bf16_t*)x1 + (size_t)(tok0 + row) * (2 * DM) + kw;
            u32x4 xs[2][4];
#pragma unroll
            for (int tb = 0; tb < 4; ++tb) xs[0][tb] = __builtin_nontemporal_load((const u32x4*)(xr + (size_t)tb * 16 * 2 * DM));
            float rstd[4];
#pragma unroll
            for (int tb = 0; tb < 4; ++tb) {
                const f32x4 a = *((const f32x4*)(x1ssq + (size_t)(tok0 + 16 * tb + row) * 16) + kq);
                float q = (a[0] + a[1]) + (a[2] + a[3]);
                q += __shfl_xor(q, 16); q += __shfl_xor(q, 32);
                rstd[tb] = 1.f / sqrtf(q * (1.f / DM) + EPS);
            }
            f32x4 acc[4][3];
#pragma unroll
            for (int tb = 0; tb < 4; ++tb) { acc[tb][0] = f32x4{}; acc[tb][1] = f32x4{}; acc[tb][2] = f32x4{}; }
            const float* ma = mod2 + (size_t)(b * 2) * 1024 + kw; const float* mc = ma + 1024;
            const bf16_t* bh = wrh + (size_t)row * 1024 + kw; const bf16_t* bl = wrl + (size_t)row * 1024 + kw;
            RtStage S0, S1;
            rt_load(S0, ma, mc, bh, bl, 0);
#pragma unroll
            for (int s = 0; s < 4; ++s) {
                const int k = 32 * s;
                if (s + 1 < 4) rt_load(S1, ma, mc, bh, bl, k + 32);
                if (s + 1 < 4) {
#pragma unroll
                    for (int tb = 0; tb < 4; ++tb) xs[(s + 1) & 1][tb] = __builtin_nontemporal_load((const u32x4*)(xr + (size_t)tb * 16 * 2 * DM + 32 * (s + 1)));
                }
#pragma unroll
                for (int tb = 0; tb < 4; ++tb) {
                    const u32x4 xw = xs[s & 1][tb];
                    const f32x4 xa = (f32x4){__builtin_bit_cast(float, xw.x << 16), __builtin_bit_cast(float, xw.x & 0xffff0000u), __builtin_bit_cast(float, xw.y << 16), __builtin_bit_cast(float, xw.y & 0xffff0000u)};
                    const f32x4 xb = (f32x4){__builtin_bit_cast(float, xw.z << 16), __builtin_bit_cast(float, xw.z & 0xffff0000u), __builtin_bit_cast(float, xw.w << 16), __builtin_bit_cast(float, xw.w & 0xffff0000u)};
                    const f32x4 ha = xa * rstd[tb] * S0.aa + S0.ca, hb = xb * rstd[tb] * S0.ab + S0.cb;
                    u32x4 w; w.x = pg8::cvt_pk_bf16(ha[0], ha[1]); w.y = pg8::cvt_pk_bf16(ha[2], ha[3]); w.z = pg8::cvt_pk_bf16(hb[0], hb[1]); w.w = pg8::cvt_pk_bf16(hb[2], hb[3]);
                    *(u32x4*)(H2 + (size_t)(tok0 + 16 * tb + row) * DM + kw + k) = w;
                    const bf16x8 af = __builtin_bit_cast(bf16x8, w);
                    u32x4 wl;
                    wl.x = pg8::cvt_pk_bf16(ha[0] - __builtin_bit_cast(float, w.x << 16), ha[1] - __builtin_bit_cast(float, w.x & 0xffff0000u));
                    wl.y = pg8::cvt_pk_bf16(ha[2] - __builtin_bit_cast(float, w.y << 16), ha[3] - __builtin_bit_cast(float, w.y & 0xffff0000u));
                    wl.z = pg8::cvt_pk_bf16(hb[0] - __builtin_bit_cast(float, w.z << 16), hb[1] - __builtin_bit_cast(float, w.z & 0xffff0000u));
                    wl.w = pg8::cvt_pk_bf16(hb[2] - __builtin_bit_cast(float, w.w << 16), hb[3] - __builtin_bit_cast(float, w.w & 0xffff0000u));
                    const bf16x8 al = __builtin_bit_cast(bf16x8, wl);
#pragma unroll
                    for (int nb = 0; nb < 3; ++nb) {
                        acc[tb][nb] = __builtin_amdgcn_mfma_f32_16x16x32_bf16(af, S0.fh[nb], acc[tb][nb], 0, 0, 0);
                        acc[tb][nb] = __builtin_amdgcn_mfma_f32_16x16x32_bf16(af, S0.fl[nb], acc[tb][nb], 0, 0, 0);
                        acc[tb][nb] = __builtin_amdgcn_mfma_f32_16x16x32_bf16(al, S0.fh[nb], acc[tb][nb], 0, 0, 0);
                    }
                }
                S0 = S1;
            }
#pragma unroll
            for (int tb = 0; tb < 4; ++tb) {
                LAS float* lg = (LAS float*)(lds + RT_LG) + (wid * 4 + tb) * 768;
#pragma unroll
                for (int nb = 0; nb < 3; ++nb)
#pragma unroll
                    for (int i = 0; i < 4; ++i) lg[(4 * kq + i) * 48 + 16 * nb + row] = acc[tb][nb][i];
            }
        }
        LDS_BARRIER();
        LAS unsigned* lcnt = (LAS unsigned*)(lds + RT_CNT);
        if (tid < 64) lcnt[tid] = 0u;
        LDS_BARRIER();
        int ea = 0, eb = 0, tk = 0; unsigned la = 0, lb = 0; float w1 = 0.f, w2 = 0.f; bool act = false;
        if (wid == 0) {
            const int pr = lane >> 4, tl = lane & 15;
            act = active;
            if (act) {
                const LAS float* l0 = (const LAS float*)(lds + RT_LG) + pr * 768 + tl * 48;
                tk = 64 * wu + 16 * pr + tl;
                float gl[4]; int gs = 0; float gmax;
#pragma unroll
                for (int j = 0; j < 4; ++j) { float s = p.b_group[j];
#pragma unroll
                    for (int w8 = 0; w8 < 8; ++w8) s += l0[w8 * 3072 + j];
                    gl[j] = s; }
                gmax = gl[0];
#pragma unroll
                for (int j = 1; j < 4; ++j) if (gl[j] > gmax) { gmax = gl[j]; gs = j; }
                float den = 0.f;
#pragma unroll
                for (int j = 0; j < 4; ++j) den += __expf(gl[j] - gmax);
                const float pg = 1.f / den;
                float v1 = -INFINITY, v2 = -INFINITY; int i1 = 0, i2 = 0;
#pragma unroll
                for (int j = 0; j < 8; ++j) {
                    float ev = p.b_router[gs * 8 + j];
#pragma unroll
                    for (int w8 = 0; w8 < 8; ++w8) ev += l0[w8 * 3072 + 16 + 8 * gs + j];
                    if (ev > v1) { v2 = v1; i2 = i1; v1 = ev; i1 = j; } else if (ev > v2) { v2 = ev; i2 = j; }
                }
                const float e2 = __expf(v2 - v1);
                w1 = pg / (1.f + e2); w2 = pg * e2 / (1.f + e2);
                ea = gs * 8 + i1; eb = gs * 8 + i2;
                la = __hip_atomic_fetch_add(lcnt + ea, 1u, __ATOMIC_RELAXED, __HIP_MEMORY_SCOPE_WORKGROUP);
                lb = __hip_atomic_fetch_add(lcnt + eb, 1u, __ATOMIC_RELAXED, __HIP_MEMORY_SCOPE_WORKGROUP);
            }
            int ln2 = lane; asm volatile("" : "+v"(ln2));
            if (ln2 < 32) { const unsigned c = lcnt[ln2]; unsigned base = 0u; if (c) base = atomicAdd(cnt + ln2 * 64, c); lcnt[32 + ln2] = base; }
            if (act) {
                const unsigned sa = lcnt[32 + ea] + la, sb = lcnt[32 + eb] + lb;
                list[ea * 16384 + sa] = tk * 2; list[eb * 16384 + sb] = tk * 2 + 1;
                rw[tk * 2] = w1; rw[tk * 2 + 1] = w2;
            }
        }
        LDS_BARRIER();
    }
}
constexpr int MISC_OFF = LDS_BYTES - 64;
__device__ __forceinline__ int vb_of(LAS unsigned char* lds) { return __builtin_amdgcn_readfirstlane(((volatile LAS int*)(lds + MISC_OFF))[4]); }
__device__ __forceinline__ int vcu_of(LAS unsigned char* lds) { return __builtin_amdgcn_readfirstlane(((volatile LAS int*)(lds + MISC_OFF))[5]); }
__device__ __forceinline__ void phase1_inproj(const Params& p, LAS unsigned char* lds) {
    pg8::Gemm g{(const bf16_t*)(p.ws + WS_H), (const bf16_t*)(p.ws + WS_WIN), 1024};
    pg8::StaticOrder S; S.init(NTOK, NPROJ, 1024, gridDim.x, vb_of(lds));
    EpiProj E{(bf16_t*)(p.ws + WS_PROJ), (float*)(p.ws + WS_IW), (float*)(p.ws + WS_LOGF), p.b_forget, p.ws + WS_IKF};
    pg8::gemm_phase<EpiProj, pg8::StaticOrder, false>(lds, g, S, E);
}
template <int MODE> __device__ __forceinline__ void attn_phase(const Params& p, LAS unsigned char* lds) {
    const int G = gridDim.x;
    for (int v = vcu_of(lds); v < 256; v += G) {
        const int bh = v >> 2, s = v & 3;
        attn_unit<MODE>(p, bh >> 3, bh & 7, 7 - s, lds, true);
        attn_unit<MODE>(p, bh >> 3, bh & 7, s, lds, false);
    }
}
__device__ __forceinline__ void indexer_phase(const Params& p, LAS unsigned char* lds) {
    const int G = gridDim.x;
    for (int v = vcu_of(lds); v < 256; v += G) indexer_wg(p, v >> 5, v & 31, lds);
    {
        __syncthreads();
        int tid_ = threadIdx.x; asm volatile("" : "+v"(tid_)); const int lane = tid_ & 63, wave = tid_ >> 6;
        LAS float* scr = (LAS float*)(lds + wave * 8704);
        const int done = (vcu_of(lds) < 256) ? 7 : 0;
        float tv[32];
        for (int xr = ((done * G + (int)blockIdx.x) * 8 + wave); xr < NXITEMS; xr += G * 8) { const TItem t = txitem(p, xr); titem_load(t, lane, tv); titem_store(t, lane, tv, scr); }
    }
    trivial_mask_rows(p);
}
__device__ __forceinline__ void phase4_outproj(const Params& p, LAS unsigned char* lds) {
    pg8::Gemm g{(const bf16_t*)(p.ws + WS_O), (const bf16_t*)(p.ws + WS_WOUT), 1024};
    pg8::StaticOrder S; S.init(NTOK, DM, 1024, gridDim.x, vb_of(lds));
    EpiOut E{p.x, p.out, (const float*)(p.ws + WS_MOD), (const float*)(p.ws + WS_SSQ), (float*)(p.ws + WS_X1SSQ)};
    pg8::gemm_phase<EpiOut, pg8::StaticOrder, false>(lds, g, S, E);
}
__device__ __forceinline__ void phase_moe(const Params& p, LAS unsigned char* lds) {
    LAS int* tab = (LAS int*)(lds + MOE_TAB_OFF); moe_order_setup((const unsigned*)(p.ws + WS_CNT), tab);
    unsigned* flags = (unsigned*)(p.ws + WS_TFLAG);
    const int G = gridDim.x, c = vb_of(lds), cx = vcu_of(lds);
    {
        pg8::Gemm g{(const bf16_t*)(p.ws + WS_H), (const bf16_t*)(p.ws + WS_WGU), 1024};
        MoeOrder S{tab, (const int*)(p.ws + WS_LIST), flags, 2, G, c, 0, (size_t)512 * 1024 * 2, (size_t)256 * 1024 * 2, true, 0, cx};
        EpiAct E{(bf16_t*)(p.ws + WS_ACT), (const int*)(p.ws + WS_LIST), (const float*)(p.ws + WS_RW)};
        pg8::gemm_phase<EpiAct, MoeOrder, true>(lds, g, S, E);
    }
    {
        const int T = __builtin_amdgcn_readfirstlane(tab[64]);
        const int n2 = (2 * T > G && 2 * T < 2 * G) ? 2 * T - G : 0;
        const int x_ = c & 7, r_ = c >> 3, G8 = G >> 3;
        int lidx = 0;
        for (int xx = 0; xx < 8; ++xx) { const int hx = (n2 > xx) ? (n2 - xx + 7) >> 3 : 0; if (xx < x_) lidx += G8 - hx; else if (xx == x_) lidx += r_ - hx; }
        const int cl = ((G & 7) == 0) ? lidx : c - n2;
        pg8::Gemm g{(const bf16_t*)(p.ws + WS_ACT), (const bf16_t*)(p.ws + WS_WD), 256};
        MoeOrder S{tab, (const int*)(p.ws + WS_LIST), flags, 4, G - n2, cl, (size_t)256 * 256 * 2, (size_t)1024 * 256 * 2, (size_t)256 * 256 * 2, false, 1, cl};
        EpiDown E{(bf16_t*)(p.ws + WS_Y), (const int*)(p.ws + WS_LIST)};
        if (c >= n2) pg8::gemm_phase<EpiDown, MoeOrder, false>(lds, g, S, E);
    }
}

__global__ void __launch_bounds__(512, 2) mega(Params p) {
    extern __shared__ __attribute__((aligned(16))) unsigned char lds_raw[];
    LAS unsigned char* lds = (LAS unsigned char*)lds_raw;
    cg::grid_group grid = cg::this_grid();
    if (p.ws == nullptr) grid.sync();
    volatile LAS unsigned* st = (volatile LAS unsigned*)(lds + LDS_BYTES - 64);
    if (threadIdx.x < 4) st[threadIdx.x] = 0u;
    __syncthreads();
    const XcdBarrier bar = xcd_barrier_post((unsigned*)(p.ws + WS_BAR), st);
#define GSYNC() xcd_barrier(bar)
#ifndef REP_MASK
#define REP_MASK 0
#endif
#ifndef TPROBE
#define TPROBE -1
#endif
    unsigned long long tp0_ = 0; (void)tp0_;
#define PH_BEGIN(i) do { if (TPROBE == (i) || (TPROBE == 10 && (i) == 0)) tp0_ = __builtin_amdgcn_s_memrealtime(); } while (0)
#define PH_END(i) do { if (TPROBE == (i)) { if (threadIdx.x == 0) { const unsigned long long t1_ = __builtin_amdgcn_s_memrealtime(); const unsigned long long d_ = t1_ - tp0_; \
        while (__builtin_amdgcn_s_memrealtime() - t1_ < d_) __builtin_amdgcn_s_sleep(8); } __syncthreads(); } } while (0)
    PH_BEGIN(0);
    f32x4 vx0[8][4];
    phase0(p, lds, vx0);
    if (TPROBE == 10) { if (threadIdx.x == 0) { const unsigned long long t1_ = __builtin_amdgcn_s_memrealtime(); const unsigned long long d_ = t1_ - tp0_; while (__builtin_amdgcn_s_memrealtime() - t1_ < d_) __builtin_amdgcn_s_sleep(8); } __syncthreads(); }
    phase0b(p, vx0);
    GSYNC(); PH_END(0); PH_BEGIN(2);
    {
        volatile LAS int* mi = (volatile LAS int*)(lds + MISC_OFF);
        if (threadIdx.x == 0) {
            const int G = gridDim.x; unsigned* bw = (unsigned*)(p.ws + WS_BAR);
            bool uni = (G % 8 == 0);
            for (int jx = 0; jx < 16; ++jx) { const unsigned cx = xb_ld(&bw[XB_XCNT(jx)]); uni = uni && (jx < 8 ? cx == (unsigned)(G / 8) : cx == 0u); }
            const int rank = mi[2], x = (int)bar.x, bx = blockIdx.x;
            mi[4] = uni ? rank * 8 + x : bx;
            mi[5] = uni ? x * (G / 8) + rank : ((G % 8 == 0) ? (bx % 8) * (G / 8) + bx / 8 : bx);
        }
        __syncthreads();
    }
    phase1_inproj(p, lds);
#if (REP_MASK) & 4
    phase1_inproj(p, lds);
#endif
    GSYNC(); PH_END(2); PH_BEGIN(3);
    attn_phase<0>(p, lds);
#if (REP_MASK) & 8
    attn_phase<0>(p, lds);
#endif
    indexer_phase(p, lds);
#if (REP_MASK) & 16
    indexer_phase(p, lds);
#endif
    GSYNC(); PH_END(3); PH_BEGIN(4);
    attn_phase<1>(p, lds);
#if (REP_MASK) & 32
    attn_phase<1>(p, lds);
#endif
    GSYNC(); PH_END(4); PH_BEGIN(5);
    phase4_outproj(p, lds);
#if (REP_MASK) & 64
    phase4_outproj(p, lds);
#endif
    GSYNC(); PH_END(5); PH_BEGIN(6);
    router_phase(p, lds);
    GSYNC(); PH_END(6); PH_BEGIN(7);
    phase_moe(p, lds);
    GSYNC(); PH_END(7); PH_BEGIN(9);
    phase_final(p, false);
    if (TPROBE == 9) { asm volatile("s_waitcnt vmcnt(0)" ::: "memory"); __syncthreads(); } PH_END(9);
}

extern "C" void kernel_launch(void* const* d_in, const int* in_sizes, int n_in, void* d_out, int out_size, void* d_ws, size_t ws_size, hipStream_t stream) {
    static int grid = 0;
    if (grid == 0) {
        if (n_in != 19 || out_size != NTOK * DM || ws_size < WS_END) { fprintf(stderr, "kernel_launch: unexpected problem (n_in %d out %d ws %zu)\n", n_in, out_size, ws_size); grid = -1; return; }
        int dev = 0, cus = 0, per_cu = 0;
        (void)hipGetDevice(&dev);
        (void)hipDeviceGetAttribute(&cus, hipDeviceAttributeMultiprocessorCount, dev);
        (void)hipFuncSetAttribute((const void*)mega, hipFuncAttributeMaxDynamicSharedMemorySize, LDS_BYTES);
        (void)hipOccupancyMaxActiveBlocksPerMultiprocessor(&per_cu, (const void*)mega, 512, LDS_BYTES);
        if (per_cu < 1) { fprintf(stderr, "kernel_launch: occupancy query says %d blocks per CU\n", per_cu); per_cu = 1; }
        grid = cus;
        if (grid % 8) grid -= grid % 8;
    }
    if (grid < 0) return;
    Params p{};
    const float** f = (const float**)&p;
    for (int i = 0; i < 19; ++i) f[i] = (const float*)d_in[i];
    p.out = (float*)d_out; p.ws = (unsigned char*)d_ws;
    (void)hipMemsetAsync(d_ws, 0, WS_ZERO_BYTES, stream);
    void* args[] = {&p};
    hipError_t e = hipLaunchCooperativeKernel((const void*)mega, dim3(grid), dim3(512), args, LDS_BYTES, stream);
    if (e != hipSuccess) fprintf(stderr, "cooperative launch failed: %s (grid %d)\n", hipGetErrorString(e), grid);
}
```

```cpp
#include <hip/hip_runtime.h>
#include <hip/hip_cooperative_groups.h>
#include <cstdio>
#include <cstdint>
namespace cg = cooperative_groups;

#define LAS __attribute__((address_space(3)))
typedef unsigned short bf16_t;
typedef short bf16x8 __attribute__((ext_vector_type(8)));
typedef float f32x4 __attribute__((ext_vector_type(4)));
typedef float f32x2 __attribute__((ext_vector_type(2)));
typedef float f32x16 __attribute__((ext_vector_type(16)));
typedef unsigned u32x4 __attribute__((ext_vector_type(4)));
typedef unsigned u32x2 __attribute__((ext_vector_type(2)));

constexpr int BATCH = 8, SEQ = 2048, DM = 1024, NTOK = BATCH * SEQ;
constexpr int NMOD = 6 * DM;
constexpr int IN_COLS = 2896, NPROJ = 3072;
constexpr int C_AQ = 0, C_BQ = 512, C_IQ = 1024, C_BK = 1536, C_BV = 2048, C_AK = 2560, C_AV = 2688, C_IK = 2816, C_IW = 2880, C_BF = 2888;
constexpr int NEXP = 32, DFF = 256;
constexpr float EPS = 1e-6f;
constexpr float LOG2E = 1.4426950408889634f;
constexpr float C2 = 0.125f * LOG2E;

constexpr size_t KiB = 1024, MiB = 1024 * 1024;
constexpr size_t WS_CNT = 0;
constexpr size_t WS_FLAG = 12 * KiB;
constexpr size_t WS_BAR = 16 * KiB;
constexpr size_t WS_TFLAG = 32 * KiB;
constexpr size_t WS_ZERO_BYTES = 64 * KiB;
constexpr size_t WS_MOD = 64 * KiB;
constexpr size_t WS_MOD2 = 256 * KiB;
constexpr size_t WS_IW = 512 * KiB;
constexpr size_t WS_LOGF = 1 * MiB;
constexpr size_t WS_SSQ = 1 * MiB + 512 * KiB;
constexpr size_t WS_X1SSQ = 2 * MiB + 512 * KiB;
constexpr size_t WS_RW = 3 * MiB + 512 * KiB;
constexpr size_t WS_LIST = 4 * MiB;
constexpr size_t WS_WR = 6 * MiB;
constexpr size_t WS_WIN = 8 * MiB;
constexpr size_t WS_WOUT = 14 * MiB;
constexpr size_t WS_WGU = 16 * MiB;
constexpr size_t WS_WD = 48 * MiB;
constexpr size_t WS_PROJ = 64 * MiB;
constexpr size_t WS_Y = 64 * MiB;
constexpr size_t WS_ACT = 128 * MiB;
constexpr size_t WS_H = 160 * MiB;
constexpr size_t WS_O = 192 * MiB;
constexpr size_t WS_MASK = 224 * MiB;
constexpr size_t WS_IKF = 228 * MiB;
constexpr size_t WS_END = 230 * MiB;

constexpr int LDS_BYTES = 147456;

struct Params {
    const float *x, *c, *w_ada, *b_ada, *g_mix, *w_in, *b_forget, *g_out_a, *g_out_b, *w_out, *g_ffn, *w_group, *b_group, *w_router, *b_router, *w_gate, *w_up, *w_down, *g_final;
    float* out;
    unsigned char* ws;
};

__device__ __forceinline__ unsigned f2bf(float f) { unsigned u = __builtin_bit_cast(unsigned, f); return (u + 0x7fffu + ((u >> 16) & 1u)) >> 16; }
__device__ __forceinline__ unsigned pk2(float lo, float hi) { return f2bf(lo) | (f2bf(hi) << 16); }
__device__ __forceinline__ float bf2f(unsigned short b) { return __builtin_bit_cast(float, (unsigned)b << 16); }
__device__ __forceinline__ float wave_sum(float v) {
#pragma unroll
    for (int o = 1; o < 64; o <<= 1) v += __shfl_xor(v, o);
    return v;
}
#define LDS_BARRIER() do { asm volatile("s_waitcnt lgkmcnt(0)" ::: "memory"); __builtin_amdgcn_s_barrier(); asm volatile("" ::: "memory"); } while (0)
__device__ __forceinline__ float siluf(float v) { return v / (1.f + __expf(-v)); }

__device__ __forceinline__ int win_row(int n) {
    if (n < 512) return C_AQ + n;
    if (n < 640) return C_AK + (n - 512);
    if (n < 768) return C_AV + (n - 640);
    if (n < 1280) return C_IQ + (n - 768);
    if (n < 1344) return C_IK + (n - 1280);
    if (n < 1352) return C_IW + (n - 1344);
    if (n < 1864) return C_BQ + (n - 1352);
    if (n < 2376) return C_BK + (n - 1864);
    if (n < 2888) return C_BV + (n - 2376);
    return C_BF + (n - 2888);
}
struct TItem { const float* W; bf16_t* WT; const float* kscale; int K, N, k0, n0, map; };
constexpr int NB_IN = (IN_COLS + 31) / 32;
constexpr int I_IN = 16 * NB_IN, I_OUT = 16 * 32, I_G = 32 * 16 * 8, I_U = I_G, I_D = 32 * 4 * 32;
constexpr int NITEMS = I_IN + I_OUT;
constexpr int NXITEMS = I_G + I_U + I_D;
__device__ __forceinline__ TItem titem(const Params& p, int r) {
    TItem t; unsigned char* ws = p.ws; t.kscale = nullptr;
    if (r < I_IN) { const int kb = r / NB_IN, nb = r % NB_IN; t.W = p.w_in; t.WT = (bf16_t*)(ws + WS_WIN); t.K = 1024; t.N = IN_COLS; t.k0 = 64 * kb; t.n0 = 32 * nb; t.map = 1; return t; } r -= I_IN;
    { const int kb = r / 32, nb = r % 32; t.W = p.w_out; t.WT = (bf16_t*)(ws + WS_WOUT); t.K = 1024; t.N = 1024; t.k0 = 64 * kb; t.n0 = 32 * nb; t.map = 0; t.kscale = t.k0 < 512 ? p.g_out_a : p.g_out_b - 512; return t; }
}
__device__ __forceinline__ TItem txitem(const Params& p, int r) {
    TItem t; unsigned char* ws = p.ws; t.kscale = nullptr;
    if (r < I_G) { const int e = r >> 7, q = r & 127, kb = q >> 3, nb = q & 7; t.W = p.w_gate + (size_t)e * 1024 * 256; t.WT = (bf16_t*)(ws + WS_WGU) + (size_t)e * 512 * 1024; t.K = 1024; t.N = 256; t.k0 = 64 * kb; t.n0 = 32 * nb; t.map = 2; return t; } r -= I_G;
    if (r < I_U) { const int e = r >> 7, q = r & 127, kb = q >> 3, nb = q & 7; t.W = p.w_up + (size_t)e * 1024 * 256; t.WT = (bf16_t*)(ws + WS_WGU) + (size_t)e * 512 * 1024; t.K = 1024; t.N = 256; t.k0 = 64 * kb; t.n0 = 32 * nb; t.map = 3; return t; } r -= I_U;
    { const int e = r >> 7, q = r & 127, kb = q >> 5, nb = q & 31; t.W = p.w_down + (size_t)e * 256 * 1024; t.WT = (bf16_t*)(ws + WS_WD) + (size_t)e * 1024 * 256; t.K = 256; t.N = 1024; t.k0 = 64 * kb; t.n0 = 32 * nb; t.map = 0; return t; }
}
__device__ __forceinline__ void titem_load(const TItem& t, int lane, float (&v)[32]) {
    const int nn = t.n0 + (lane & 31);
    const float* src = t.W + (size_t)(t.k0 + (lane >> 5)) * t.N + nn;
    const bool ok = nn < t.N;
    const size_t step = (size_t)2 * t.N;
#pragma unroll
    for (int i = 0; i < 32; ++i) { v[i] = ok ? __builtin_nontemporal_load(src) : 0.f; src += step; }
    if (t.kscale) {
        const float* ks = t.kscale + t.k0 + (lane >> 5);
#pragma unroll
        for (int i = 0; i < 32; ++i) v[i] *= ks[2 * i];
    }
}
__device__ __forceinline__ void titem_store(const TItem& t, int lane, const float (&v)[32], LAS float* scr) {
#pragma unroll
    for (int i = 0; i < 32; ++i) scr[(2 * i + (lane >> 5)) * 33 + (lane & 31)] = v[i];
    asm volatile("s_waitcnt lgkmcnt(0)" ::: "memory");
    const int c = lane & 7;
#pragma unroll
    for (int j = 0; j < 4; ++j) {
        const int nl = (lane >> 3) + 8 * j, n = t.n0 + nl;
        const LAS float* s = scr + (8 * c) * 33 + nl;
        u32x4 o; o.x = pk2(s[0 * 33], s[1 * 33]); o.y = pk2(s[2 * 33], s[3 * 33]); o.z = pk2(s[4 * 33], s[5 * 33]); o.w = pk2(s[6 * 33], s[7 * 33]);
        int row;
        if (t.map == 0) row = n; else if (t.map == 1) row = win_row(n); else if (t.map == 2) row = (n >> 7) * 256 + (n & 127); else row = (n >> 7) * 256 + 128 + (n & 127);
        if (n < t.N) *(u32x4*)(t.WT + (size_t)row * t.K + t.k0 + 8 * c) = o;
    }
    asm volatile("s_waitcnt lgkmcnt(0)" ::: "memory");
}

__device__ __forceinline__ void titem_dma_issue(const TItem& t, int lane, LAS float* scr) {
    const float* src = t.W + (size_t)(t.k0 + (lane >> 3)) * t.N + t.n0 + 4 * (lane & 7);
    const size_t step = (size_t)8 * t.N;
#pragma unroll
    for (int i = 0; i < 8; ++i) { __builtin_amdgcn_global_load_lds((const unsigned*)src, (LAS unsigned*)(scr + i * 256), 16, 0, 2); src += step; }
}
__device__ __forceinline__ void titem_dma_finish(const TItem& t, int lane, const LAS float* scr) {
    const int c = lane & 7;
#pragma unroll
    for (int j = 0; j < 4; ++j) {
        const int nl = (lane >> 3) + 8 * j, n = t.n0 + nl;
        const LAS float* s = scr + (8 * c) * 32 + nl;
        u32x4 o; o.x = pk2(s[0 * 32], s[1 * 32]); o.y = pk2(s[2 * 32], s[3 * 32]); o.z = pk2(s[4 * 32], s[5 * 32]); o.w = pk2(s[6 * 32], s[7 * 32]);
        int row;
        if (t.map == 0) row = n; else if (t.map == 2) row = (n >> 7) * 256 + (n & 127); else row = (n >> 7) * 256 + 128 + (n & 127);
        *(u32x4*)(t.WT + (size_t)row * t.K + t.k0 + 8 * c) = o;
    }
}

__device__ __forceinline__ void phase0b_issue(const Params& p, f32x4 (&vx)[8][4]) {
    int tid_ = threadIdx.x; asm volatile("" : "+v"(tid_)); const int tid = tid_, lane = tid & 63, wave = tid >> 6, G = gridDim.x;
    const int gw = blockIdx.x * 8 + wave, NGW = G * 8;
    if (NTOK == 8 * NGW) {
#pragma unroll
        for (int r = 0; r < 8; ++r) {
            const f32x4* xr = (const f32x4*)(p.x + (size_t)(8 * gw + r) * DM) + lane;
#pragma unroll
            for (int j = 0; j < 4; ++j) vx[r][j] = __builtin_nontemporal_load(xr + 64 * j);
        }
    }
}
__device__ __forceinline__ void phase0(const Params& p, LAS unsigned char* lds, f32x4 (&vx)[8][4]) {
    int tid_ = threadIdx.x; asm volatile("" : "+v"(tid_)); const int tid = tid_, lane = tid & 63, wave = tid >> 6, G = gridDim.x;
    unsigned char* ws = p.ws;
    const int nA = NMOD / 32;
    const bool split = (G >= nA + 32), helper = split && ((int)blockIdx.x >= nA);
    if (helper) phase0b_issue(p, vx);
    else {
    for (int item = blockIdx.x; item < NMOD / 32; item += G) {
        LAS float* sc = (LAS float*)lds;
        LAS float* red = (LAS float*)(lds + 32768);
        const int j0 = 32 * item, col = lane & 31, kr = lane >> 5;
        const int kb = wave * 128 + 64 * kr;
        const unsigned loff = (unsigned)(kb * NMOD + j0 + col);
        const __amdgpu_buffer_rsrc_t wrs = __builtin_amdgcn_make_buffer_rsrc((void*)p.w_ada, 0, 0x7fffffff, 0x00020000);
        float w[32];
#pragma unroll
        for (int u = 0; u < 32; ++u) w[u] = __builtin_bit_cast(float, __builtin_amdgcn_raw_buffer_load_b32(wrs, loff * 4u, u * (NMOD * 4), 2));
        for (int i = tid; i < BATCH * DM; i += 512) sc[i] = siluf(p.c[i]);
        __syncthreads();
        float acc[8];
#pragma unroll
        for (int b = 0; b < 8; ++b) acc[b] = 0.f;
#pragma unroll 1
        for (int i0 = 0; i0 < 64; i0 += 32) {
            if (i0) {
#pragma unroll
                for (int u = 0; u < 32; ++u) w[u] = __builtin_bit_cast(float, __builtin_amdgcn_raw_buffer_load_b32(wrs, loff * 4u, (32 + u) * (NMOD * 4), 2));
            }
#pragma unroll
            for (int b = 0; b < 8; ++b) {
#pragma unroll
                for (int u4 = 0; u4 < 32; u4 += 4) {
                    const f32x4 s = *(const LAS f32x4*)(sc + b * 1024 + kb + i0 + u4);
                    acc[b] += (s[0] * w[u4] + s[1] * w[u4 + 1]) + (s[2] * w[u4 + 2] + s[3] * w[u4 + 3]);
                }
            }
        }
#pragma unroll
        for (int b = 0; b < 8; ++b) { acc[b] += __shfl_xor(acc[b], 32); if (kr == 0) red[(wave * 8 + b) * 32 + col] = acc[b]; }
        __syncthreads();
        if (wave == 0) {
#pragma unroll
            for (int q = 0; q < 4; ++q) {
                const int o = lane + 64 * q, b = o >> 5, cc = o & 31; float s = 0.f;
#pragma unroll
                for (int w8 = 0; w8 < 8; ++w8) s += red[(w8 * 8 + b) * 32 + cc];
                __hip_atomic_store((float*)(ws + WS_MOD) + b * NMOD + j0 + cc, s + p.b_ada[j0 + cc], __ATOMIC_RELAXED, __HIP_MEMORY_SCOPE_AGENT);
            }
            asm volatile("s_waitcnt vmcnt(0)" ::: "memory");
            if (tid == 0) __hip_atomic_fetch_add((unsigned*)(ws + WS_FLAG), 1u, __ATOMIC_RELAXED, __HIP_MEMORY_SCOPE_AGENT);
        }
        __syncthreads();
    }
    phase0b_issue(p, vx);
    }
    if (split && !helper) return;
    const int hb = helper ? (int)blockIdx.x - nA : (int)blockIdx.x, HG = helper ? G - nA : G;
    {
        bf16_t* wrh = (bf16_t*)(ws + WS_WR); bf16_t* wrl = wrh + 48 * 1024;
        for (int i = hb * 512 + tid; i < 48 * 1024; i += HG * 512) {
            const int o = i >> 10, k = i & 1023; float v = 0.f;
            if (o < 4) v = p.w_group[k * 4 + o];
            else if (o >= 16) { const int g = (o - 16) >> 3, e = (o - 16) & 7; v = p.w_router[((size_t)g * 1024 + k) * 8 + e]; }
            const unsigned hb = f2bf(v); const float hf = bf2f((unsigned short)hb);
            wrh[i] = (bf16_t)hb; wrl[i] = (bf16_t)f2bf(v - hf);
        }
    }
    {
        u32x4* z = (u32x4*)((bf16_t*)(ws + WS_WIN) + (size_t)IN_COLS * 1024);
        const int n16 = (NPROJ - IN_COLS) * 1024 * 2 / 16;
        for (int i = hb * 512 + tid; i < n16; i += HG * 512) z[i] = (u32x4){0u, 0u, 0u, 0u};
    }
    {
        LAS float* scr = (LAS float*)(lds + 49152 + wave * 8704);
        const int gw = hb * 8 + wave, NGW = HG * 8;
        float va[32], vb[32];
        int it = gw;
        if (it < NITEMS) { const TItem t0 = titem(p, it); titem_load(t0, lane, va); }
        while (it < NITEMS) {
            const TItem tc = titem(p, it);
            const int nx = it + NGW;
            if (nx < NITEMS) { const TItem tn = titem(p, nx); titem_load(tn, lane, vb); }
            titem_store(tc, lane, va, scr);
#pragma unroll
            for (int i = 0; i < 32; ++i) va[i] = vb[i];
            it = nx;
        }
    }
}

__device__ __forceinline__ void phase0b(const Params& p, f32x4 (&vx)[8][4]) {
    int tid_ = threadIdx.x; asm volatile("" : "+v"(tid_)); const int tid = tid_, lane = tid & 63, wave = tid >> 6, G = gridDim.x;
    const float* mod = (const float*)(p.ws + WS_MOD);
    float* mod2 = (float*)(p.ws + WS_MOD2);
    const int gw = blockIdx.x * 8 + wave, NGW = G * 8;
    const bool fast = (NTOK == 8 * NGW);
    if (tid == 0) {
        unsigned* flag = (unsigned*)(p.ws + WS_FLAG); unsigned sp = 0;
        while (__hip_atomic_load(flag, __ATOMIC_RELAXED, __HIP_MEMORY_SCOPE_AGENT) < (unsigned)(NMOD / 32)) { __builtin_amdgcn_s_sleep(2); if (++sp > (1u << 22)) break; }
        __builtin_amdgcn_fence(__ATOMIC_ACQUIRE, "agent");
        asm volatile("s_waitcnt vmcnt(0)" ::: "memory");
    }
    __syncthreads();
    for (int i = blockIdx.x * 512 + tid; i < BATCH * DM; i += G * 512) {
        const int b = i >> 10, k = i & 1023;
        mod2[(b * 2 + 0) * 1024 + k] = p.g_ffn[k] * (1.f + mod[b * NMOD + 4 * DM + k]);
        mod2[(b * 2 + 1) * 1024 + k] = mod[b * NMOD + 3 * DM + k];
    }
    bf16_t* H = (bf16_t*)(p.ws + WS_H);
    if (fast) {
        const int b = (8 * gw) >> 11;
        f32x4 A4[4], S4[4];
#pragma unroll
        for (int j = 0; j < 4; ++j) {
            const int k = 4 * lane + 256 * j;
            const f32x4 g = *(const f32x4*)(p.g_mix + k), sh = *(const f32x4*)(mod + b * NMOD + k), sc = *(const f32x4*)(mod + b * NMOD + DM + k);
            A4[j] = g * (1.f + sc); S4[j] = sh;
        }
#pragma unroll
        for (int r = 0; r < 8; ++r) {
            const int m = 8 * gw + r;
            float s = 0.f;
#pragma unroll
            for (int j = 0; j < 4; ++j) s += (vx[r][j].x * vx[r][j].x + vx[r][j].y * vx[r][j].y) + (vx[r][j].z * vx[r][j].z + vx[r][j].w * vx[r][j].w);
            const float rstd = 1.f / sqrtf(wave_sum(s) * (1.f / DM) + EPS);
            unsigned long long* o8 = (unsigned long long*)(H + (size_t)m * DM) + lane;
#pragma unroll
            for (int j = 0; j < 4; ++j) {
                const f32x4 h = vx[r][j] * rstd * A4[j] + S4[j];
                o8[64 * j] = (unsigned long long)pk2(h.x, h.y) | ((unsigned long long)pk2(h.z, h.w) << 32);
            }
        }
        return;
    }
    for (int m = gw; m < NTOK; m += NGW) {
        const int b = m >> 11;
        const f32x4* xr = (const f32x4*)(p.x + (size_t)m * DM) + lane;
        f32x4 v[4]; float s = 0.f;
#pragma unroll
        for (int j = 0; j < 4; ++j) { v[j] = __builtin_nontemporal_load(xr + 64 * j); s += (v[j].x * v[j].x + v[j].y * v[j].y) + (v[j].z * v[j].z + v[j].w * v[j].w); }
        const float rstd = 1.f / sqrtf(wave_sum(s) * (1.f / DM) + EPS);
        unsigned long long* o8 = (unsigned long long*)(H + (size_t)m * DM) + lane;
#pragma unroll
        for (int j = 0; j < 4; ++j) {
            const int k = 4 * lane + 256 * j;
            const f32x4 g = *(const f32x4*)(p.g_mix + k), sh = *(const f32x4*)(mod + b * NMOD + k), sc = *(const f32x4*)(mod + b * NMOD + DM + k);
            const f32x4 h = v[j] * rstd * g * (1.f + sc) + sh;
            o8[64 * j] = (unsigned long long)pk2(h.x, h.y) | ((unsigned long long)pk2(h.z, h.w) << 32);
        }
    }
}

__device__ __forceinline__ void phase_final(const Params& p, bool skeleton) {
    int tid_ = threadIdx.x; asm volatile("" : "+v"(tid_)); const int tid = tid_, lane = tid & 63, wave = tid >> 6, G = gridDim.x;
    const float* mod = (const float*)(p.ws + WS_MOD);
    const bf16_t* Y = (const bf16_t*)(p.ws + WS_Y);
    const int gw = blockIdx.x * 8 + wave, NGW = G * 8;
    if (!skeleton && NTOK == 8 * NGW) {
        const int b = (8 * gw) >> 11;
        f32x4 GF[4], GN[4];
#pragma unroll
        for (int j = 0; j < 4; ++j) { const int k = 4 * lane + 256 * j; GF[j] = *(const f32x4*)(mod + b * NMOD + 5 * DM + k); GN[j] = *(const f32x4*)(p.g_final + k); }
#pragma unroll 2
        for (int r = 0; r < 8; ++r) {
            const int m = 8 * gw + r;
            const u32x2* xb16 = (const u32x2*)((const bf16_t*)p.out + (size_t)m * (2 * DM)) + lane;
            f32x4 v[4]; float s = 0.f;
#pragma unroll
            for (int j = 0; j < 4; ++j) {
                const int k = 4 * lane + 256 * j;
                const u32x2 w = __builtin_nontemporal_load(xb16 + 64 * j);
                const u32x2 y0 = __builtin_nontemporal_load((const u32x2*)(Y + ((size_t)m * 2 + 0) * DM + k)), y1 = __builtin_nontemporal_load((const u32x2*)(Y + ((size_t)m * 2 + 1) * DM + k));
                v[j] = (f32x4){__builtin_bit_cast(float, w.x << 16), __builtin_bit_cast(float, w.x & 0xffff0000u), __builtin_bit_cast(float, w.y << 16), __builtin_bit_cast(float, w.y & 0xffff0000u)};
                f32x4 ys;
                ys.x = bf2f((unsigned short)(y0.x & 0xffff)) + bf2f((unsigned short)(y1.x & 0xffff)); ys.y = bf2f((unsigned short)(y0.x >> 16)) + bf2f((unsigned short)(y1.x >> 16));
                ys.z = bf2f((unsigned short)(y0.y & 0xffff)) + bf2f((unsigned short)(y1.y & 0xffff)); ys.w = bf2f((unsigned short)(y0.y >> 16)) + bf2f((unsigned short)(y1.y >> 16));
                v[j] = v[j] + GF[j] * ys;
                s += (v[j].x * v[j].x + v[j].y * v[j].y) + (v[j].z * v[j].z + v[j].w * v[j].w);
            }
            const float rstd = 1.f / sqrtf(wave_sum(s) * (1.f / DM) + EPS);
            f32x4* o = (f32x4*)(p.out + (size_t)m * DM) + lane;
#pragma unroll
            for (int j = 0; j < 4; ++j) o[64 * j] = v[j] * rstd * GN[j];
        }
        return;
    }
    for (int m = gw; m < NTOK; m += NGW) {
        const int b = m >> 11;
        const f32x4* xr = (const f32x4*)(p.x + (size_t)m * DM) + lane;
        const u32x2* xb16 = (const u32x2*)((const bf16_t*)p.out + (size_t)m * (2 * DM)) + lane;
        f32x4 v[4]; float s = 0.f;
#pragma unroll
        for (int j = 0; j < 4; ++j) {
            if (skeleton) v[j] = xr[64 * j];
            else { const u32x2 w = __builtin_nontemporal_load(xb16 + 64 * j); v[j] = (f32x4){__builtin_bit_cast(float, w.x << 16), __builtin_bit_cast(float, w.x & 0xffff0000u), __builtin_bit_cast(float, w.y << 16), __builtin_bit_cast(float, w.y & 0xffff0000u)}; }
            if (!skeleton) {
                const int k = 4 * lane + 256 * j;
                const f32x4 gf = *(const f32x4*)(mod + b * NMOD + 5 * DM + k);
                const u32x2 y0 = __builtin_nontemporal_load((const u32x2*)(Y + ((size_t)m * 2 + 0) * DM + k)), y1 = __builtin_nontemporal_load((const u32x2*)(Y + ((size_t)m * 2 + 1) * DM + k));
                f32x4 ys;
                ys.x = bf2f((unsigned short)(y0.x & 0xffff)) + bf2f((unsigned short)(y1.x & 0xffff)); ys.y = bf2f((unsigned short)(y0.x >> 16)) + bf2f((unsigned short)(y1.x >> 16));
                ys.z = bf2f((unsigned short)(y0.y & 0xffff)) + bf2f((unsigned short)(y1.y & 0xffff)); ys.w = bf2f((unsigned short)(y0.y >> 16)) + bf2f((unsigned short)(y1.y >> 16));
                v[j] = v[j] + gf * ys;
            }
            s += (v[j].x * v[j].x + v[j].y * v[j].y) + (v[j].z * v[j].z + v[j].w * v[j].w);
        }
        const float rstd = 1.f / sqrtf(wave_sum(s) * (1.f / DM) + EPS);
        f32x4* o = (f32x4*)(p.out + (size_t)m * DM) + lane;
#pragma unroll
        for (int j = 0; j < 4; ++j) { const f32x4 g = *(const f32x4*)(p.g_final + 4 * lane + 256 * j); o[64 * j] = v[j] * rstd * g; }
    }
}

#define XB_TMO      128
#define XB_XCNT(j)  (256  + 64 * (j))
#define XB_XSUB(j)  (1280 + 64 * (j))
#define XB_XGEN(j)  (2304 + 64 * (j))
#define XB_TOP      3328
#define XB_TOPGEN   3392
#define XCD_BAR_WORDS 3456
#define XB_SPIN_CAP (1u << 18)
__device__ __forceinline__ unsigned xb_ld(unsigned* p)              { return __hip_atomic_load(p, __ATOMIC_RELAXED, __HIP_MEMORY_SCOPE_AGENT); }
__device__ __forceinline__ unsigned xb_add(unsigned* p, unsigned v) { return __hip_atomic_fetch_add(p, v, __ATOMIC_RELAXED, __HIP_MEMORY_SCOPE_AGENT); }
__device__ __forceinline__ unsigned xb_xcc_id() { return (unsigned)__builtin_amdgcn_s_getreg((3 << 11) | 20) & 0xFu; }
#define XB_SPIN(cond, bar) do { unsigned _sp = 0; while (cond) { __builtin_amdgcn_s_sleep(1); \
    if ((++_sp & 255u) == 0u) { if (xb_ld(&(bar)[XB_TMO])) break; if (_sp > XB_SPIN_CAP) { atomicAdd(&(bar)[XB_TMO], 1u); break; } } } } while (0)
struct XcdBarrier { unsigned* bar; unsigned x; volatile LAS unsigned* st; };
__device__ __forceinline__ XcdBarrier xcd_barrier_post(unsigned* bar, volatile LAS unsigned* st) {
    XcdBarrier b; b.bar = bar; b.x = xb_xcc_id(); b.st = st;
    if (threadIdx.x == 0) st[2] = xb_add(&bar[XB_XCNT(b.x)], 1u);
    return b;
}
__device__ __forceinline__ void xcd_barrier_complete(unsigned* bar, unsigned x, unsigned& nloc, unsigned& nx) {
    const unsigned G = gridDim.x * gridDim.y * gridDim.z;
    unsigned sum, cnt, mine, sp = 0u;
    for (;;) {
        sum = 0u; cnt = 0u; mine = 0u;
#pragma unroll
        for (unsigned j = 0; j < 16; ++j) { const unsigned c = xb_ld(&bar[XB_XCNT(j)]); sum += c; cnt += (c > 0u) ? 1u : 0u; mine = (j == x) ? c : mine; }
        if (sum == G) break;
        __builtin_amdgcn_s_sleep(1);
        if ((++sp & 255u) == 0u) { if (xb_ld(&bar[XB_TMO])) break; if (sp > XB_SPIN_CAP) { atomicAdd(&bar[XB_TMO], 1u); break; } }
    }
    nloc = mine > 0u ? mine : 1u; nx = cnt > 0u ? cnt : 1u;
}
__device__ __forceinline__ void xcd_barrier(const XcdBarrier& b) {
    asm volatile("s_waitcnt vmcnt(0)" ::: "memory");
    __syncthreads();
    if (threadIdx.x == 0) {
        unsigned* bar = b.bar;
        __builtin_amdgcn_s_waitcnt(0);
        unsigned nloc = b.st[0], nx = b.st[1];
        if (nloc == 0u) { xcd_barrier_complete(bar, b.x, nloc, nx); b.st[0] = nloc; b.st[1] = nx; }
        const unsigned old = xb_add(&bar[XB_XSUB(b.x)], 1u);
        const unsigned gen = old / nloc;
        if (old + 1u == (gen + 1u) * nloc) {
            __builtin_amdgcn_fence(__ATOMIC_RELEASE, "agent");
            asm volatile("s_waitcnt vmcnt(0)" ::: "memory");
            const unsigned og = xb_add(&bar[XB_TOP], 1u);
            const unsigned tg = og / nx;
            if (og + 1u == (tg + 1u) * nx) xb_add(&bar[XB_TOPGEN], 1u);
            else XB_SPIN(xb_ld(&bar[XB_TOPGEN]) == tg, bar);
            __builtin_amdgcn_fence(__ATOMIC_ACQUIRE, "agent");
            xb_add(&bar[XB_XGEN(b.x)], 1u);
            asm volatile("s_waitcnt vmcnt(0)" ::: "memory");
        } else {
            XB_SPIN(xb_ld(&bar[XB_XGEN(b.x)]) == gen, bar);
            __builtin_amdgcn_fence(__ATOMIC_ACQUIRE, "agent");
            asm volatile("s_waitcnt vmcnt(0)" ::: "memory");
        }
    }
    __syncthreads();
}
namespace pg8 {
constexpr int BM = 256, BK = 64, HALF = 128, HTB = HALF * BK * 2, STAGE_BYTES = 8 * HTB, NXCD = 8, WGM = 8;
__host__ __device__ __forceinline__ int lds_byte(int r, int c) { const int st = (r >> 4) * 2 + (c >> 5), rr = r & 15, cc = c & 31, ob = rr * 64 + cc * 2; return st * 1024 + (ob ^ (((ob >> 9) & 1) << 5)); }
__host__ __device__ __forceinline__ void stage_rc(int b, int& R, int& C) { const int st = b / 1024, sb = b % 1024, swz = sb ^ (((sb >> 9) & 1) << 5); R = (st >> 1) * 16 + swz / 64; C = (st & 1) * 32 + (swz % 64) / 2; }
__host__ __device__ __forceinline__ int perm32(int rho) { const int n = rho >> 4, i = rho & 15; return 8 * (i >> 2) + 4 * n + (i & 3); }

struct Unit { int pm, pn; size_t aoff, boff; int e, r0, cnt; };
struct Gemm { const bf16_t* A; const bf16_t* Bt; int K; };

struct StaticOrder {
    int nM, nN, nwg, G, c; size_t tstep;
    __device__ void init(int M, int N, int K, int G_, int c_) { nM = M / BM; nN = N / BM; nwg = nM * nN; G = G_; c = c_; tstep = (size_t)BM * K * 2; }
    __device__ bool next(int i, Unit& u) const {
        const long L = (long)i * G + c; if (L >= nwg) return false;
        int wgid = (int)L; { const int q = nwg / NXCD, r = nwg % NXCD, xcd = wgid % NXCD, off = wgid / NXCD; wgid = (xcd < r ? xcd * (q + 1) : r * (q + 1) + (xcd - r) * q) + off; }
        const int nig = WGM * nN, gid = wgid / nig, fm = gid * WGM, gsz = (nM - fm) < WGM ? (nM - fm) : WGM;
        u.pm = fm + ((wgid % nig) % gsz); u.pn = (wgid % nig) / gsz; u.aoff = (size_t)u.pm * tstep; u.boff = (size_t)u.pn * tstep; u.e = 0; u.r0 = 0; u.cnt = 0; return true;
    }
    __device__ __forceinline__ unsigned arow(const Unit&, int R) const { return 0u; }
    __device__ __forceinline__ void a_ready(const Unit&) const {}
    __device__ __forceinline__ void done(const Unit&) const {}
};

__device__ __forceinline__ unsigned cvt_pk_bf16(float lo, float hi) { unsigned r; asm volatile("v_cvt_pk_bf16_f32 %0, %1, %2" : "=v"(r) : "v"(lo), "v"(hi)); return r; }

template <class Epi, class Sched, bool GATHER>
__device__ __forceinline__ void gemm_phase(LAS unsigned char* lds, const Gemm g, const Sched& S, const Epi& E) {
    int tid_ = threadIdx.x; asm volatile("" : "+v"(tid_)); const int tid = tid_, wid = __builtin_amdgcn_readfirstlane(tid >> 6), lane = tid & 63, wr = wid >> 2, wc = wid & 3, fr = lane & 15, fq = lane >> 4;
    const int K = g.K, nt = K / BK;
    int Rst[2], Cst[2]; unsigned voffB[2], voffA[2], cOA[2][2], nOA[2][2];
    const size_t kstep = (size_t)(BK * 2);
    const size_t hstep = (size_t)HALF * K * 2;
#pragma unroll
    for (int i = 0; i < 2; ++i) { int R, C; stage_rc(tid * 16 + i * 8192, R, C); Rst[i] = R; Cst[i] = C; const int Rb = Epi::PERM ? ((R & ~31) + perm32(R & 31)) : R; voffB[i] = (unsigned)(Rb * K + C) * 2u; voffA[i] = (unsigned)(R * K + C) * 2u; }
    const unsigned ldsw = (unsigned)wid * 1024u;
    const int aoff = lds_byte(wr * 64 + fr, fq * 8), boff = lds_byte(wc * 32 + fr, fq * 8);
#define PG8_SA(b, h) (((b) * 2 + (h)) * HTB)
#define PG8_SB(b, h) ((4 + (b) * 2 + (h)) * HTB)
#define PG8_STAGE_B(bufoff, gbase) do { _Pragma("unroll") for (int _i = 0; _i < 2; ++_i) \
        __builtin_amdgcn_global_load_lds((const unsigned*)((const char*)(gbase) + voffB[_i]), (LAS unsigned*)(lds + (bufoff) + ldsw + _i * 8192), 16, 0, 0); } while (0)
#define PG8_STAGE_A(bufoff, gbase, H, o0, o1) do { \
        const char* _gb = GATHER ? (const char*)(gbase) : (const char*)(gbase) + (H) * hstep; \
        const unsigned _o0 = GATHER ? (o0) : voffA[0], _o1 = GATHER ? (o1) : voffA[1]; \
        __builtin_amdgcn_global_load_lds((const unsigned*)(_gb + _o0), (LAS unsigned*)(lds + (bufoff) + ldsw), 16, 0, 0); \
        __builtin_amdgcn_global_load_lds((const unsigned*)(_gb + _o1), (LAS unsigned*)(lds + (bufoff) + ldsw + 8192), 16, 0, 0); } while (0)
#define PG8_LDA(dst, b, h) do { _Pragma("unroll") for (int m = 0; m < 4; ++m) _Pragma("unroll") for (int k = 0; k < 2; ++k) dst[m][k] = *(const LAS bf16x8*)(lds + PG8_SA(b, h) + aoff + m * 2048 + k * 1024); } while (0)
#define PG8_LDB(dst, b, h) do { _Pragma("unroll") for (int n = 0; n < 2; ++n) _Pragma("unroll") for (int k = 0; k < 2; ++k) dst[n][k] = *(const LAS bf16x8*)(lds + PG8_SB(b, h) + boff + n * 2048 + k * 1024); } while (0)
#define PG8_MMA(ai, bj, At, Bt) do { __builtin_amdgcn_s_setprio(1); _Pragma("unroll") for (int m = 0; m < 4; ++m) _Pragma("unroll") for (int n = 0; n < 2; ++n) _Pragma("unroll") for (int k = 0; k < 2; ++k) \
        acc[ai][bj][m][n] = __builtin_amdgcn_mfma_f32_16x16x32_bf16(Bt[n][k], At[m][k], acc[ai][bj][m][n], 0, 0, 0); __builtin_amdgcn_s_setprio(0); } while (0)
#define PG8_WAIT_V(n) asm volatile("s_waitcnt vmcnt(" #n ")" ::: "memory")
#define PG8_WAIT_L(n) asm volatile("s_waitcnt lgkmcnt(" #n ")" ::: "memory")
#define PG8_BAR __builtin_amdgcn_s_barrier()
#define PG8_SCHED __builtin_amdgcn_sched_barrier(0)
#define PG8_SETOFF(dst, u) do { if (GATHER) { _Pragma("unroll") for (int _h = 0; _h < 2; ++_h) _Pragma("unroll") for (int _i = 0; _i < 2; ++_i) \
        dst[_h][_i] = S.arow(u, Rst[_i] + HALF * _h) * (unsigned)(K * 2) + (unsigned)(Cst[_i] * 2); } } while (0)
    Unit cur, nxt; int ui = 0;
    if (!S.next(0, cur)) return;
    f32x4 acc[2][2][4][2];
#pragma unroll
    for (int a = 0; a < 2; ++a)
#pragma unroll
        for (int b = 0; b < 2; ++b)
#pragma unroll
            for (int m = 0; m < 4; ++m)
#pragma unroll
                for (int n = 0; n < 2; ++n) acc[a][b][m][n] = (f32x4){0.f, 0.f, 0.f, 0.f};
    bf16x8 At[4][2], B0[2][2], B1[2][2];
    const char* cA = (const char*)g.A + cur.aoff; const char* cB = (const char*)g.Bt + cur.boff;
    S.a_ready(cur);
    PG8_SETOFF(cOA, cur);
    if constexpr (Epi::MID) E.pre(lds, cur, wr);
    PG8_STAGE_B(PG8_SB(0, 0), cB); PG8_STAGE_B(PG8_SB(0, 1), cB + hstep); PG8_STAGE_A(PG8_SA(0, 0), cA, 0, cOA[0][0], cOA[0][1]); PG8_STAGE_A(PG8_SA(0, 1), cA, 1, cOA[1][0], cOA[1][1]);
    if (wr == 1) PG8_BAR;
    PG8_WAIT_V(2); PG8_BAR;
    PG8_STAGE_B(PG8_SB(1, 0), cB + kstep); PG8_STAGE_A(PG8_SA(1, 0), cA + kstep, 0, cOA[0][0], cOA[0][1]); PG8_STAGE_B(PG8_SB(1, 1), cB + hstep + kstep);
    PG8_WAIT_V(6); PG8_BAR;
    for (;;) {
        const bool has_next = S.next(ui + 1, nxt);
        if (has_next) S.a_ready(nxt);
        const char* nA = has_next ? (const char*)g.A + nxt.aoff : cA; const char* nB = has_next ? (const char*)g.Bt + nxt.boff : cB;
        if constexpr (GATHER) { if (has_next) { PG8_SETOFF(nOA, nxt); } else {
#pragma unroll
            for (int _h = 0; _h < 2; ++_h)
#pragma unroll
                for (int _i = 0; _i < 2; ++_i) nOA[_h][_i] = cOA[_h][_i]; } }
        for (int t = 0; t < nt; t += 2) {
            const bool last = (t == nt - 2);
            if constexpr (Epi::MID) { if (t == nt / 2) E.mid(acc, cur, wr, lds); }
            const char* a1 = cA + (size_t)(t + 1) * kstep;
            const char* a2 = last ? nA : cA + (size_t)(t + 2) * kstep; const char* b2 = last ? nB : cB + (size_t)(t + 2) * kstep;
            const char* a3 = a2 + kstep; const char* b3 = b2 + kstep;
            unsigned x00 = 0, x01 = 0, x10 = 0, x11 = 0;
            if constexpr (GATHER) { x00 = last ? nOA[0][0] : cOA[0][0]; x01 = last ? nOA[0][1] : cOA[0][1]; x10 = last ? nOA[1][0] : cOA[1][0]; x11 = last ? nOA[1][1] : cOA[1][1]; }
            PG8_LDB(B0, 0, 0); PG8_LDB(B1, 0, 1); PG8_SCHED; PG8_LDA(At, 0, 0); PG8_STAGE_A(PG8_SA(1, 1), a1, 1, cOA[1][0], cOA[1][1]);
            PG8_WAIT_V(8); PG8_WAIT_L(0); PG8_BAR; PG8_MMA(0, 0, At, B0); PG8_MMA(0, 1, At, B1); PG8_BAR; PG8_SCHED;
            PG8_LDA(At, 0, 1); PG8_STAGE_B(PG8_SB(0, 0), b2); PG8_STAGE_B(PG8_SB(0, 1), b2 + hstep); PG8_STAGE_A(PG8_SA(0, 0), a2, 0, x00, x01);
            PG8_WAIT_V(8); PG8_WAIT_L(0); PG8_BAR; PG8_MMA(1, 0, At, B0); PG8_MMA(1, 1, At, B1); PG8_BAR; PG8_SCHED;
            PG8_LDB(B0, 1, 0); PG8_LDB(B1, 1, 1); PG8_SCHED; PG8_LDA(At, 1, 0); PG8_STAGE_A(PG8_SA(0, 1), a2, 1, x10, x11);
            PG8_WAIT_V(8); PG8_WAIT_L(0); PG8_BAR; PG8_MMA(0, 0, At, B0); PG8_MMA(0, 1, At, B1); PG8_BAR; PG8_SCHED;
            PG8_LDA(At, 1, 1); PG8_STAGE_B(PG8_SB(1, 0), b3); PG8_STAGE_B(PG8_SB(1, 1), b3 + hstep); PG8_STAGE_A(PG8_SA(1, 0), a3, 0, x00, x01);
            PG8_WAIT_V(8); PG8_WAIT_L(0); PG8_BAR; PG8_MMA(1, 0, At, B0); PG8_MMA(1, 1, At, B1); PG8_BAR; PG8_SCHED;
        }
        if (wr == 0) PG8_BAR;
        if constexpr (Epi::MID) E(acc, cur, wr, wc, lds); else E(acc, cur, wr, wc);
        S.done(cur);
        if (!has_next) break;
        if constexpr (Epi::MID) { PG8_BAR; E.pre(lds, nxt, wr); }
#pragma unroll
        for (int a = 0; a < 2; ++a)
#pragma unroll
            for (int b = 0; b < 2; ++b)
#pragma unroll
                for (int m = 0; m < 4; ++m)
#pragma unroll
                    for (int n = 0; n < 2; ++n) acc[a][b][m][n] = (f32x4){0.f, 0.f, 0.f, 0.f};
        cur = nxt; cA = nA; cB = nB; ++ui;
        if constexpr (GATHER) {
#pragma unroll
            for (int _h = 0; _h < 2; ++_h)
#pragma unroll
                for (int _i = 0; _i < 2; ++_i) cOA[_h][_i] = nOA[_h][_i]; }
        if (wr == 1) PG8_BAR;
    }
    PG8_WAIT_V(0);
    PG8_BAR;
#undef PG8_SA
#undef PG8_SB
#undef PG8_STAGE_A
#undef PG8_STAGE_B
#undef PG8_LDA
#undef PG8_LDB
#undef PG8_MMA
#undef PG8_WAIT_V
#undef PG8_WAIT_L
#undef PG8_BAR
#undef PG8_SCHED
#undef PG8_SETOFF
}
}
typedef float f32x2 __attribute__((ext_vector_type(2)));
using pg8::cvt_pk_bf16;

struct EpiProj {
    static constexpr bool PERM = true, MID = false;
    bf16_t* O; float* iw; float* logf; const float* b_forget; unsigned char* ikf;
    __device__ __forceinline__ void operator()(const f32x4 (&acc)[2][2][4][2], const pg8::Unit& u, int wr, int wc) const {
        int ln_ = threadIdx.x & 63; asm volatile("" : "+v"(ln_)); const int fr = ln_ & 15, fq = ln_ >> 4;
        const int row0 = u.pm * 256 + wr * 64 + fr, col0 = u.pn * 256 + wc * 32 + 8 * fq;
        const float sc = (u.pn < 4) ? C2 : 1.f;
#pragma unroll
        for (int ai = 0; ai < 2; ++ai)
#pragma unroll
            for (int m = 0; m < 4; ++m) {
                const int row = row0 + ai * 128 + m * 16;
                bf16_t* rowp = O + (size_t)row * NPROJ + col0;
#pragma unroll
                for (int bj = 0; bj < 2; ++bj) {
                    const f32x4 v0 = acc[ai][bj][m][0] * sc, v1 = acc[ai][bj][m][1] * sc;
                    u32x4 w; w.x = cvt_pk_bf16(v0[0], v0[1]); w.y = cvt_pk_bf16(v0[2], v0[3]); w.z = cvt_pk_bf16(v1[0], v1[1]); w.w = cvt_pk_bf16(v1[2], v1[3]);
                    *(u32x4*)(rowp + bj * 128) = w;
                    if (u.pn == 11 && bj == 0 && wc < 2)
                        *(u32x4*)(ikf + ((size_t)(row >> 5) << 12) + (wc * 2 + (fq >> 1)) * 1024 + (row & 31) * 32 + (fq & 1) * 16) = w;
                }
                if (u.pn == 11 && wc == 2 && fq < 2) {
                    const f32x4 v0 = acc[ai][0][m][0], v1 = acc[ai][0][m][1];
                    if (fq == 0) { *(f32x4*)(iw + (size_t)row * 8) = v0; *(f32x4*)(iw + (size_t)row * 8 + 4) = v1; }
                    else {
                        f32x4 o0, o1;
#pragma unroll
                        for (int i = 0; i < 4; ++i) {
                            const float z0 = v0[i] + b_forget[i], z1 = v1[i] + b_forget[4 + i];
                            o0[i] = fminf(z0, 0.f) - log1pf(__expf(-fabsf(z0))); o1[i] = fminf(z1, 0.f) - log1pf(__expf(-fabsf(z1)));
                        }
                        *(f32x4*)(logf + (size_t)row * 8) = o0; *(f32x4*)(logf + (size_t)row * 8 + 4) = o1;
                    }
                }
            }
    }
};

struct EpiOut {
    static constexpr bool PERM = false, MID = true;
    const float* x; float* x1; const float* mod; const float* ssq; float* x1ssq;
    __device__ __forceinline__ void rowscale(int row, int fq, float& ra, float& rb) const {
        const f32x4 a = *((const f32x4*)(ssq + (size_t)row * 16) + fq);
        const float t = (a[0] + a[1]) + (a[2] + a[3]);
        const float u2 = t + __shfl_xor(t, 16), v2 = __shfl_xor(u2, 32);
        const float sa = (fq < 2) ? u2 : v2, sb = (fq < 2) ? v2 : u2;
        ra = 1.f / sqrtf(sa * (1.f / 512.f) + EPS); rb = 1.f / sqrtf(sb * (1.f / 512.f) + EPS);
    }
    static constexpr int EPRE_OFF = 131072 + 2048;
    __device__ __forceinline__ void pre(LAS unsigned char* lds, const pg8::Unit& u, int wr) const {
        int ln_ = threadIdx.x & 63; asm volatile("" : "+v"(ln_)); const int fr = ln_ & 15, fq = ln_ >> 4;
        LAS f32x2* pr = (LAS f32x2*)(lds + EPRE_OFF);
        f32x4 a[8];
#pragma unroll
        for (int i = 0; i < 8; ++i) a[i] = *((const f32x4*)(ssq + (size_t)(u.pm * 256 + (i >> 2) * 128 + wr * 64 + (i & 3) * 16 + fr) * 16) + fq);
#pragma unroll
        for (int i = 0; i < 8; ++i) {
            const float t = (a[i][0] + a[i][1]) + (a[i][2] + a[i][3]);
            const float u2 = t + __shfl_xor(t, 16), v2 = __shfl_xor(u2, 32);
            const float sa = (fq < 2) ? u2 : v2, sb = (fq < 2) ? v2 : u2;
            const float ra = 1.f / sqrtf(sa * (1.f / 512.f) + EPS), rb = 1.f / sqrtf(sb * (1.f / 512.f) + EPS);
            f32x2 w2; w2.x = ra / rb; w2.y = rb;
            pr[(i >> 2) * 128 + wr * 64 + (i & 3) * 16 + fr] = w2;
        }
    }
    __device__ __forceinline__ void mid(f32x4 (&acc)[2][2][4][2], const pg8::Unit& u, int wr, LAS unsigned char* lds) const {
        int ln_ = threadIdx.x & 63; asm volatile("" : "+v"(ln_)); const int fr = ln_ & 15;
        const LAS f32x2* pr = (const LAS f32x2*)(lds + EPRE_OFF);
#pragma unroll
        for (int ai = 0; ai < 2; ++ai)
#pragma unroll
            for (int m = 0; m < 4; ++m) {
                const float f = pr[ai * 128 + wr * 64 + m * 16 + fr].x;
#pragma unroll
                for (int bj = 0; bj < 2; ++bj)
#pragma unroll
                    for (int n = 0; n < 2; ++n) acc[ai][bj][m][n] = acc[ai][bj][m][n] * f;
            }
    }
    __device__ __forceinline__ void operator()(const f32x4 (&acc)[2][2][4][2], const pg8::Unit& u, int wr, int wc, LAS unsigned char* lds) const {
        int ln_ = threadIdx.x & 63; asm volatile("" : "+v"(ln_)); const int fr = ln_ & 15, fq = ln_ >> 4;
        const LAS f32x2* pr = (const LAS f32x2*)(lds + EPRE_OFF);
        const int col0 = u.pn * 256 + wc * 32 + 4 * fq;
        bf16_t* x1b = (bf16_t*)x1;
        f32x4 gmv[2][2];
        {
            const int b0 = (u.pm * 256) >> 11;
#pragma unroll
            for (int bj = 0; bj < 2; ++bj)
#pragma unroll
                for (int n = 0; n < 2; ++n) gmv[bj][n] = *(const f32x4*)(mod + b0 * NMOD + 2 * DM + col0 + bj * 128 + n * 16);
        }
#pragma unroll
        for (int ai = 0; ai < 2; ++ai)
#pragma unroll
            for (int m = 0; m < 4; ++m) {
                const int row = u.pm * 256 + ai * 128 + wr * 64 + m * 16 + fr;
                const float rb = pr[ai * 128 + wr * 64 + m * 16 + fr].y;
                float q = 0.f;
#pragma unroll
                for (int bj = 0; bj < 2; ++bj)
#pragma unroll
                    for (int n = 0; n < 2; ++n) {
                        const int col = col0 + bj * 128 + n * 16;
                        const f32x4 xv = __builtin_nontemporal_load((const f32x4*)(x + (size_t)row * DM + col)), gm = gmv[bj][n];
                        const f32x4 o = xv + gm * (acc[ai][bj][m][n] * rb);
                        u32x2 w; w.x = cvt_pk_bf16(o[0], o[1]); w.y = cvt_pk_bf16(o[2], o[3]);
                        *(u32x2*)(x1b + (size_t)row * (2 * DM) + col) = w;
                        q += (o[0] * o[0] + o[1] * o[1]) + (o[2] * o[2] + o[3] * o[3]);
                    }
                q += __shfl_xor(q, 16); q += __shfl_xor(q, 32);
                if (fq == 0) x1ssq[(size_t)row * 16 + u.pn * 4 + wc] = q;
            }
    }
};

struct EpiAct {
    static constexpr bool PERM = true, MID = false;
    bf16_t* act; const int* list; const float* rw;
    __device__ __forceinline__ void operator()(const f32x4 (&acc)[2][2][4][2], const pg8::Unit& u, int wr, int wc) const {
        int ln_ = threadIdx.x & 63; asm volatile("" : "+v"(ln_)); const int fr = ln_ & 15, fq = ln_ >> 4;
        const int col0 = u.pn * 128 + wc * 32 + 8 * fq;
#pragma unroll
        for (int ai = 0; ai < 2; ++ai)
#pragma unroll
            for (int m = 0; m < 4; ++m) {
                const int rl = ai * 128 + wr * 64 + m * 16 + fr;
                float w = 0.f;
                if (u.r0 + rl < u.cnt) w = rw[list[u.e * 16384 + u.r0 + rl]];
                f32x4 o[2];
#pragma unroll
                for (int n = 0; n < 2; ++n)
#pragma unroll
                    for (int i = 0; i < 4; ++i) { const float gv = acc[ai][0][m][n][i], uv = acc[ai][1][m][n][i]; o[n][i] = gv / (1.f + __expf(-gv)) * uv * w; }
                u32x4 pk; pk.x = cvt_pk_bf16(o[0][0], o[0][1]); pk.y = cvt_pk_bf16(o[0][2], o[0][3]); pk.z = cvt_pk_bf16(o[1][0], o[1][1]); pk.w = cvt_pk_bf16(o[1][2], o[1][3]);
                *(u32x4*)(act + ((size_t)u.pm * 256 + rl) * 256 + col0) = pk;
            }
    }
};

struct EpiDown {
    static constexpr bool PERM = true, MID = false;
    bf16_t* y; const int* list;
    __device__ __forceinline__ void operator()(const f32x4 (&acc)[2][2][4][2], const pg8::Unit& u, int wr, int wc) const {
        int ln_ = threadIdx.x & 63; asm volatile("" : "+v"(ln_)); const int fr = ln_ & 15, fq = ln_ >> 4;
        const int col0 = u.pn * 256 + wc * 32 + 8 * fq;
#pragma unroll
        for (int ai = 0; ai < 2; ++ai)
#pragma unroll
            for (int m = 0; m < 4; ++m) {
                const int rl = ai * 128 + wr * 64 + m * 16 + fr;
                if (u.r0 + rl < u.cnt) {
                    const int slot = list[u.e * 16384 + u.r0 + rl];
#pragma unroll
                    for (int bj = 0; bj < 2; ++bj) {
                        const f32x4 v0 = acc[ai][bj][m][0], v1 = acc[ai][bj][m][1];
                        u32x4 pk; pk.x = cvt_pk_bf16(v0[0], v0[1]); pk.y = cvt_pk_bf16(v0[2], v0[3]); pk.z = cvt_pk_bf16(v1[0], v1[1]); pk.w = cvt_pk_bf16(v1[2], v1[3]);
                        *(u32x4*)(y + (size_t)slot * DM + col0 + bj * 128) = pk;
                    }
                }
            }
    }
};

constexpr int MOE_TAB_OFF = 131072 + 1024;
__device__ __forceinline__ void moe_order_setup(const unsigned* cnt, LAS int* tab) {
    const int tid = threadIdx.x;
    if (tid < 64) {
        const int e = tid & 31;
        const int c = (int)cnt[e * 64];
        const int nt_ = (c + 255) >> 8;
        int inc = nt_;
#pragma unroll
        for (int o = 1; o < 32; o <<= 1) { const int t = __shfl_up(inc, o, 32); if (e >= o) inc += t; }
        if (tid < 32) { tab[e] = c; tab[32 + e] = inc - nt_; if (e == 31) tab[64] = inc; }
    }
    __syncthreads();
}
struct MoeOrder {
    const LAS int* tab; const int* list; unsigned* flags; int NN, G, c; size_t a_tile, b_exp, b_tile; bool gather; int mode; int c0;
    __device__ bool next(int i, pg8::Unit& u) const {
        const int L = (i == 0) ? c0 : i * G + c, tau = L / NN, pn = L - tau * NN;
        if (tau >= __builtin_amdgcn_readfirstlane(tab[64])) return false;
        int e = 0;
#pragma unroll 1
        for (int s = 16; s >= 1; s >>= 1) if (__builtin_amdgcn_readfirstlane(tab[32 + e + s]) <= tau) e += s;
        u.pm = tau; u.pn = pn; u.e = e; u.r0 = (tau - __builtin_amdgcn_readfirstlane(tab[32 + e])) * 256; u.cnt = __builtin_amdgcn_readfirstlane(tab[e]);
        u.aoff = gather ? 0 : (size_t)tau * a_tile; u.boff = (size_t)e * b_exp + (size_t)pn * b_tile; return true;
    }
    __device__ __forceinline__ unsigned arow(const pg8::Unit& u, int R) const {
        int r = u.r0 + R; if (r >= u.cnt) r = u.cnt - 1;
        return (unsigned)(list[u.e * 16384 + r] >> 1);
    }
    __device__ __forceinline__ void a_ready(const pg8::Unit& u) const {
        if (mode == 1) {
            unsigned* f = flags + 32 * u.pm; unsigned sp = 0;
            while (__hip_atomic_load(f, __ATOMIC_RELAXED, __HIP_MEMORY_SCOPE_AGENT) < 2u) { __builtin_amdgcn_s_sleep(4); if (++sp > (1u << 20)) break; }
            asm volatile("" ::: "memory");
        }
    }
    __device__ __forceinline__ void done(const pg8::Unit& u) const {
        if (mode == 0) {
            asm volatile("s_waitcnt vmcnt(0)" ::: "memory");
            __builtin_amdgcn_s_barrier();
            if (threadIdx.x == 0) {
                __builtin_amdgcn_fence(__ATOMIC_RELEASE, "agent");
                asm volatile("s_waitcnt vmcnt(0)" ::: "memory");
                __hip_atomic_fetch_add(flags + 32 * u.pm, 1u, __ATOMIC_RELAXED, __HIP_MEMORY_SCOPE_AGENT);
            }
        }
    }
};
constexpr int AT_K = 0, AT_V = 16384, AT_CUM = 32768, AT_WSF = 40960, AT_OST = 43008, AT_END = 43008 + 32768;
constexpr float ATT_THR = 6.0f;
__device__ __forceinline__ int crow(int r, int hi) { return (r & 3) + 8 * (r >> 2) + 4 * hi; }
typedef short v4i16_t __attribute__((ext_vector_type(4)));
__device__ __forceinline__ v4i16_t vtr(const LAS unsigned char* p) { return __builtin_amdgcn_ds_read_tr16_b64_v4i16((LAS v4i16_t*)p); }
__device__ __forceinline__ float max3f(float a, float b, float c) { return fmaxf(fmaxf(a, b), c); }

template <int MODE> __device__ __forceinline__ void att_cinit(f32x16& c0, f32x16& c1, const LAS float* cumk, int kv0, int hi, float m_run, float slope2, u32x2 mw, int qrow, bool band) {
    if (MODE == 0) {
#pragma unroll
        for (int g4 = 0; g4 < 4; ++g4) {
            const f32x4 a = *(const LAS f32x4*)(cumk + kv0 + 8 * g4 + 4 * hi), c = *(const LAS f32x4*)(cumk + kv0 + 32 + 8 * g4 + 4 * hi);
#pragma unroll
            for (int i = 0; i < 4; ++i) { c0[4 * g4 + i] = a[i] - m_run; c1[4 * g4 + i] = c[i] - m_run; }
        }
        if (band) {
#pragma unroll
            for (int r = 0; r < 16; ++r) { const int kv = kv0 + crow(r, hi); if (kv > qrow) c0[r] = -INFINITY; if (kv + 32 > qrow) c1[r] = -INFINITY; }
        }
    } else {
        const float base0 = slope2 * (float)(kv0 + 4 * hi) - m_run, base1 = base0 + slope2 * 32.f;
        const unsigned w0 = mw.x >> (4 * hi), w1 = mw.y >> (4 * hi);
#pragma unroll
        for (int r = 0; r < 16; ++r) {
            const int cr = (r & 3) + 8 * (r >> 2);
            const float v0 = fmaf(slope2, (float)cr, base0), v1 = fmaf(slope2, (float)cr, base1);
            const int t0 = ((int)(w0 << (31 - cr))) >> 31, t1 = ((int)(w1 << (31 - cr))) >> 31;
            c0[r] = __builtin_bit_cast(float, (__builtin_bit_cast(int, v0) & t0) | (int)(0xff800000u & ~(unsigned)t0));
            c1[r] = __builtin_bit_cast(float, (__builtin_bit_cast(int, v1) & t1) | (int)(0xff800000u & ~(unsigned)t1));
        }
    }
}
__device__ __forceinline__ void att_kload(bf16x8 (&kf)[8], const LAS unsigned char* kb) {
#pragma unroll
    for (int d0 = 0; d0 < 4; ++d0) { kf[2 * d0] = *(const LAS bf16x8*)(kb + d0 * 2048); kf[2 * d0 + 1] = *(const LAS bf16x8*)(kb + d0 * 2048 + 512); }
}
struct AttState { float m_run, l_run; bool started, resc; };

template <int MODE, bool FIRST, bool HAS_NEXT>
__device__ __forceinline__ void att_step(f32x16& X0, f32x16& X1, f32x16& Y0, f32x16& Y1, f32x16 (&o)[2], const bf16x8 (&qr)[4], bf16x8 (&kf)[8], AttState& st,
                                         const LAS unsigned char* vprev, const LAS unsigned char* knext, int kv0_next, u32x2 mw_next, bool band_next,
                                         const LAS float* cumk, LAS float* wsf, int r32, int hi, float slope2, int qrow) {
#pragma unroll
    for (int d0 = 0; d0 < 4; ++d0) {
        X0 = __builtin_amdgcn_mfma_f32_32x32x16_bf16(kf[2 * d0], qr[d0], X0, 0, 0, 0);
        X1 = __builtin_amdgcn_mfma_f32_32x32x16_bf16(kf[2 * d0 + 1], qr[d0], X1, 0, 0, 0);
    }
    bf16x8 pa[4];
    if (!FIRST) {
        float s0 = 0.f, s1 = 0.f, s2 = 0.f, s3 = 0.f;
#pragma unroll
        for (int r = 0; r < 16; r += 4) { s0 += Y0[r] + Y1[r]; s1 += Y0[r + 1] + Y1[r + 1]; s2 += Y0[r + 2] + Y1[r + 2]; s3 += Y0[r + 3] + Y1[r + 3]; }
        st.l_run += (s0 + s1) + (s2 + s3);
#pragma unroll
        for (int s = 0; s < 2; ++s) {
            u32x4 w0, w1;
            w0.x = pg8::cvt_pk_bf16(Y0[8 * s + 0], Y0[8 * s + 1]); w0.y = pg8::cvt_pk_bf16(Y0[8 * s + 2], Y0[8 * s + 3]); w0.z = pg8::cvt_pk_bf16(Y0[8 * s + 4], Y0[8 * s + 5]); w0.w = pg8::cvt_pk_bf16(Y0[8 * s + 6], Y0[8 * s + 7]);
            w1.x = pg8::cvt_pk_bf16(Y1[8 * s + 0], Y1[8 * s + 1]); w1.y = pg8::cvt_pk_bf16(Y1[8 * s + 2], Y1[8 * s + 3]); w1.z = pg8::cvt_pk_bf16(Y1[8 * s + 4], Y1[8 * s + 5]); w1.w = pg8::cvt_pk_bf16(Y1[8 * s + 6], Y1[8 * s + 7]);
            pa[s] = __builtin_bit_cast(bf16x8, w0); pa[2 + s] = __builtin_bit_cast(bf16x8, w1);
        }
    }
    {
        float a = max3f(X0[0], X0[1], X1[0]), c = max3f(X0[2], X0[3], X1[1]); a = max3f(a, X1[2], X1[3]);
#pragma unroll
        for (int r = 4; r < 16; r += 4) { a = max3f(a, X0[r], X0[r + 1]); c = max3f(c, X0[r + 2], X0[r + 3]); a = max3f(a, X1[r], X1[r + 1]); c = max3f(c, X1[r + 2], X1[r + 3]); }
        float rm = fmaxf(a, c); rm = fmaxf(rm, __shfl_xor(rm, 32));
        const bool bump = st.started ? (rm > ATT_THR) : (rm > -INFINITY);
        if (__any(bump)) {
            const float dl = bump ? rm : 0.f;
#pragma unroll
            for (int r = 0; r < 16; ++r) { X0[r] -= dl; X1[r] -= dl; }
            st.m_run += dl;
            const float f = (bump && st.started) ? __builtin_amdgcn_exp2f(-dl) : 1.f;
            st.l_run *= f; if (hi == 0) wsf[r32] = f; st.resc = true; st.started = st.started || bump;
        }
    }
    if (!FIRST) {
#pragma unroll
        for (int ks = 0; ks < 4; ++ks)
#pragma unroll
            for (int d0 = 0; d0 < 2; ++d0) {
                const v4i16_t lo = vtr(vprev + d0 * 4096 + ks * 1024), hh = vtr(vprev + d0 * 4096 + ks * 1024 + 512);
                const bf16x8 vf = (bf16x8){lo[0], lo[1], lo[2], lo[3], hh[0], hh[1], hh[2], hh[3]};
                o[d0] = __builtin_amdgcn_mfma_f32_32x32x16_bf16(pa[ks], vf, o[d0], 0, 0, 0);
            }
    }
#pragma unroll
    for (int r = 0; r < 16; ++r) { X0[r] = __builtin_amdgcn_exp2f(X0[r]); X1[r] = __builtin_amdgcn_exp2f(X1[r]); }
    if (HAS_NEXT) { att_kload(kf, knext); att_cinit<MODE>(Y0, Y1, cumk, kv0_next, hi, st.m_run, slope2, mw_next, qrow, band_next); }
    if (st.resc) {
#pragma unroll
        for (int g4 = 0; g4 < 4; ++g4) {
            const f32x4 fv = *(const LAS f32x4*)(wsf + 8 * g4 + 4 * hi);
#pragma unroll
            for (int i = 0; i < 4; ++i) { o[0][4 * g4 + i] *= fv[i]; o[1][4 * g4 + i] *= fv[i]; }
        }
        st.resc = false;
    }
}

template <int MODE>
__device__ __forceinline__ void attn_unit(const Params& p, int b, int h, int qb, LAS unsigned char* lds, bool do_scan) {
    int tid_ = threadIdx.x; asm volatile("" : "+v"(tid_)); const int tid = tid_, lane = tid & 63, r32 = lane & 31, hi = lane >> 5, wid = __builtin_amdgcn_readfirstlane(tid >> 6);
    const bf16_t* proj = (const bf16_t*)(p.ws + WS_PROJ);
    const int rowbase = b * SEQ, q0 = qb * 256;
    const int qcol = (MODE == 0 ? C_BQ : C_AQ) + h * 64;
    const int kcol = (MODE == 0 ? C_BK + h * 64 : C_AK + (h >> 2) * 64);
    const int vcol = (MODE == 0 ? C_BV + h * 64 : C_AV + (h >> 2) * 64);
    const int NT = (q0 + 256) / 64;
    LAS float* cumk = (LAS float*)(lds + AT_CUM);
    LAS float* wsf = (LAS float*)(lds + AT_WSF) + wid * 64;
    if (MODE == 0 && do_scan) {
        const float* lf = (const float*)(p.ws + WS_LOGF);
        const int NK = q0 + 256;
        float v[4]; float run = 0.f;
#pragma unroll
        for (int i = 0; i < 4; ++i) { const int s = 4 * tid + i; const float x = (s < NK) ? lf[(size_t)(rowbase + s) * 8 + h] : 0.f; run += x; v[i] = run; }
        float inc = run;
#pragma unroll
        for (int o = 1; o < 64; o <<= 1) { const float t = __shfl_up(inc, o); if (lane >= o) inc += t; }
        LAS float* wt = (LAS float*)(lds + AT_WSF);
        if (lane == 63) wt[wid] = inc;
        __syncthreads();
        float pre = inc - run;
        for (int w = 0; w < wid; ++w) pre += wt[w];
#pragma unroll
        for (int i = 0; i < 4; ++i) cumk[4 * tid + i] = -(pre + v[i]) * LOG2E;
        __syncthreads();
    }
    const float slope2 = (MODE == 1) ? exp2f(-(float)(h + 1)) * LOG2E : 0.f;
    const bf16_t* ksrc = proj + (size_t)(rowbase + lane) * NPROJ + kcol + wid * 8;
    const bf16_t* vsrc = proj + (size_t)(rowbase + 16 * (wid & 3) + (lane >> 2)) * NPROJ + vcol + (wid >> 2) * 32 + (lane & 3) * 8;
    const int stoff = wid * 1024 + lane * 16;
    const size_t tstride = (size_t)64 * NPROJ;
    {
        const u32x4 k0 = *(const u32x4*)(ksrc + (size_t)(NT - 1) * tstride), k1 = *(const u32x4*)(ksrc + (size_t)(NT - 2) * tstride);
        *(LAS u32x4*)(lds + AT_K + stoff) = k0; *(LAS u32x4*)(lds + AT_K + 8192 + stoff) = k1;
    }
    const int qrow = q0 + wid * 32 + r32;
    bf16x8 qr[4];
    {
        const bf16_t* qp = proj + (size_t)(rowbase + qrow) * NPROJ + qcol + hi * 8;
#pragma unroll
        for (int d0 = 0; d0 < 4; ++d0) qr[d0] = *(const bf16x8*)(qp + d0 * 16);
    }
    const unsigned* mrow = (const unsigned*)(p.ws + WS_MASK) + (size_t)(rowbase + qrow) * 64;
    __syncthreads();
    AttState st; st.m_run = 0.f; st.l_run = 0.f; st.started = false; st.resc = false;
    f32x16 o[2]; o[0] = f32x16{}; o[1] = f32x16{};
    f32x16 A0, A1, B0, B1; A0 = f32x16{}; A1 = f32x16{}; B0 = f32x16{}; B1 = f32x16{};
    bf16x8 kf[8];
    const int wq_lo = q0 + wid * 32;
    const LAS unsigned char* kfrag = lds + AT_K + hi * 1024 + r32 * 16;
    const LAS unsigned char* vfrag = lds + AT_V + ((lane >> 4) & 1) * 32 + (lane & 3) * 8 + (4 * hi + ((lane & 15) >> 2)) * 64;
    {
        att_kload(kf, kfrag);
        u32x2 mw = (u32x2){0u, 0u}; if (MODE == 1) mw = *(const u32x2*)(mrow + 2 * (NT - 1));
        att_cinit<MODE>(A0, A1, cumk, 64 * (NT - 1), hi, 0.f, slope2, mw, qrow, true);
    }
    LDS_BARRIER();
#define ATT_ITER(U, FIRST_, NEXT_, X0, X1, Y0, Y1) do { const int u = (U); \
        int tk = NT - 3 - u; tk = tk < 0 ? 0 : tk; \
        const u32x4 kreg = *(const u32x4*)(ksrc + (size_t)tk * tstride); \
        const u32x4 vreg = *(const u32x4*)(vsrc + (size_t)(NT - 1 - u) * tstride); \
        int tn = NT - 2 - u; tn = tn < 0 ? 0 : tn; \
        u32x2 mwn = (u32x2){0u, 0u}; \
        if (MODE == 1) mwn = *(const u32x2*)(mrow + 2 * tn); \
        const LAS unsigned char* vprev = vfrag + ((u - 1) & 1) * 8192; \
        const LAS unsigned char* knext = kfrag + ((u + 1) & 1) * 8192; \
        att_step<MODE, FIRST_, NEXT_>(X0, X1, Y0, Y1, o, qr, kf, st, vprev, knext, 64 * tn, mwn, (64 * tn + 63 > wq_lo), cumk, wsf, r32, hi, slope2, qrow); \
        *(LAS u32x4*)(lds + AT_K + (u & 1) * 8192 + stoff) = kreg; \
        *(LAS u32x4*)(lds + AT_V + (u & 1) * 8192 + stoff) = vreg; \
        LDS_BARRIER(); } while (0)
    ATT_ITER(0, true, true, A0, A1, B0, B1);
    for (int uu = 1; uu < NT - 1; uu += 2) {
        ATT_ITER(uu, false, true, B0, B1, A0, A1);
        ATT_ITER(uu + 1, false, true, A0, A1, B0, B1);
    }
    ATT_ITER(NT - 1, false, false, B0, B1, A0, A1);
#undef ATT_ITER
    {
        const f32x16 Y0 = B0, Y1 = B1;
        float s0 = 0.f, s1 = 0.f;
#pragma unroll
        for (int r = 0; r < 16; r += 2) { s0 += Y0[r] + Y1[r]; s1 += Y0[r + 1] + Y1[r + 1]; }
        st.l_run += s0 + s1;
        const LAS unsigned char* vprev = vfrag + ((NT - 1) & 1) * 8192;
#pragma unroll
        for (int s = 0; s < 4; ++s) {
            u32x4 w;
            if (s < 2) { w.x = pg8::cvt_pk_bf16(Y0[8 * s + 0], Y0[8 * s + 1]); w.y = pg8::cvt_pk_bf16(Y0[8 * s + 2], Y0[8 * s + 3]); w.z = pg8::cvt_pk_bf16(Y0[8 * s + 4], Y0[8 * s + 5]); w.w = pg8::cvt_pk_bf16(Y0[8 * s + 6], Y0[8 * s + 7]); }
            else { const int q = s - 2; w.x = pg8::cvt_pk_bf16(Y1[8 * q + 0], Y1[8 * q + 1]); w.y = pg8::cvt_pk_bf16(Y1[8 * q + 2], Y1[8 * q + 3]); w.z = pg8::cvt_pk_bf16(Y1[8 * q + 4], Y1[8 * q + 5]); w.w = pg8::cvt_pk_bf16(Y1[8 * q + 6], Y1[8 * q + 7]); }
            const bf16x8 pa = __builtin_bit_cast(bf16x8, w);
#pragma unroll
            for (int d0 = 0; d0 < 2; ++d0) {
                const v4i16_t lo = vtr(vprev + d0 * 4096 + s * 1024), hh = vtr(vprev + d0 * 4096 + s * 1024 + 512);
                const bf16x8 vf = (bf16x8){lo[0], lo[1], lo[2], lo[3], hh[0], hh[1], hh[2], hh[3]};
                o[d0] = __builtin_amdgcn_mfma_f32_32x32x16_bf16(pa, vf, o[d0], 0, 0, 0);
            }
        }
    }
    float l_run = st.l_run;
    l_run += __shfl_xor(l_run, 32);
    if (hi == 0) wsf[32 + r32] = l_run;
    float rli[16];
#pragma unroll
    for (int g4 = 0; g4 < 4; ++g4) {
        const f32x4 lv = *(const LAS f32x4*)(wsf + 32 + 8 * g4 + 4 * hi);
#pragma unroll
        for (int i = 0; i < 4; ++i) rli[4 * g4 + i] = 1.f / lv[i];
    }
    LAS bf16_t* stg = (LAS bf16_t*)(lds + AT_OST) + wid * 2048;
#pragma unroll
    for (int r = 0; r < 16; ++r) {
        const int orow = crow(r, hi);
#pragma unroll
        for (int d0 = 0; d0 < 2; ++d0) stg[orow * 64 + d0 * 32 + r32] = (bf16_t)f2bf(o[d0][r] * rli[r]);
    }
    bf16_t* O = (bf16_t*)(p.ws + WS_O);
    float* ssq = (float*)(p.ws + WS_SSQ);
    const int ocol = (MODE == 1 ? 0 : 512) + h * 64, slot = (MODE == 1 ? 0 : 8) + h;
#pragma unroll
    for (int i = 0; i < 4; ++i) {
        const int row = i * 8 + (lane >> 3), ch = lane & 7;
        const u32x4 v = *(const LAS u32x4*)(stg + row * 64 + ch * 8);
        const size_t grow = (size_t)(rowbase + q0 + wid * 32 + row);
        *(u32x4*)(O + grow * DM + ocol + ch * 8) = v;
        float q = 0.f;
#pragma unroll
        for (int j = 0; j < 4; ++j) { const float a = bf2f((unsigned short)(v[j] & 0xffff)), c = bf2f((unsigned short)(v[j] >> 16)); q += a * a + c * c; }
        q += __shfl_xor(q, 1); q += __shfl_xor(q, 2); q += __shfl_xor(q, 4);
        if (ch == 0) ssq[grow * 16 + slot] = q;
    }
    LDS_BARRIER();
}
constexpr int IX_SC = 0, IX_HIST = 131072, IX_CAND = 131072 + 2048, IX_END = 131072 + 4096;
#define IX_DPP(OP, ctrl, rm) v = OP(v, __builtin_bit_cast(float, __builtin_amdgcn_update_dpp(__builtin_bit_cast(int, v), __builtin_bit_cast(int, v), ctrl, rm, 0xf, false)))
__device__ __forceinline__ float wave_maxf(float v) {
    IX_DPP(fmaxf, 0x111, 0xf); IX_DPP(fmaxf, 0x112, 0xf); IX_DPP(fmaxf, 0x114, 0xf); IX_DPP(fmaxf, 0x118, 0xf); IX_DPP(fmaxf, 0x142, 0xa); IX_DPP(fmaxf, 0x143, 0xc);
    return __builtin_bit_cast(float, __builtin_amdgcn_readlane(__builtin_bit_cast(int, v), 63));
}
__device__ __forceinline__ float wave_minf(float v) {
    IX_DPP(fminf, 0x111, 0xf); IX_DPP(fminf, 0x112, 0xf); IX_DPP(fminf, 0x114, 0xf); IX_DPP(fminf, 0x118, 0xf); IX_DPP(fminf, 0x142, 0xa); IX_DPP(fminf, 0x143, 0xc);
    return __builtin_bit_cast(float, __builtin_amdgcn_readlane(__builtin_bit_cast(int, v), 63));
}
#undef IX_DPP
struct IxOps { bf16x8 aq[2][4]; bf16x8 kf[2][4]; };
__device__ __forceinline__ void ix_prefetch(IxOps& X, const bf16_t* proj, const unsigned char* ikf, int rowbase, int t0, int wid, int r32, int hi) {
    const int i = r32, qi = 2 * ((i >> 2) & 1) + (i >> 4), head = 4 * ((i >> 3) & 1) + (i & 3);
#pragma unroll
    for (int g = 0; g < 2; ++g) {
        const bf16_t* ap = proj + (size_t)(rowbase + t0 + 4 * g + qi) * NPROJ + C_IQ + head * 64 + hi * 8;
#pragma unroll
        for (int d0 = 0; d0 < 4; ++d0) X.aq[g][d0] = *(const bf16x8*)(ap + d0 * 16);
    }
    const int NTI = (t0 + 7) / 32 + 1;
#pragma unroll
    for (int q = 0; q < 2; ++q) {
        const int j = wid + 8 * q;
        if (j < NTI) {
            const unsigned char* kp = ikf + ((size_t)((rowbase >> 5) + j) << 12) + r32 * 32 + hi * 16;
#pragma unroll
            for (int d0 = 0; d0 < 4; ++d0) X.kf[q][d0] = *(const bf16x8*)(kp + d0 * 1024);
        }
    }
}
__device__ __forceinline__ void ix_tile(const bf16x8 (&aq)[2][4], const bf16x8 (&kf)[4], const float (&wq)[2][2][8], LAS float* sc, int key, int hi) {
#pragma unroll
    for (int g = 0; g < 2; ++g) {
        f32x16 d = f32x16{};
#pragma unroll
        for (int d0 = 0; d0 < 4; ++d0) d = __builtin_amdgcn_mfma_f32_32x32x16_bf16(aq[g][d0], kf[d0], d, 0, 0, 0);
#pragma unroll
        for (int a = 0; a < 2; ++a) {
            float sv = 0.f;
#pragma unroll
            for (int hh = 0; hh < 8; ++hh) sv += wq[g][a][hh] * fmaxf(d[8 * a + hh], 0.f);
            sc[(4 * g + 2 * hi + a) * 2048 + key] = sv;
        }
    }
}
__device__ __forceinline__ void ix_score(const IxOps& X, const Params& p, int rowbase, int t0, LAS float* sc, int wid, int r32, int hi) {
    const unsigned char* ikf = p.ws + WS_IKF;
    const float* iwp = (const float*)(p.ws + WS_IW);
    const int NTI = (t0 + 7) / 32 + 1;
    float wq[2][2][8];
#pragma unroll
    for (int g = 0; g < 2; ++g)
#pragma unroll
        for (int a = 0; a < 2; ++a) {
            const float* wp = iwp + (size_t)(rowbase + t0 + 4 * g + 2 * hi + a) * 8;
            const f32x4 w0 = *(const f32x4*)wp, w1 = *(const f32x4*)(wp + 4);
#pragma unroll
            for (int j = 0; j < 4; ++j) { wq[g][a][j] = w0[j]; wq[g][a][4 + j] = w1[j]; }
        }
    bf16x8 cur[2][4], nxt[2][4];
#pragma unroll
    for (int q = 0; q < 2; ++q)
#pragma unroll
        for (int d0 = 0; d0 < 4; ++d0) { cur[q][d0] = X.kf[q][d0]; nxt[q][d0] = X.kf[q][d0]; }
#pragma unroll 1
    for (int bb = 0; bb < 4; ++bb) {
        if (wid + 16 * bb >= NTI) break;
#pragma unroll
        for (int q = 0; q < 2; ++q) {
            const int j = wid + 16 * (bb + 1) + 8 * q;
            if (bb < 3 && j < NTI) {
                const unsigned char* kp = ikf + ((size_t)((rowbase >> 5) + j) << 12) + r32 * 32 + hi * 16;
#pragma unroll
                for (int d0 = 0; d0 < 4; ++d0) nxt[q][d0] = *(const bf16x8*)(kp + d0 * 1024);
            }
        }
#pragma unroll
        for (int q = 0; q < 2; ++q) { const int j = wid + 16 * bb + 8 * q; if (j < NTI) ix_tile(X.aq, cur[q], wq, sc, 32 * j + r32, hi); }
#pragma unroll
        for (int q = 0; q < 2; ++q)
#pragma unroll
            for (int d0 = 0; d0 < 4; ++d0) cur[q][d0] = nxt[q][d0];
    }
}

template <int NR>
__device__ __forceinline__ int ix_count_ge(const float (&val)[NR], float piv, unsigned& accw) {
    unsigned acc = 0u;
    f32x2 pp; pp.x = piv; pp.y = piv;
#pragma unroll
    for (int i = 0; i < NR; i += 2) {
        f32x2 a; a.x = val[i]; a.y = val[i + 1];
        const f32x2 d = a - pp; const float dx = d.x, dy = d.y;
        acc = __builtin_amdgcn_alignbit(acc, __builtin_bit_cast(unsigned, dx), 31);
        acc = __builtin_amdgcn_alignbit(acc, __builtin_bit_cast(unsigned, dy), 31);
    }
    accw = acc;
    const int cl = NR - __popc(acc);
    int tot = 0;
#pragma unroll
    for (int b = 0; b < 6; ++b) tot += __popcll(__ballot((cl >> b) & 1)) << b;
    return tot;
}
template <int NR>
__device__ __forceinline__ void ix_select_impl(const LAS float* myv, LAS unsigned* hist, LAS float* cand, unsigned* mrow, int n, int lane) {
    float val[NR];
#pragma unroll
    for (int i = 0; i < NR; ++i) { const int key = 64 * i + lane; const float x = myv[key]; val[i] = (key < n) ? x : -INFINITY; }
    float vmax = -INFINITY, vmin = INFINITY;
#pragma unroll
    for (int i = 0; i < NR; ++i) { vmax = fmaxf(vmax, val[i]); vmin = fminf(vmin, (val[i] == -INFINITY) ? INFINITY : val[i]); }
    float lo = wave_minf(vmin); const float top0 = wave_maxf(vmax);
    float ub = INFINITY;
    const int k = 256;
    int cge_lo = n, cge_ub = 0;
    const int nv = (n - lane + 63) >> 6;
    unsigned acc_lo = (1u << (NR - nv)) - 1u, acc_ub = (NR == 32) ? 0xffffffffu : ((1u << (NR & 31)) - 1u);
    float vstar = lo; int rprime = k; bool ties = true;
    const unsigned long long ltmask = (lane == 0) ? 0ull : (~0ull >> (64 - lane));
#pragma unroll 1
    for (int iter = 0; iter < 200; ++iter) {
        const int c = cge_lo - cge_ub;
        if (c <= 64) {
            const int kr = k - cge_ub;
            unsigned B = ~acc_lo & acc_ub;
            const int pc = __popc(B);
            int slot = 0;
#pragma unroll
            for (int b = 0; b < 6; ++b) {
                const unsigned long long bm = __ballot((pc >> b) & 1);
                slot += (int)__builtin_amdgcn_mbcnt_hi((unsigned)(bm >> 32), __builtin_amdgcn_mbcnt_lo((unsigned)bm, 0u)) << b;
            }
            cand[lane] = -INFINITY;
            while (__any(B != 0u)) {
                if (B != 0u) { const int j = __ffs((int)B) - 1; cand[slot] = myv[64 * (NR - 1 - j) + lane]; ++slot; B &= B - 1u; }
            }
            const float mine = cand[lane];
            int gt = 0, ge = 0;
#pragma unroll 1
            for (int jj = 0; jj < c; jj += 16) {
                f32x4 x[4];
#pragma unroll
                for (int q = 0; q < 4; ++q) x[q] = *(const LAS f32x4*)(cand + jj + 4 * q);
#pragma unroll
                for (int q = 0; q < 4; ++q)
#pragma unroll
                    for (int e = 0; e < 4; ++e) { gt += (x[q][e] > mine) ? 1 : 0; ge += (x[q][e] >= mine) ? 1 : 0; }
            }
            const bool ok = (lane < c) && (gt < kr) && (kr <= ge);
            const unsigned long long om = __ballot(ok);
            const int L2 = om ? (__ffsll((long long)om) - 1) : 0;
            vstar = __builtin_bit_cast(float, __builtin_amdgcn_readlane(__builtin_bit_cast(int, mine), L2));
            const int gtl = __builtin_amdgcn_readlane(gt, L2), gel = __builtin_amdgcn_readlane(ge, L2);
            rprime = kr - gtl; ties = (gel - gtl) != rprime;
            break;
        }
        const float top = (ub == INFINITY) ? top0 : ub;
        const float mid = lo + (top - lo) * 0.5f;
        if (!(mid > lo) || !(mid < top)) {
            unsigned dummy;
            if (ub == INFINITY && top0 > lo) {
                const int m = ix_count_ge<NR>(val, top0, dummy);
                if (m >= k) { vstar = top0; rprime = k; } else { vstar = lo; rprime = k - m; }
            } else { vstar = lo; rprime = k - cge_ub; }
            ties = true;
            break;
        }
        unsigned aw;
        const int cnt = ix_count_ge<NR>(val, mid, aw);
        if (cnt >= k) { lo = mid; cge_lo = cnt; acc_lo = aw; } else { ub = mid; cge_ub = cnt; acc_ub = aw; }
    }
    LAS unsigned long long* mw = (LAS unsigned long long*)hist;
    unsigned wlo = 0u, whi = 0u;
    if (!ties) {
#define IX_WL(i) if (i < NR) { const unsigned long long sm = __ballot(val[i < NR ? i : 0] >= vstar); \
            asm volatile("s_nop 1\n\tv_writelane_b32 %0, %1, " #i : "+v"(wlo) : "s"((unsigned)sm)); asm volatile("v_writelane_b32 %0, %1, " #i : "+v"(whi) : "s"((unsigned)(sm >> 32))); }
        IX_WL(0) IX_WL(1) IX_WL(2) IX_WL(3) IX_WL(4) IX_WL(5) IX_WL(6) IX_WL(7) IX_WL(8) IX_WL(9) IX_WL(10) IX_WL(11) IX_WL(12) IX_WL(13) IX_WL(14) IX_WL(15)
        IX_WL(16) IX_WL(17) IX_WL(18) IX_WL(19) IX_WL(20) IX_WL(21) IX_WL(22) IX_WL(23) IX_WL(24) IX_WL(25) IX_WL(26) IX_WL(27) IX_WL(28) IX_WL(29) IX_WL(30) IX_WL(31)
#undef IX_WL
    } else {
        int run = 0;
#pragma unroll
        for (int i = 0; i < NR; ++i) {
            const float v = val[i];
            const bool eq = (v == vstar);
            const unsigned long long em = __ballot(eq);
            const bool sel = (v > vstar) || (eq && (run + __popcll(em & ltmask)) < rprime);
            run += __popcll(em);
            const unsigned long long sm = __ballot(sel);
            if (lane == 0) mw[i] = sm;
        }
    }
    if (ties && lane < NR) { const unsigned long long w = mw[lane < NR ? lane : 0]; wlo = (unsigned)w; whi = (unsigned)(w >> 32); }
    if (lane < 32) *(unsigned long long*)(mrow + 2 * lane) = ((unsigned long long)whi << 32) | wlo;
}
__device__ __forceinline__ void ix_select(const LAS float* myv, LAS unsigned* hist, LAS float* cand, unsigned* mrow, int n, int lane) {
    const int nact = (n + 63) >> 6;
    if (nact <= 8) ix_select_impl<8>(myv, hist, cand, mrow, n, lane);
    else if (nact <= 16) ix_select_impl<16>(myv, hist, cand, mrow, n, lane);
    else if (nact <= 24) ix_select_impl<24>(myv, hist, cand, mrow, n, lane);
    else ix_select_impl<32>(myv, hist, cand, mrow, n, lane);
}

__device__ __forceinline__ int ix_unit_t0(int i, int j) { return 8 * (32 + 32 * i + ((i & 1) ? 31 - j : j)); }
__device__ __forceinline__ void indexer_wg(const Params& p, int b, int j, LAS unsigned char* lds) {
    int tid_ = threadIdx.x; asm volatile("" : "+v"(tid_)); const int tid = tid_, lane = tid & 63, r32 = lane & 31, hi = lane >> 5, wid = __builtin_amdgcn_readfirstlane(tid >> 6);
    const bf16_t* proj = (const bf16_t*)(p.ws + WS_PROJ);
    const int rowbase = b * SEQ;
    LAS unsigned* hist = (LAS unsigned*)(lds + IX_HIST) + wid * 64;
    LAS float* cand = (LAS float*)(lds + IX_CAND) + wid * 64;
    IxOps X;
    ix_prefetch(X, proj, p.ws + WS_IKF, rowbase, ix_unit_t0(6, j), wid, r32, hi);
    const int xstride = (int)gridDim.x * 8; int xr = (int)blockIdx.x * 8 + wid; int xleft = 7;
    for (int i = 6; i >= 0; --i) {
        const int t0 = ix_unit_t0(i, j);
        LAS float* sc = (LAS float*)(lds + IX_SC) + (i & 1) * (8 * 2048);
        LAS float* sco = (LAS float*)(lds + IX_SC) + ((i + 1) & 1) * (8 * 2048);
        const bool xi = (xleft > 0) && (xr < NXITEMS);
        const TItem xt = txitem(p, xi ? xr : 0);
        if (xi) titem_dma_issue(xt, lane, sco + wid * 2048);
        ix_score(X, p, rowbase, t0, sc, wid, r32, hi);
        if (xi) { asm volatile("s_waitcnt vmcnt(0)" ::: "memory"); titem_dma_finish(xt, lane, sco + wid * 2048); xr += xstride; --xleft; }
        LDS_BARRIER();
        if (i > 0) ix_prefetch(X, proj, p.ws + WS_IKF, rowbase, ix_unit_t0(i - 1, j), wid, r32, hi);
        const int t = t0 + wid;
        ix_select(sc + wid * 2048, hist, cand, (unsigned*)(p.ws + WS_MASK) + (size_t)(rowbase + t) * 64, t + 1, lane);
    }
    __syncthreads();
}

__device__ __forceinline__ void trivial_mask_rows(const Params& p) {
    unsigned* mask = (unsigned*)(p.ws + WS_MASK);
    const int G = gridDim.x;
    for (int i = blockIdx.x * 512 + threadIdx.x; i < BATCH * 256 * 64; i += G * 512) {
        const int w = i & 63, t = (i >> 6) & 255, b = i >> 14;
        unsigned v;
        if (32 * w + 31 <= t) v = 0xffffffffu; else if (32 * w > t) v = 0u; else v = (1u << (t - 32 * w + 1)) - 1u;
        mask[(size_t)(b * SEQ + t) * 64 + w] = v;
    }
}
constexpr int RT_LG = 0;
constexpr int RT_CNT = 98304;
struct RtStage { f32x4 aa, ab, ca, cb; bf16x8 fh[3], fl[3]; };
__device__ __forceinline__ void rt_load(RtStage& S, const float* ma, const float* mc, const bf16_t* bh, const bf16_t* bl, int k) {
    S.aa = *(const f32x4*)(ma + k); S.ab = *(const f32x4*)(ma + k + 4); S.ca = *(const f32x4*)(mc + k); S.cb = *(const f32x4*)(mc + k + 4);
#pragma unroll
    for (int nb = 0; nb < 3; ++nb) { S.fh[nb] = *(const bf16x8*)(bh + (size_t)nb * 16 * 1024 + k); S.fl[nb] = *(const bf16x8*)(bl + (size_t)nb * 16 * 1024 + k); }
}
__device__ __forceinline__ void router_phase(const Params& p, LAS unsigned char* lds) {
    int tid_ = threadIdx.x; asm volatile("" : "+v"(tid_)); const int tid = tid_, lane = tid & 63, wid = __builtin_amdgcn_readfirstlane(tid >> 6), G = gridDim.x;
    const float* x1 = p.out; const float* x1ssq = (const float*)(p.ws + WS_X1SSQ); const float* mod2 = (const float*)(p.ws + WS_MOD2);
    bf16_t* H2 = (bf16_t*)(p.ws + WS_H);
    const bf16_t* wrh = (const bf16_t*)(p.ws + WS_WR); const bf16_t* wrl = wrh + 48 * 1024;
    unsigned* cnt = (unsigned*)(p.ws + WS_CNT); int* list = (int*)(p.ws + WS_LIST); float* rw = (float*)(p.ws + WS_RW);
    const int iters = (NTOK / 64 + G - 1) / G;
    for (int it = 0; it < iters; ++it) {
        int ln_ = lane; asm volatile("" : "+v"(ln_)); const int row = ln_ & 15, kq = ln_ >> 4;
        const int wu = it * G + blockIdx.x;
        const bool active = wu < NTOK / 64;
        if (active) {
            const int tok0 = 64 * wu, b = tok0 >> 11, kw = 128 * wid + 8 * kq;
            const bf16_t* xr = (const bf16_t*)x1 + (size_t)(tok0 + row) * (2 * DM) + kw;
            u32x4 xs[2][4];
#pragma unroll
            for (int tb = 0; tb < 4; ++tb) xs[0][tb] = __builtin_nontemporal_load((const u32x4*)(xr + (size_t)tb * 16 * 2 * DM));
            float rstd[4];
#pragma unroll
            for (int tb = 0; tb < 4; ++tb) {
                const f32x4 a = *((const f32x4*)(x1ssq + (size_t)(tok0 + 16 * tb + row) * 16) + kq);
                float q = (a[0] + a[1]) + (a[2] + a[3]);
                q += __shfl_xor(q, 16); q += __shfl_xor(q, 32);
                rstd[tb] = 1.f / sqrtf(q * (1.f / DM) + EPS);
            }
            f32x4 acc[4][3];
#pragma unroll
            for (int tb = 0; tb < 4; ++tb) { acc[tb][0] = f32x4{}; acc[tb][1] = f32x4{}; acc[tb][2] = f32x4{}; }
            const float* ma = mod2 + (size_t)(b * 2) * 1024 + kw; const float* mc = ma + 1024;
            const bf16_t* bh = wrh + (size_t)row * 1024 + kw; const bf16_t* bl = wrl + (size_t)row * 1024 + kw;
            RtStage S0, S1;
            rt_load(S0, ma, mc, bh, bl, 0);
#pragma unroll
            for (int s = 0; s < 4; ++s) {
                const int k = 32 * s;
                if (s + 1 < 4) rt_load(S1, ma, mc, bh, bl, k + 32);
                if (s + 1 < 4) {
#pragma unroll
                    for (int tb = 0; tb < 4; ++tb) xs[(s + 1) & 1][tb] = __builtin_nontemporal_load((const u32x4*)(xr + (size_t)tb * 16 * 2 * DM + 32 * (s + 1)));
                }
#pragma unroll
                for (int tb = 0; tb < 4; ++tb) {
                    const u32x4 xw = xs[s & 1][tb];
                    const f32x4 xa = (f32x4){__builtin_bit_cast(float, xw.x << 16), __builtin_bit_cast(float, xw.x & 0xffff0000u), __builtin_bit_cast(float, xw.y << 16), __builtin_bit_cast(float, xw.y & 0xffff0000u)};
                    const f32x4 xb = (f32x4){__builtin_bit_cast(float, xw.z << 16), __builtin_bit_cast(float, xw.z & 0xffff0000u), __builtin_bit_cast(float, xw.w << 16), __builtin_bit_cast(float, xw.w & 0xffff0000u)};
                    const f32x4 ha = xa * rstd[tb] * S0.aa + S0.ca, hb = xb * rstd[tb] * S0.ab + S0.cb;
                    u32x4 w; w.x = pg8::cvt_pk_bf16(ha[0], ha[1]); w.y = pg8::cvt_pk_bf16(ha[2], ha[3]); w.z = pg8::cvt_pk_bf16(hb[0], hb[1]); w.w = pg8::cvt_pk_bf16(hb[2], hb[3]);
                    *(u32x4*)(H2 + (size_t)(tok0 + 16 * tb + row) * DM + kw + k) = w;
                    const bf16x8 af = __builtin_bit_cast(bf16x8, w);
                    u32x4 wl;
                    wl.x = pg8::cvt_pk_bf16(ha[0] - __builtin_bit_cast(float, w.x << 16), ha[1] - __builtin_bit_cast(float, w.x & 0xffff0000u));
                    wl.y = pg8::cvt_pk_bf16(ha[2] - __builtin_bit_cast(float, w.y << 16), ha[3] - __builtin_bit_cast(float, w.y & 0xffff0000u));
                    wl.z = pg8::cvt_pk_bf16(hb[0] - __builtin_bit_cast(float, w.z << 16), hb[1] - __builtin_bit_cast(float, w.z & 0xffff0000u));
                    wl.w = pg8::cvt_pk_bf16(hb[2] - __builtin_bit_cast(float, w.w << 16), hb[3] - __builtin_bit_cast(float, w.w & 0xffff0000u));
                    const bf16x8 al = __builtin_bit_cast(bf16x8, wl);
#pragma unroll
                    for (int nb = 0; nb < 3; ++nb) {
                        acc[tb][nb] = __builtin_amdgcn_mfma_f32_16x16x32_bf16(af, S0.fh[nb], acc[tb][nb], 0, 0, 0);
                        acc[tb][nb] = __builtin_amdgcn_mfma_f32_16x16x32_bf16(af, S0.fl[nb], acc[tb][nb], 0, 0, 0);
                        acc[tb][nb] = __builtin_amdgcn_mfma_f32_16x16x32_bf16(al, S0.fh[nb], acc[tb][nb], 0, 0, 0);
                    }
                }
                S0 = S1;
            }
#pragma unroll
            for (int tb = 0; tb < 4; ++tb) {
                LAS float* lg = (LAS float*)(lds + RT_LG) + (wid * 4 + tb) * 768;
#pragma unroll
                for (int nb = 0; nb < 3; ++nb)
#pragma unroll
                    for (int i = 0; i < 4; ++i) lg[(4 * kq + i) * 48 + 16 * nb + row] = acc[tb][nb][i];
            }
        }
        LDS_BARRIER();
        LAS unsigned* lcnt = (LAS unsigned*)(lds + RT_CNT);
        if (tid < 64) lcnt[tid] = 0u;
        LDS_BARRIER();
        int ea = 0, eb = 0, tk = 0; unsigned la = 0, lb = 0; float w1 = 0.f, w2 = 0.f; bool act = false;
        if (wid == 0) {
            const int pr = lane >> 4, tl = lane & 15;
            act = active;
            if (act) {
                const LAS float* l0 = (const LAS float*)(lds + RT_LG) + pr * 768 + tl * 48;
                tk = 64 * wu + 16 * pr + tl;
                float gl[4]; int gs = 0; float gmax;
#pragma unroll
                for (int j = 0; j < 4; ++j) { float s = p.b_group[j];
#pragma unroll
                    for (int w8 = 0; w8 < 8; ++w8) s += l0[w8 * 3072 + j];
                    gl[j] = s; }
                gmax = gl[0];
#pragma unroll
                for (int j = 1; j < 4; ++j) if (gl[j] > gmax) { gmax = gl[j]; gs = j; }
                float den = 0.f;
#pragma unroll
                for (int j = 0; j < 4; ++j) den += __expf(gl[j] - gmax);
                const float pg = 1.f / den;
                float v1 = -INFINITY, v2 = -INFINITY; int i1 = 0, i2 = 0;
#pragma unroll
                for (int j = 0; j < 8; ++j) {
                    float ev = p.b_router[gs * 8 + j];
#pragma unroll
                    for (int w8 = 0; w8 < 8; ++w8) ev += l0[w8 * 3072 + 16 + 8 * gs + j];
                    if (ev > v1) { v2 = v1; i2 = i1; v1 = ev; i1 = j; } else if (ev > v2) { v2 = ev; i2 = j; }
                }
                const float e2 = __expf(v2 - v1);
                w1 = pg / (1.f + e2); w2 = pg * e2 / (1.f + e2);
                ea = gs * 8 + i1; eb = gs * 8 + i2;
                la = __hip_atomic_fetch_add(lcnt + ea, 1u, __ATOMIC_RELAXED, __HIP_MEMORY_SCOPE_WORKGROUP);
                lb = __hip_atomic_fetch_add(lcnt + eb, 1u, __ATOMIC_RELAXED, __HIP_MEMORY_SCOPE_WORKGROUP);
            }
            int ln2 = lane; asm volatile("" : "+v"(ln2));
            if (ln2 < 32) { const unsigned c = lcnt[ln2]; unsigned base = 0u; if (c) base = atomicAdd(cnt + ln2 * 64, c); lcnt[32 + ln2] = base; }
            if (act) {
                const unsigned sa = lcnt[32 + ea] + la, sb = lcnt[32 + eb] + lb;
                list[ea * 16384 + sa] = tk * 2; list[eb * 16384 + sb] = tk * 2 + 1;
                rw[tk * 2] = w1; rw[tk * 2 + 1] = w2;
            }
        }
        LDS_BARRIER();
    }
}
constexpr int MISC_OFF = LDS_BYTES - 64;
__device__ __forceinline__ int vb_of(LAS unsigned char* lds) { return __builtin_amdgcn_readfirstlane(((volatile LAS int*)(lds + MISC_OFF))[4]); }
__device__ __forceinline__ int vcu_of(LAS unsigned char* lds) { return __builtin_amdgcn_readfirstlane(((volatile LAS int*)(lds + MISC_OFF))[5]); }
__device__ __forceinline__ void phase1_inproj(const Params& p, LAS unsigned char* lds) {
    pg8::Gemm g{(const bf16_t*)(p.ws + WS_H), (const bf16_t*)(p.ws + WS_WIN), 1024};
    pg8::StaticOrder S; S.init(NTOK, NPROJ, 1024, gridDim.x, vb_of(lds));
    EpiProj E{(bf16_t*)(p.ws + WS_PROJ), (float*)(p.ws + WS_IW), (float*)(p.ws + WS_LOGF), p.b_forget, p.ws + WS_IKF};
    pg8::gemm_phase<EpiProj, pg8::StaticOrder, false>(lds, g, S, E);
}
template <int MODE> __device__ __forceinline__ void attn_phase(const Params& p, LAS unsigned char* lds) {
    const int G = gridDim.x;
    for (int v = vcu_of(lds); v < 256; v += G) {
        const int bh = v >> 2, s = v & 3;
        attn_unit<MODE>(p, bh >> 3, bh & 7, 7 - s, lds, true);
        attn_unit<MODE>(p, bh >> 3, bh & 7, s, lds, false);
    }
}
__device__ __forceinline__ void indexer_phase(const Params& p, LAS unsigned char* lds) {
    const int G = gridDim.x;
    for (int v = vcu_of(lds); v < 256; v += G) indexer_wg(p, v >> 5, v & 31, lds);
    {
        __syncthreads();
        int tid_ = threadIdx.x; asm volatile("" : "+v"(tid_)); const int lane = tid_ & 63, wave = tid_ >> 6;
        LAS float* scr = (LAS float*)(lds + wave * 8704);
        const int done = (vcu_of(lds) < 256) ? 7 : 0;
        float tv[32];
        for (int xr = ((done * G + (int)blockIdx.x) * 8 + wave); xr < NXITEMS; xr += G * 8) { const TItem t = txitem(p, xr); titem_load(t, lane, tv); titem_store(t, lane, tv, scr); }
    }
    trivial_mask_rows(p);
}
__device__ __forceinline__ void phase4_outproj(const Params& p, LAS unsigned char* lds) {
    pg8::Gemm g{(const bf16_t*)(p.ws + WS_O), (const bf16_t*)(p.ws + WS_WOUT), 1024};
    pg8::StaticOrder S; S.init(NTOK, DM, 1024, gridDim.x, vb_of(lds));
    EpiOut E{p.x, p.out, (const float*)(p.ws + WS_MOD), (const float*)(p.ws + WS_SSQ), (float*)(p.ws + WS_X1SSQ)};
    pg8::gemm_phase<EpiOut, pg8::StaticOrder, false>(lds, g, S, E);
}
__device__ __forceinline__ void phase_moe(const Params& p, LAS unsigned char* lds) {
    LAS int* tab = (LAS int*)(lds + MOE_TAB_OFF); moe_order_setup((const unsigned*)(p.ws + WS_CNT), tab);
    unsigned* flags = (unsigned*)(p.ws + WS_TFLAG);
    const int G = gridDim.x, c = vb_of(lds), cx = vcu_of(lds);
    {
        pg8::Gemm g{(const bf16_t*)(p.ws + WS_H), (const bf16_t*)(p.ws + WS_WGU), 1024};
        MoeOrder S{tab, (const int*)(p.ws + WS_LIST), flags, 2, G, c, 0, (size_t)512 * 1024 * 2, (size_t)256 * 1024 * 2, true, 0, cx};
        EpiAct E{(bf16_t*)(p.ws + WS_ACT), (const int*)(p.ws + WS_LIST), (const float*)(p.ws + WS_RW)};
        pg8::gemm_phase<EpiAct, MoeOrder, true>(lds, g, S, E);
    }
    {
        const int T = __builtin_amdgcn_readfirstlane(tab[64]);
        const int n2 = (2 * T > G && 2 * T < 2 * G) ? 2 * T - G : 0;
        const int x_ = c & 7, r_ = c >> 3, G8 = G >> 3;
        int lidx = 0;
        for (int xx = 0; xx < 8; ++xx) { const int hx = (n2 > xx) ? (n2 - xx + 7) >> 3 : 0; if (xx < x_) lidx += G8 - hx; else if (xx == x_) lidx += r_ - hx; }
        const int cl = ((G & 7) == 0) ? lidx : c - n2;
        pg8::Gemm g{(const bf16_t*)(p.ws + WS_ACT), (const bf16_t*)(p.ws + WS_WD), 256};
        MoeOrder S{tab, (const int*)(p.ws + WS_LIST), flags, 4, G - n2, cl, (size_t)256 * 256 * 2, (size_t)1024 * 256 * 2, (size_t)256 * 256 * 2, false, 1, cl};
        EpiDown E{(bf16_t*)(p.ws + WS_Y), (const int*)(p.ws + WS_LIST)};
        if (c >= n2) pg8::gemm_phase<EpiDown, MoeOrder, false>(lds, g, S, E);
    }
}

__global__ void __launch_bounds__(512, 2) mega(Params p) {
    extern __shared__ __attribute__((aligned(16))) unsigned char lds_raw[];
    LAS unsigned char* lds = (LAS unsigned char*)lds_raw;
    cg::grid_group grid = cg::this_grid();
    if (p.ws == nullptr) grid.sync();
    volatile LAS unsigned* st = (volatile LAS unsigned*)(lds + LDS_BYTES - 64);
    if (threadIdx.x < 4) st[threadIdx.x] = 0u;
    __syncthreads();
    const XcdBarrier bar = xcd_barrier_post((unsigned*)(p.ws + WS_BAR), st);
#define GSYNC() xcd_barrier(bar)
#ifndef REP_MASK
#define REP_MASK 0
#endif
#ifndef TPROBE
#define TPROBE -1
#endif
    unsigned long long tp0_ = 0; (void)tp0_;
#define PH_BEGIN(i) do { if (TPROBE == (i) || (TPROBE == 10 && (i) == 0)) tp0_ = __builtin_amdgcn_s_memrealtime(); } while (0)
#define PH_END(i) do { if (TPROBE == (i)) { if (threadIdx.x == 0) { const unsigned long long t1_ = __builtin_amdgcn_s_memrealtime(); const unsigned long long d_ = t1_ - tp0_; \
        while (__builtin_amdgcn_s_memrealtime() - t1_ < d_) __builtin_amdgcn_s_sleep(8); } __syncthreads(); } } while (0)
    PH_BEGIN(0);
    f32x4 vx0[8][4];
    phase0(p, lds, vx0);
    if (TPROBE == 10) { if (threadIdx.x == 0) { const unsigned long long t1_ = __builtin_amdgcn_s_memrealtime(); const unsigned long long d_ = t1_ - tp0_; while (__builtin_amdgcn_s_memrealtime() - t1_ < d_) __builtin_amdgcn_s_sleep(8); } __syncthreads(); }
    phase0b(p, vx0);
    GSYNC(); PH_END(0); PH_BEGIN(2);
    {
        volatile LAS int* mi = (volatile LAS int*)(lds + MISC_OFF);
        if (threadIdx.x == 0) {
            const int G = gridDim.x; unsigned* bw = (unsigned*)(p.ws + WS_BAR);
            bool uni = (G % 8 == 0);
            for (int jx = 0; jx < 16; ++jx) { const unsigned cx = xb_ld(&bw[XB_XCNT(jx)]); uni = uni && (jx < 8 ? cx == (unsigned)(G / 8) : cx == 0u); }
            const int rank = mi[2], x = (int)bar.x, bx = blockIdx.x;
            mi[4] = uni ? rank * 8 + x : bx;
            mi[5] = uni ? x * (G / 8) + rank : ((G % 8 == 0) ? (bx % 8) * (G / 8) + bx / 8 : bx);
        }
        __syncthreads();
    }
    phase1_inproj(p, lds);
#if (REP_MASK) & 4
    phase1_inproj(p, lds);
#endif
    GSYNC(); PH_END(2); PH_BEGIN(3);
    attn_phase<0>(p, lds);
#if (REP_MASK) & 8
    attn_phase<0>(p, lds);
#endif
    indexer_phase(p, lds);
#if (REP_MASK) & 16
    indexer_phase(p, lds);
#endif
    GSYNC(); PH_END(3); PH_BEGIN(4);
    attn_phase<1>(p, lds);
#if (REP_MASK) & 32
    attn_phase<1>(p, lds);
#endif
    GSYNC(); PH_END(4); PH_BEGIN(5);
    phase4_outproj(p, lds);
#if (REP_MASK) & 64
    phase4_outproj(p, lds);
#endif
    GSYNC(); PH_END(5); PH_BEGIN(6);
    router_phase(p, lds);
    GSYNC(); PH_END(6); PH_BEGIN(7);
    phase_moe(p, lds);
    GSYNC(); PH_END(7); PH_BEGIN(9);
    phase_final(p, false);
    if (TPROBE == 9) { asm volatile("s_waitcnt vmcnt(0)" ::: "memory"); __syncthreads(); } PH_END(9);
}

extern "C" void kernel_launch(void* const* d_in, const int* in_sizes, int n_in, void* d_out, int out_size, void* d_ws, size_t ws_size, hipStream_t stream) {
    static int grid = 0;
    if (grid == 0) {
        if (n_in != 19 || out_size != NTOK * DM || ws_size < WS_END) { fprintf(stderr, "kernel_launch: unexpected problem (n_in %d out %d ws %zu)\n", n_in, out_size, ws_size); grid = -1; return; }
        int dev = 0, cus = 0, per_cu = 0;
        (void)hipGetDevice(&dev);
        (void)hipDeviceGetAttribute(&cus, hipDeviceAttributeMultiprocessorCount, dev);
        (void)hipFuncSetAttribute((const void*)mega, hipFuncAttributeMaxDynamicSharedMemorySize, LDS_BYTES);
        (void)hipOccupancyMaxActiveBlocksPerMultiprocessor(&per_cu, (const void*)mega, 512, LDS_BYTES);
        if (per_cu < 1) { fprintf(stderr, "kernel_launch: occupancy query says %d blocks per CU\n", per_cu); per_cu = 1; }
        grid = cus;
        if (grid % 8) grid -= grid % 8;
    }
    if (grid < 0) return;
    Params p{};
    const float** f = (const float**)&p;
    for (int i = 0; i < 19; ++i) f[i] = (const float*)d_in[i];
    p.out = (float*)d_out; p.ws = (unsigned char*)d_ws;
    (void)hipMemsetAsync(d_ws, 0, WS_ZERO_BYTES, stream);
    void* args[] = {&p};
    hipError_t e = hipLaunchCooperativeKernel((const void*)mega, dim3(grid), dim3(512), args, LDS_BYTES, stream);
    if (e != hipSuccess) fprintf(stderr, "cooperative launch failed: %s (grid %d)\n", hipGetErrorString(e), grid);
}
```

```cpp
#include <hip/hip_runtime.h>
#include <hip/hip_cooperative_groups.h>
#include <cstdio>
#include <cstdint>
namespace cg = cooperative_groups;

#define LAS __attribute__((address_space(3)))
typedef unsigned short bf16_t;
typedef short bf16x8 __attribute__((ext_vector_type(8)));
typedef float f32x4 __attribute__((ext_vector_type(4)));
typedef float f32x2 __attribute__((ext_vector_type(2)));
typedef float f32x16 __attribute__((ext_vector_type(16)));
typedef unsigned u32x4 __attribute__((ext_vector_type(4)));
typedef unsigned u32x2 __attribute__((ext_vector_type(2)));

constexpr int BATCH = 8, SEQ = 2048, DM = 1024, NTOK = BATCH * SEQ;
constexpr int NMOD = 6 * DM;
constexpr int IN_COLS = 2896, NPROJ = 3072;
constexpr int C_AQ = 0, C_BQ = 512, C_IQ = 1024, C_BK = 1536, C_BV = 2048, C_AK = 2560, C_AV = 2688, C_IK = 2816, C_IW = 2880, C_BF = 2888;
constexpr int NEXP = 32, DFF = 256;
constexpr float EPS = 1e-6f;
constexpr float LOG2E = 1.4426950408889634f;
constexpr float C2 = 0.125f * LOG2E;

constexpr size_t KiB = 1024, MiB = 1024 * 1024;
constexpr size_t WS_CNT = 0;
constexpr size_t WS_FLAG = 12 * KiB;
constexpr size_t WS_BAR = 16 * KiB;
constexpr size_t WS_TFLAG = 32 * KiB;
constexpr size_t WS_ZERO_BYTES = 64 * KiB;
constexpr size_t WS_MOD = 64 * KiB;
constexpr size_t WS_MOD2 = 256 * KiB;
constexpr size_t WS_IW = 512 * KiB;
constexpr size_t WS_LOGF = 1 * MiB;
constexpr size_t WS_SSQ = 1 * MiB + 512 * KiB;
constexpr size_t WS_X1SSQ = 2 * MiB + 512 * KiB;
constexpr size_t WS_RW = 3 * MiB + 512 * KiB;
constexpr size_t WS_LIST = 4 * MiB;
constexpr size_t WS_WR = 6 * MiB;
constexpr size_t WS_WIN = 8 * MiB;
constexpr size_t WS_WOUT = 14 * MiB;
constexpr size_t WS_WGU = 16 * MiB;
constexpr size_t WS_WD = 48 * MiB;
constexpr size_t WS_PROJ = 64 * MiB;
constexpr size_t WS_Y = 64 * MiB;
constexpr size_t WS_ACT = 128 * MiB;
constexpr size_t WS_H = 160 * MiB;
constexpr size_t WS_O = 192 * MiB;
constexpr size_t WS_MASK = 224 * MiB;
constexpr size_t WS_IKF = 228 * MiB;
constexpr size_t WS_RWS = 230 * MiB;
constexpr size_t WS_END = 232 * MiB;

constexpr int LDS_BYTES = 147456;

struct Params {
    const float *x, *c, *w_ada, *b_ada, *g_mix, *w_in, *b_forget, *g_out_a, *g_out_b, *w_out, *g_ffn, *w_group, *b_group, *w_router, *b_router, *w_gate, *w_up, *w_down, *g_final;
    float* out;
    unsigned char* ws;
};

__device__ __forceinline__ unsigned f2bf(float f) { unsigned u = __builtin_bit_cast(unsigned, f); return (u + 0x7fffu + ((u >> 16) & 1u)) >> 16; }
__device__ __forceinline__ unsigned pk2(float lo, float hi) { return f2bf(lo) | (f2bf(hi) << 16); }
__device__ __forceinline__ float bf2f(unsigned short b) { return __builtin_bit_cast(float, (unsigned)b << 16); }
__device__ __forceinline__ float wave_sum(float v) {
    asm volatile("s_nop 1\n\tv_add_f32_dpp %0, %0, %0 row_shr:1 row_mask:0xf bank_mask:0xf\n\t"
                 "s_nop 1\n\tv_add_f32_dpp %0, %0, %0 row_shr:2 row_mask:0xf bank_mask:0xf\n\t"
                 "s_nop 1\n\tv_add_f32_dpp %0, %0, %0 row_shr:4 row_mask:0xf bank_mask:0xf\n\t"
                 "s_nop 1\n\tv_add_f32_dpp %0, %0, %0 row_shr:8 row_mask:0xf bank_mask:0xf\n\t"
                 "s_nop 1\n\tv_add_f32_dpp %0, %0, %0 row_bcast:15 row_mask:0xa bank_mask:0xf\n\t"
                 "s_nop 1\n\tv_add_f32_dpp %0, %0, %0 row_bcast:31 row_mask:0xc bank_mask:0xf\n\t"
                 "s_nop 1" : "+v"(v));
    return __builtin_bit_cast(float, __builtin_amdgcn_readlane(__builtin_bit_cast(int, v), 63));
}
#define LDS_BARRIER() do { asm volatile("s_waitcnt lgkmcnt(0)" ::: "memory"); __builtin_amdgcn_s_barrier(); asm volatile("" ::: "memory"); } while (0)
__device__ __forceinline__ float siluf(float v) { return v * __builtin_amdgcn_rcpf(1.f + __expf(-v)); }

__device__ __forceinline__ int win_row(int n) {
    if (n < 512) return C_AQ + n;
    if (n < 640) return C_AK + (n - 512);
    if (n < 768) return C_AV + (n - 640);
    if (n < 1280) return C_IQ + (n - 768);
    if (n < 1344) return C_IK + (n - 1280);
    if (n < 1352) return C_IW + (n - 1344);
    if (n < 1864) return C_BQ + (n - 1352);
    if (n < 2376) return C_BK + (n - 1864);
    if (n < 2888) return C_BV + (n - 2376);
    return C_BF + (n - 2888);
}
struct TItem { const float* W; bf16_t* WT; const float* kscale; int K, N, k0, n0, map; };
constexpr int NB_IN = (IN_COLS + 31) / 32;
constexpr int I_IN = 16 * NB_IN, I_OUT = 16 * 32, I_G = 32 * 16 * 8, I_U = I_G, I_D = 32 * 4 * 32;
constexpr int NITEMS = I_IN + I_OUT;
constexpr int NXITEMS = I_G + I_U + I_D;
__device__ __forceinline__ TItem titem(const Params& p, int r) {
    TItem t; unsigned char* ws = p.ws; t.kscale = nullptr;
    if (r < I_IN) { const int kb = r / NB_IN, nb = r % NB_IN; t.W = p.w_in; t.WT = (bf16_t*)(ws + WS_WIN); t.K = 1024; t.N = IN_COLS; t.k0 = 64 * kb; t.n0 = 32 * nb; t.map = 1; return t; } r -= I_IN;
    { const int kb = r / 32, nb = r % 32; t.W = p.w_out; t.WT = (bf16_t*)(ws + WS_WOUT); t.K = 1024; t.N = 1024; t.k0 = 64 * kb; t.n0 = 32 * nb; t.map = 0; t.kscale = t.k0 < 512 ? p.g_out_a : p.g_out_b - 512; return t; }
}
__device__ __forceinline__ TItem txitem(const Params& p, int r) {
    TItem t; unsigned char* ws = p.ws; t.kscale = nullptr;
    if (r < I_G) { const int e = r >> 7, q = r & 127, kb = q >> 3, nb = q & 7; t.W = p.w_gate + (size_t)e * 1024 * 256; t.WT = (bf16_t*)(ws + WS_WGU) + (size_t)e * 512 * 1024; t.K = 1024; t.N = 256; t.k0 = 64 * kb; t.n0 = 32 * nb; t.map = 2; return t; } r -= I_G;
    if (r < I_U) { const int e = r >> 7, q = r & 127, kb = q >> 3, nb = q & 7; t.W = p.w_up + (size_t)e * 1024 * 256; t.WT = (bf16_t*)(ws + WS_WGU) + (size_t)e * 512 * 1024; t.K = 1024; t.N = 256; t.k0 = 64 * kb; t.n0 = 32 * nb; t.map = 3; return t; } r -= I_U;
    { const int e = r >> 7, q = r & 127, kb = q >> 5, nb = q & 31; t.W = p.w_down + (size_t)e * 256 * 1024; t.WT = (bf16_t*)(ws + WS_WD) + (size_t)e * 1024 * 256; t.K = 256; t.N = 1024; t.k0 = 64 * kb; t.n0 = 32 * nb; t.map = 0; return t; }
}
__device__ __forceinline__ void titem_load(const TItem& t, int lane, float (&v)[32]) {
    const int nn = t.n0 + (lane & 31);
    const float* src = t.W + (size_t)(t.k0 + (lane >> 5)) * t.N + nn;
    const bool ok = nn < t.N;
    const size_t step = (size_t)2 * t.N;
#pragma unroll
    for (int i = 0; i < 32; ++i) { v[i] = ok ? __builtin_nontemporal_load(src) : 0.f; src += step; }
    if (t.kscale) {
        const float* ks = t.kscale + t.k0 + (lane >> 5);
#pragma unroll
        for (int i = 0; i < 32; ++i) v[i] *= ks[2 * i];
    }
}
__device__ __forceinline__ void titem_store(const TItem& t, int lane, const float (&v)[32], LAS float* scr) {
#pragma unroll
    for (int i = 0; i < 32; ++i) scr[(2 * i + (lane >> 5)) * 33 + (lane & 31)] = v[i];
    asm volatile("s_waitcnt lgkmcnt(0)" ::: "memory");
    const int c = lane & 7;
#pragma unroll
    for (int j = 0; j < 4; ++j) {
        const int nl = (lane >> 3) + 8 * j, n = t.n0 + nl;
        const LAS float* s = scr + (8 * c) * 33 + nl;
        u32x4 o; o.x = pk2(s[0 * 33], s[1 * 33]); o.y = pk2(s[2 * 33], s[3 * 33]); o.z = pk2(s[4 * 33], s[5 * 33]); o.w = pk2(s[6 * 33], s[7 * 33]);
        int row;
        if (t.map == 0) row = n; else if (t.map == 1) row = win_row(n); else if (t.map == 2) row = (n >> 7) * 256 + (n & 127); else row = (n >> 7) * 256 + 128 + (n & 127);
        if (n < t.N) *(u32x4*)(t.WT + (size_t)row * t.K + t.k0 + 8 * c) = o;
    }
    asm volatile("s_waitcnt lgkmcnt(0)" ::: "memory");
}

__device__ __forceinline__ void titem_dma_issue(const TItem& t, int lane, LAS float* scr) {
    const float* src = t.W + (size_t)(t.k0 + (lane >> 3)) * t.N + t.n0 + 4 * (lane & 7);
    const size_t step = (size_t)8 * t.N;
#pragma unroll
    for (int i = 0; i < 8; ++i) { __builtin_amdgcn_global_load_lds((const unsigned*)src, (LAS unsigned*)(scr + i * 256), 16, 0, 2); src += step; }
}
__device__ __forceinline__ void titem_dma_finish(const TItem& t, int lane, const LAS float* scr) {
    const int c = lane & 7;
#pragma unroll
    for (int j = 0; j < 4; ++j) {
        const int nl = (lane >> 3) + 8 * j, n = t.n0 + nl;
        const LAS float* s = scr + (8 * c) * 32 + nl;
        u32x4 o; o.x = pk2(s[0 * 32], s[1 * 32]); o.y = pk2(s[2 * 32], s[3 * 32]); o.z = pk2(s[4 * 32], s[5 * 32]); o.w = pk2(s[6 * 32], s[7 * 32]);
        int row;
        if (t.map == 0) row = n; else if (t.map == 2) row = (n >> 7) * 256 + (n & 127); else row = (n >> 7) * 256 + 128 + (n & 127);
        *(u32x4*)(t.WT + (size_t)row * t.K + t.k0 + 8 * c) = o;
    }
}

__device__ __forceinline__ void phase0b_issue(const Params& p, f32x4 (&vx)[8][4]) {
    int tid_ = threadIdx.x; asm volatile("" : "+v"(tid_)); const int tid = tid_, lane = tid & 63, wave = tid >> 6, G = gridDim.x;
    const int gw = blockIdx.x * 8 + wave, NGW = G * 8;
    if (NTOK == 8 * NGW) {
#pragma unroll
        for (int r = 0; r < 8; ++r) {
            const f32x4* xr = (const f32x4*)(p.x + (size_t)(8 * gw + r) * DM) + lane;
#pragma unroll
            for (int j = 0; j < 4; ++j) vx[r][j] = __builtin_nontemporal_load(xr + 64 * j);
        }
    }
}
__device__ __forceinline__ void phase0(const Params& p, LAS unsigned char* lds, f32x4 (&vx)[8][4]) {
    int tid_ = threadIdx.x; asm volatile("" : "+v"(tid_)); const int tid = tid_, lane = tid & 63, wave = tid >> 6, G = gridDim.x;
    unsigned char* ws = p.ws;
    const int nA = NMOD / 32;
    const bool split = (G >= nA + 32), helper = split && ((int)blockIdx.x >= nA);
    if (helper) phase0b_issue(p, vx);
    else {
    for (int item = blockIdx.x; item < NMOD / 32; item += G) {
        LAS float* sc = (LAS float*)lds;
        LAS float* red = (LAS float*)(lds + 32768);
        const int j0 = 32 * item, col = lane & 31, kr = lane >> 5;
        const int kb = wave * 128 + 64 * kr;
        const unsigned loff = (unsigned)(kb * NMOD + j0 + col);
        const __amdgpu_buffer_rsrc_t wrs = __builtin_amdgcn_make_buffer_rsrc((void*)p.w_ada, 0, 0x7fffffff, 0x00020000);
        float w[32];
#pragma unroll
        for (int u = 0; u < 32; ++u) w[u] = __builtin_bit_cast(float, __builtin_amdgcn_raw_buffer_load_b32(wrs, loff * 4u, u * (NMOD * 4), 2));
        for (int i = tid; i < BATCH * DM; i += 512) sc[i] = siluf(p.c[i]);
        __syncthreads();
        float acc[8];
#pragma unroll
        for (int b = 0; b < 8; ++b) acc[b] = 0.f;
#pragma unroll 1
        for (int i0 = 0; i0 < 64; i0 += 32) {
            if (i0) {
#pragma unroll
                for (int u = 0; u < 32; ++u) w[u] = __builtin_bit_cast(float, __builtin_amdgcn_raw_buffer_load_b32(wrs, loff * 4u, (32 + u) * (NMOD * 4), 2));
            }
#pragma unroll
            for (int b = 0; b < 8; ++b) {
#pragma unroll
                for (int u4 = 0; u4 < 32; u4 += 4) {
                    const f32x4 s = *(const LAS f32x4*)(sc + b * 1024 + kb + i0 + u4);
                    acc[b] += (s[0] * w[u4] + s[1] * w[u4 + 1]) + (s[2] * w[u4 + 2] + s[3] * w[u4 + 3]);
                }
            }
        }
#pragma unroll
        for (int b = 0; b < 8; ++b) { acc[b] += __shfl_xor(acc[b], 32); if (kr == 0) red[(wave * 8 + b) * 32 + col] = acc[b]; }
        __syncthreads();
        if (wave == 0) {
#pragma unroll
            for (int q = 0; q < 4; ++q) {
                const int o = lane + 64 * q, b = o >> 5, cc = o & 31; float s = 0.f;
#pragma unroll
                for (int w8 = 0; w8 < 8; ++w8) s += red[(w8 * 8 + b) * 32 + cc];
                __hip_atomic_store((float*)(ws + WS_MOD) + b * NMOD + j0 + cc, s + p.b_ada[j0 + cc], __ATOMIC_RELAXED, __HIP_MEMORY_SCOPE_AGENT);
            }
            asm volatile("s_waitcnt vmcnt(0)" ::: "memory");
            if (tid == 0) __hip_atomic_fetch_add((unsigned*)(ws + WS_FLAG), 1u, __ATOMIC_RELAXED, __HIP_MEMORY_SCOPE_AGENT);
        }
        __syncthreads();
    }
    phase0b_issue(p, vx);
    }
    if (split && !helper) return;
    const int hb = helper ? (int)blockIdx.x - nA : (int)blockIdx.x, HG = helper ? G - nA : G;
    {
        bf16_t* wrh = (bf16_t*)(ws + WS_WR); bf16_t* wrl = wrh + 48 * 1024;
        for (int i = hb * 512 + tid; i < 48 * 1024; i += HG * 512) {
            const int o = i >> 10, k = i & 1023; float v = 0.f;
            if (o < 4) v = p.w_group[k * 4 + o];
            else if (o >= 16) { const int g = (o - 16) >> 3, e = (o - 16) & 7; v = p.w_router[((size_t)g * 1024 + k) * 8 + e]; }
            const unsigned hb = f2bf(v); const float hf = bf2f((unsigned short)hb);
            wrh[i] = (bf16_t)hb; wrl[i] = (bf16_t)f2bf(v - hf);
        }
    }
    {
        u32x4* z = (u32x4*)((bf16_t*)(ws + WS_WIN) + (size_t)IN_COLS * 1024);
        const int n16 = (NPROJ - IN_COLS) * 1024 * 2 / 16;
        for (int i = hb * 512 + tid; i < n16; i += HG * 512) z[i] = (u32x4){0u, 0u, 0u, 0u};
    }
    {
        LAS float* scr = (LAS float*)(lds + 49152 + wave * 8704);
        const int gw = hb * 8 + wave, NGW = HG * 8;
        float va[32], vb[32];
        int it = gw;
        if (it < NITEMS) { const TItem t0 = titem(p, it); titem_load(t0, lane, va); }
        while (it < NITEMS) {
            const TItem tc = titem(p, it);
            const int nx = it + NGW;
            if (nx < NITEMS) { const TItem tn = titem(p, nx); titem_load(tn, lane, vb); }
            titem_store(tc, lane, va, scr);
#pragma unroll
            for (int i = 0; i < 32; ++i) va[i] = vb[i];
            it = nx;
        }
    }
}

__device__ __forceinline__ void phase0b(const Params& p, f32x4 (&vx)[8][4]) {
    int tid_ = threadIdx.x; asm volatile("" : "+v"(tid_)); const int tid = tid_, lane = tid & 63, wave = tid >> 6, G = gridDim.x;
    const float* mod = (const float*)(p.ws + WS_MOD);
    float* mod2 = (float*)(p.ws + WS_MOD2);
    const int gw = blockIdx.x * 8 + wave, NGW = G * 8;
    const bool fast = (NTOK == 8 * NGW);
    if (tid == 0) {
        unsigned* flag = (unsigned*)(p.ws + WS_FLAG); unsigned sp = 0;
        while (__hip_atomic_load(flag, __ATOMIC_RELAXED, __HIP_MEMORY_SCOPE_AGENT) < (unsigned)(NMOD / 32)) { __builtin_amdgcn_s_sleep(2); if (++sp > (1u << 22)) break; }
        __builtin_amdgcn_fence(__ATOMIC_ACQUIRE, "agent");
        asm volatile("s_waitcnt vmcnt(0)" ::: "memory");
    }
    __syncthreads();
    for (int i = blockIdx.x * 512 + tid; i < BATCH * DM; i += G * 512) {
        const int b = i >> 10, k = i & 1023;
        mod2[(b * 2 + 0) * 1024 + k] = p.g_ffn[k] * (1.f + mod[b * NMOD + 4 * DM + k]);
        mod2[(b * 2 + 1) * 1024 + k] = mod[b * NMOD + 3 * DM + k];
    }
    bf16_t* H = (bf16_t*)(p.ws + WS_H);
    if (fast) {
        const int b = (8 * gw) >> 11;
        f32x4 A4[4], S4[4];
#pragma unroll
        for (int j = 0; j < 4; ++j) {
            const int k = 4 * lane + 256 * j;
            const f32x4 g = *(const f32x4*)(p.g_mix + k), sh = *(const f32x4*)(mod + b * NMOD + k), sc = *(const f32x4*)(mod + b * NMOD + DM + k);
            A4[j] = g * (1.f + sc); S4[j] = sh;
        }
#pragma unroll
        for (int r = 0; r < 8; ++r) {
            const int m = 8 * gw + r;
            float s = 0.f;
#pragma unroll
            for (int j = 0; j < 4; ++j) s += (vx[r][j].x * vx[r][j].x + vx[r][j].y * vx[r][j].y) + (vx[r][j].z * vx[r][j].z + vx[r][j].w * vx[r][j].w);
            const float rstd = __builtin_amdgcn_rsqf(wave_sum(s) * (1.f / DM) + EPS);
            unsigned long long* o8 = (unsigned long long*)(H + (size_t)m * DM) + lane;
#pragma unroll
            for (int j = 0; j < 4; ++j) {
                const f32x4 h = vx[r][j] * rstd * A4[j] + S4[j];
                o8[64 * j] = (unsigned long long)pk2(h.x, h.y) | ((unsigned long long)pk2(h.z, h.w) << 32);
            }
        }
        return;
    }
    for (int m = gw; m < NTOK; m += NGW) {
        const int b = m >> 11;
        const f32x4* xr = (const f32x4*)(p.x + (size_t)m * DM) + lane;
        f32x4 v[4]; float s = 0.f;
#pragma unroll
        for (int j = 0; j < 4; ++j) { v[j] = __builtin_nontemporal_load(xr + 64 * j); s += (v[j].x * v[j].x + v[j].y * v[j].y) + (v[j].z * v[j].z + v[j].w * v[j].w); }
        const float rstd = __builtin_amdgcn_rsqf(wave_sum(s) * (1.f / DM) + EPS);
        unsigned long long* o8 = (unsigned long long*)(H + (size_t)m * DM) + lane;
#pragma unroll
        for (int j = 0; j < 4; ++j) {
            const int k = 4 * lane + 256 * j;
            const f32x4 g = *(const f32x4*)(p.g_mix + k), sh = *(const f32x4*)(mod + b * NMOD + k), sc = *(const f32x4*)(mod + b * NMOD + DM + k);
            const f32x4 h = v[j] * rstd * g * (1.f + sc) + sh;
            o8[64 * j] = (unsigned long long)pk2(h.x, h.y) | ((unsigned long long)pk2(h.z, h.w) << 32);
        }
    }
}

__device__ __forceinline__ void phase_final(const Params& p, bool skeleton) {
    int tid_ = threadIdx.x; asm volatile("" : "+v"(tid_)); const int tid = tid_, lane = tid & 63, wave = tid >> 6, G = gridDim.x;
    const float* mod = (const float*)(p.ws + WS_MOD);
    const bf16_t* Y = (const bf16_t*)(p.ws + WS_Y);
    const int gw = blockIdx.x * 8 + wave, NGW = G * 8;
    if (!skeleton && NTOK == 8 * NGW) {
        const int b = (8 * gw) >> 11;
        f32x4 GF[4], GN[4];
#pragma unroll
        for (int j = 0; j < 4; ++j) { const int k = 4 * lane + 256 * j; GF[j] = *(const f32x4*)(mod + b * NMOD + 5 * DM + k); GN[j] = *(const f32x4*)(p.g_final + k); }
#pragma unroll 2
        for (int r = 0; r < 8; ++r) {
            const int m = 8 * gw + r;
            const u32x2* xb16 = (const u32x2*)((const bf16_t*)p.out + (size_t)m * (2 * DM)) + lane;
            f32x4 v[4]; float s = 0.f;
#pragma unroll
            for (int j = 0; j < 4; ++j) {
                const int k = 4 * lane + 256 * j;
                const u32x2 w = __builtin_nontemporal_load(xb16 + 64 * j);
                const u32x2 y0 = __builtin_nontemporal_load((const u32x2*)(Y + ((size_t)m * 2 + 0) * DM + k)), y1 = __builtin_nontemporal_load((const u32x2*)(Y + ((size_t)m * 2 + 1) * DM + k));
                v[j] = (f32x4){__builtin_bit_cast(float, w.x << 16), __builtin_bit_cast(float, w.x & 0xffff0000u), __builtin_bit_cast(float, w.y << 16), __builtin_bit_cast(float, w.y & 0xffff0000u)};
                f32x4 ys;
                ys.x = bf2f((unsigned short)(y0.x & 0xffff)) + bf2f((unsigned short)(y1.x & 0xffff)); ys.y = bf2f((unsigned short)(y0.x >> 16)) + bf2f((unsigned short)(y1.x >> 16));
                ys.z = bf2f((unsigned short)(y0.y & 0xffff)) + bf2f((unsigned short)(y1.y & 0xffff)); ys.w = bf2f((unsigned short)(y0.y >> 16)) + bf2f((unsigned short)(y1.y >> 16));
                v[j] = v[j] + GF[j] * ys;
                s += (v[j].x * v[j].x + v[j].y * v[j].y) + (v[j].z * v[j].z + v[j].w * v[j].w);
            }
            const float rstd = __builtin_amdgcn_rsqf(wave_sum(s) * (1.f / DM) + EPS);
            f32x4* o = (f32x4*)(p.out + (size_t)m * DM) + lane;
#pragma unroll
            for (int j = 0; j < 4; ++j) o[64 * j] = v[j] * rstd * GN[j];
        }
        return;
    }
    for (int m = gw; m < NTOK; m += NGW) {
        const int b = m >> 11;
        const f32x4* xr = (const f32x4*)(p.x + (size_t)m * DM) + lane;
        const u32x2* xb16 = (const u32x2*)((const bf16_t*)p.out + (size_t)m * (2 * DM)) + lane;
        f32x4 v[4]; float s = 0.f;
#pragma unroll
        for (int j = 0; j < 4; ++j) {
            if (skeleton) v[j] = xr[64 * j];
            else { const u32x2 w = __builtin_nontemporal_load(xb16 + 64 * j); v[j] = (f32x4){__builtin_bit_cast(float, w.x << 16), __builtin_bit_cast(float, w.x & 0xffff0000u), __builtin_bit_cast(float, w.y << 16), __builtin_bit_cast(float, w.y & 0xffff0000u)}; }
            if (!skeleton) {
                const int k = 4 * lane + 256 * j;
                const f32x4 gf = *(const f32x4*)(mod + b * NMOD + 5 * DM + k);
                const u32x2 y0 = __builtin_nontemporal_load((const u32x2*)(Y + ((size_t)m * 2 + 0) * DM + k)), y1 = __builtin_nontemporal_load((const u32x2*)(Y + ((size_t)m * 2 + 1) * DM + k));
                f32x4 ys;
                ys.x = bf2f((unsigned short)(y0.x & 0xffff)) + bf2f((unsigned short)(y1.x & 0xffff)); ys.y = bf2f((unsigned short)(y0.x >> 16)) + bf2f((unsigned short)(y1.x >> 16));
                ys.z = bf2f((unsigned short)(y0.y & 0xffff)) + bf2f((unsigned short)(y1.y & 0xffff)); ys.w = bf2f((unsigned short)(y0.y >> 16)) + bf2f((unsigned short)(y1.y >> 16));
                v[j] = v[j] + gf * ys;
            }
            s += (v[j].x * v[j].x + v[j].y * v[j].y) + (v[j].z * v[j].z + v[j].w * v[j].w);
        }
        const float rstd = __builtin_amdgcn_rsqf(wave_sum(s) * (1.f / DM) + EPS);
        f32x4* o = (f32x4*)(p.out + (size_t)m * DM) + lane;
#pragma unroll
        for (int j = 0; j < 4; ++j) { const f32x4 g = *(const f32x4*)(p.g_final + 4 * lane + 256 * j); o[64 * j] = v[j] * rstd * g; }
    }
}

#define XB_TMO      128
#define XB_XCNT(j)  (256  + 64 * (j))
#define XB_XSUB(j)  (1280 + 64 * (j))
#define XB_XGEN(j)  (2304 + 64 * (j))
#define XB_TOP      3328
#define XB_TOPGEN   3392
#define XCD_BAR_WORDS 3456
#define XB_SPIN_CAP (1u << 18)
__device__ __forceinline__ unsigned xb_ld(unsigned* p)              { return __hip_atomic_load(p, __ATOMIC_RELAXED, __HIP_MEMORY_SCOPE_AGENT); }
__device__ __forceinline__ unsigned xb_add(unsigned* p, unsigned v) { return __hip_atomic_fetch_add(p, v, __ATOMIC_RELAXED, __HIP_MEMORY_SCOPE_AGENT); }
__device__ __forceinline__ unsigned xb_xcc_id() { return (unsigned)__builtin_amdgcn_s_getreg((3 << 11) | 20) & 0xFu; }
#define XB_SPIN(cond, bar) do { unsigned _sp = 0; while (cond) { __builtin_amdgcn_s_sleep(1); \
    if ((++_sp & 255u) == 0u) { if (xb_ld(&(bar)[XB_TMO])) break; if (_sp > XB_SPIN_CAP) { atomicAdd(&(bar)[XB_TMO], 1u); break; } } } } while (0)
struct XcdBarrier { unsigned* bar; unsigned x; volatile LAS unsigned* st; };
__device__ __forceinline__ XcdBarrier xcd_barrier_post(unsigned* bar, volatile LAS unsigned* st) {
    XcdBarrier b; b.bar = bar; b.x = xb_xcc_id(); b.st = st;
    if (threadIdx.x == 0) st[2] = xb_add(&bar[XB_XCNT(b.x)], 1u);
    return b;
}
__device__ __forceinline__ void xcd_barrier_complete(unsigned* bar, unsigned x, unsigned& nloc, unsigned& nx) {
    const unsigned G = gridDim.x * gridDim.y * gridDim.z;
    unsigned sum, cnt, mine, sp = 0u;
    for (;;) {
        sum = 0u; cnt = 0u; mine = 0u;
#pragma unroll
        for (unsigned j = 0; j < 16; ++j) { const unsigned c = xb_ld(&bar[XB_XCNT(j)]); sum += c; cnt += (c > 0u) ? 1u : 0u; mine = (j == x) ? c : mine; }
        if (sum == G) break;
        __builtin_amdgcn_s_sleep(1);
        if ((++sp & 255u) == 0u) { if (xb_ld(&bar[XB_TMO])) break; if (sp > XB_SPIN_CAP) { atomicAdd(&bar[XB_TMO], 1u); break; } }
    }
    nloc = mine > 0u ? mine : 1u; nx = cnt > 0u ? cnt : 1u;
}
__device__ __forceinline__ void xcd_barrier_census(const XcdBarrier& b) {
    if (threadIdx.x < 64) {
        const unsigned G = gridDim.x * gridDim.y * gridDim.z, j = threadIdx.x & 15;
        unsigned c = 0u, sp = 0u;
        for (;;) {
            c = xb_ld(&b.bar[XB_XCNT(j)]);
            unsigned s = c;
            s += __shfl_xor(s, 1); s += __shfl_xor(s, 2); s += __shfl_xor(s, 4); s += __shfl_xor(s, 8);
            if (s == G) break;
            __builtin_amdgcn_s_sleep(1);
            if ((++sp & 255u) == 0u) { if (xb_ld(&b.bar[XB_TMO])) break; if (sp > XB_SPIN_CAP) { atomicAdd(&b.bar[XB_TMO], 1u); break; } }
        }
        const unsigned nloc = (unsigned)__builtin_amdgcn_readlane((int)c, (int)b.x);
        const unsigned nx = (unsigned)__popcll(__ballot(c > 0u) & 0xffffull);
        if (threadIdx.x == 0) { b.st[0] = nloc > 0u ? nloc : 1u; b.st[1] = nx > 0u ? nx : 1u; }
    }
    __syncthreads();
}
__device__ __forceinline__ void xcd_barrier(const XcdBarrier& b) {
    asm volatile("s_waitcnt vmcnt(0)" ::: "memory");
    __syncthreads();
    if (threadIdx.x == 0) {
        unsigned* bar = b.bar;
        __builtin_amdgcn_s_waitcnt(0);
        unsigned nloc = b.st[0], nx = b.st[1];
        if (nloc == 0u) { xcd_barrier_complete(bar, b.x, nloc, nx); b.st[0] = nloc; b.st[1] = nx; }
        const unsigned old = xb_add(&bar[XB_XSUB(b.x)], 1u);
        const unsigned gen = old / nloc;
        if (old + 1u == (gen + 1u) * nloc) {
            __builtin_amdgcn_fence(__ATOMIC_RELEASE, "agent");
            asm volatile("s_waitcnt vmcnt(0)" ::: "memory");
            const unsigned og = xb_add(&bar[XB_TOP], 1u);
            const unsigned tg = og / nx;
            if (og + 1u == (tg + 1u) * nx) xb_add(&bar[XB_TOPGEN], 1u);
            else XB_SPIN(xb_ld(&bar[XB_TOPGEN]) == tg, bar);
            __builtin_amdgcn_fence(__ATOMIC_ACQUIRE, "agent");
            xb_add(&bar[XB_XGEN(b.x)], 1u);
            asm volatile("s_waitcnt vmcnt(0)" ::: "memory");
        } else {
            XB_SPIN(xb_ld(&bar[XB_XGEN(b.x)]) == gen, bar);
            __builtin_amdgcn_fence(__ATOMIC_ACQUIRE, "agent");
            asm volatile("s_waitcnt vmcnt(0)" ::: "memory");
        }
    }
    __syncthreads();
}
namespace pg8 {
constexpr int BM = 256, BK = 64, HALF = 128, HTB = HALF * BK * 2, STAGE_BYTES = 8 * HTB, NXCD = 8, WGM = 8;
__host__ __device__ __forceinline__ int lds_byte(int r, int c) { const int st = (r >> 4) * 2 + (c >> 5), rr = r & 15, cc = c & 31, ob = rr * 64 + cc * 2; return st * 1024 + (ob ^ (((ob >> 9) & 1) << 5)); }
__host__ __device__ __forceinline__ void stage_rc(int b, int& R, int& C) { const int st = b / 1024, sb = b % 1024, swz = sb ^ (((sb >> 9) & 1) << 5); R = (st >> 1) * 16 + swz / 64; C = (st & 1) * 32 + (swz % 64) / 2; }
__host__ __device__ __forceinline__ int perm32(int rho) { const int n = rho >> 4, i = rho & 15; return 8 * (i >> 2) + 4 * n + (i & 3); }

struct Unit { int pm, pn; size_t aoff, boff; int e, r0, cnt; };
struct Gemm { const bf16_t* A; const bf16_t* Bt; int K; };

struct StaticOrder {
    int nM, nN, nwg, G, c; size_t tstep;
    __device__ void init(int M, int N, int K, int G_, int c_) { nM = M / BM; nN = N / BM; nwg = nM * nN; G = G_; c = c_; tstep = (size_t)BM * K * 2; }
    __device__ bool next(int i, Unit& u) const {
        const long L = (long)i * G + c; if (L >= nwg) return false;
        int wgid = (int)L; { const int q = nwg / NXCD, r = nwg % NXCD, xcd = wgid % NXCD, off = wgid / NXCD; wgid = (xcd < r ? xcd * (q + 1) : r * (q + 1) + (xcd - r) * q) + off; }
        const int nig = WGM * nN, gid = wgid / nig, fm = gid * WGM, gsz = (nM - fm) < WGM ? (nM - fm) : WGM;
        u.pm = fm + ((wgid % nig) % gsz); u.pn = (wgid % nig) / gsz; u.aoff = (size_t)u.pm * tstep; u.boff = (size_t)u.pn * tstep; u.e = 0; u.r0 = 0; u.cnt = 0; return true;
    }
    __device__ __forceinline__ unsigned arow(const Unit&, int R) const { return 0u; }
    __device__ __forceinline__ void a_ready(const Unit&) const {}
    __device__ __forceinline__ void done(const Unit&) const {}
};

__device__ __forceinline__ unsigned cvt_pk_bf16(float lo, float hi) { unsigned r; asm volatile("v_cvt_pk_bf16_f32 %0, %1, %2" : "=v"(r) : "v"(lo), "v"(hi)); return r; }

template <class Epi, class Sched, bool GATHER>
__device__ __forceinline__ void gemm_phase(LAS unsigned char* lds, const Gemm g, const Sched& S, const Epi& E) {
    int tid_ = threadIdx.x; asm volatile("" : "+v"(tid_)); const int tid = tid_, wid = __builtin_amdgcn_readfirstlane(tid >> 6), lane = tid & 63, wr = wid >> 2, wc = wid & 3, fr = lane & 15, fq = lane >> 4;
    const int K = g.K, nt = K / BK;
    int Rst[2], Cst[2]; unsigned voffB[2], voffA[2], cOA[2][2], nOA[2][2];
    const size_t kstep = (size_t)(BK * 2);
    const size_t hstep = (size_t)HALF * K * 2;
#pragma unroll
    for (int i = 0; i < 2; ++i) { int R, C; stage_rc(tid * 16 + i * 8192, R, C); Rst[i] = R; Cst[i] = C; const int Rb = Epi::PERM ? ((R & ~31) + perm32(R & 31)) : R; voffB[i] = (unsigned)(Rb * K + C) * 2u; voffA[i] = (unsigned)(R * K + C) * 2u; }
    const unsigned ldsw = (unsigned)wid * 1024u;
    const int aoff = lds_byte(wr * 64 + fr, fq * 8), boff = lds_byte(wc * 32 + fr, fq * 8);
#define PG8_SA(b, h) (((b) * 2 + (h)) * HTB)
#define PG8_SB(b, h) ((4 + (b) * 2 + (h)) * HTB)
#define PG8_STAGE_B(bufoff, gbase) do { _Pragma("unroll") for (int _i = 0; _i < 2; ++_i) \
        __builtin_amdgcn_global_load_lds((const unsigned*)((const char*)(gbase) + voffB[_i]), (LAS unsigned*)(lds + (bufoff) + ldsw + _i * 8192), 16, 0, 0); } while (0)
#define PG8_STAGE_A(bufoff, gbase, H, o0, o1) do { \
        const char* _gb = GATHER ? (const char*)(gbase) : (const char*)(gbase) + (H) * hstep; \
        const unsigned _o0 = GATHER ? (o0) : voffA[0], _o1 = GATHER ? (o1) : voffA[1]; \
        __builtin_amdgcn_global_load_lds((const unsigned*)(_gb + _o0), (LAS unsigned*)(lds + (bufoff) + ldsw), 16, 0, 0); \
        __builtin_amdgcn_global_load_lds((const unsigned*)(_gb + _o1), (LAS unsigned*)(lds + (bufoff) + ldsw + 8192), 16, 0, 0); } while (0)
#define PG8_LDA(dst, b, h) do { _Pragma("unroll") for (int m = 0; m < 4; ++m) _Pragma("unroll") for (int k = 0; k < 2; ++k) dst[m][k] = *(const LAS bf16x8*)(lds + PG8_SA(b, h) + aoff + m * 2048 + k * 1024); } while (0)
#define PG8_LDB(dst, b, h) do { _Pragma("unroll") for (int n = 0; n < 2; ++n) _Pragma("unroll") for (int k = 0; k < 2; ++k) dst[n][k] = *(const LAS bf16x8*)(lds + PG8_SB(b, h) + boff + n * 2048 + k * 1024); } while (0)
#define PG8_MMA(ai, bj, At, Bt) do { __builtin_amdgcn_s_setprio(1); _Pragma("unroll") for (int m = 0; m < 4; ++m) _Pragma("unroll") for (int n = 0; n < 2; ++n) _Pragma("unroll") for (int k = 0; k < 2; ++k) \
        acc[ai][bj][m][n] = __builtin_amdgcn_mfma_f32_16x16x32_bf16(Bt[n][k], At[m][k], acc[ai][bj][m][n], 0, 0, 0); __builtin_amdgcn_s_setprio(0); } while (0)
#define PG8_WAIT_V(n) asm volatile("s_waitcnt vmcnt(" #n ")" ::: "memory")
#define PG8_WAIT_L(n) asm volatile("s_waitcnt lgkmcnt(" #n ")" ::: "memory")
#define PG8_BAR __builtin_amdgcn_s_barrier()
#define PG8_SCHED __builtin_amdgcn_sched_barrier(0)
#define PG8_SETOFF(dst, u) do { if (GATHER) { _Pragma("unroll") for (int _h = 0; _h < 2; ++_h) _Pragma("unroll") for (int _i = 0; _i < 2; ++_i) \
        dst[_h][_i] = S.arow(u, Rst[_i] + HALF * _h) * (unsigned)(K * 2) + (unsigned)(Cst[_i] * 2); } } while (0)
    Unit cur, nxt; int ui = 0;
    if (!S.next(0, cur)) return;
    f32x4 acc[2][2][4][2];
#pragma unroll
    for (int a = 0; a < 2; ++a)
#pragma unroll
        for (int b = 0; b < 2; ++b)
#pragma unroll
            for (int m = 0; m < 4; ++m)
#pragma unroll
                for (int n = 0; n < 2; ++n) acc[a][b][m][n] = (f32x4){0.f, 0.f, 0.f, 0.f};
    bf16x8 At[4][2], B0[2][2], B1[2][2];
    const char* cA = (const char*)g.A + cur.aoff; const char* cB = (const char*)g.Bt + cur.boff;
    S.a_ready(cur);
    PG8_SETOFF(cOA, cur);
    if constexpr (Epi::PRE) E.pre(lds, cur, wr);
    PG8_STAGE_B(PG8_SB(0, 0), cB); PG8_STAGE_B(PG8_SB(0, 1), cB + hstep); PG8_STAGE_A(PG8_SA(0, 0), cA, 0, cOA[0][0], cOA[0][1]); PG8_STAGE_A(PG8_SA(0, 1), cA, 1, cOA[1][0], cOA[1][1]);
    if (wr == 1) PG8_BAR;
    PG8_WAIT_V(2); PG8_BAR;
    PG8_STAGE_B(PG8_SB(1, 0), cB + kstep); PG8_STAGE_A(PG8_SA(1, 0), cA + kstep, 0, cOA[0][0], cOA[0][1]); PG8_STAGE_B(PG8_SB(1, 1), cB + hstep + kstep);
    PG8_WAIT_V(6); PG8_BAR;
    for (;;) {
        const bool has_next = S.next(ui + 1, nxt);
        if (has_next) S.a_ready(nxt);
        const char* nA = has_next ? (const char*)g.A + nxt.aoff : cA; const char* nB = has_next ? (const char*)g.Bt + nxt.boff : cB;
        if constexpr (GATHER) { if (has_next) { PG8_SETOFF(nOA, nxt); } else {
#pragma unroll
            for (int _h = 0; _h < 2; ++_h)
#pragma unroll
                for (int _i = 0; _i < 2; ++_i) nOA[_h][_i] = cOA[_h][_i]; } }
        for (int t = 0; t < nt; t += 2) {
            const bool last = (t == nt - 2);
            if constexpr (Epi::MID) { if (t == nt / 2) E.mid(acc, cur, wr, lds); }
            const char* a1 = cA + (size_t)(t + 1) * kstep;
            const char* a2 = last ? nA : cA + (size_t)(t + 2) * kstep; const char* b2 = last ? nB : cB + (size_t)(t + 2) * kstep;
            const char* a3 = a2 + kstep; const char* b3 = b2 + kstep;
            unsigned x00 = 0, x01 = 0, x10 = 0, x11 = 0;
            if constexpr (GATHER) { x00 = last ? nOA[0][0] : cOA[0][0]; x01 = last ? nOA[0][1] : cOA[0][1]; x10 = last ? nOA[1][0] : cOA[1][0]; x11 = last ? nOA[1][1] : cOA[1][1]; }
            PG8_LDB(B0, 0, 0); PG8_LDB(B1, 0, 1); PG8_SCHED; PG8_LDA(At, 0, 0); PG8_STAGE_A(PG8_SA(1, 1), a1, 1, cOA[1][0], cOA[1][1]);
            PG8_WAIT_V(8); PG8_WAIT_L(0); PG8_BAR; PG8_MMA(0, 0, At, B0); PG8_MMA(0, 1, At, B1); PG8_BAR; PG8_SCHED;
            PG8_LDA(At, 0, 1); PG8_STAGE_B(PG8_SB(0, 0), b2); PG8_STAGE_B(PG8_SB(0, 1), b2 + hstep); PG8_STAGE_A(PG8_SA(0, 0), a2, 0, x00, x01);
            PG8_WAIT_V(8); PG8_WAIT_L(0); PG8_BAR; PG8_MMA(1, 0, At, B0); PG8_MMA(1, 1, At, B1); PG8_BAR; PG8_SCHED;
            PG8_LDB(B0, 1, 0); PG8_LDB(B1, 1, 1); PG8_SCHED; PG8_LDA(At, 1, 0); PG8_STAGE_A(PG8_SA(0, 1), a2, 1, x10, x11);
            PG8_WAIT_V(8); PG8_WAIT_L(0); PG8_BAR; PG8_MMA(0, 0, At, B0); PG8_MMA(0, 1, At, B1); PG8_BAR; PG8_SCHED;
            PG8_LDA(At, 1, 1); PG8_STAGE_B(PG8_SB(1, 0), b3); PG8_STAGE_B(PG8_SB(1, 1), b3 + hstep); PG8_STAGE_A(PG8_SA(1, 0), a3, 0, x00, x01);
            PG8_WAIT_V(8); PG8_WAIT_L(0); PG8_BAR; PG8_MMA(1, 0, At, B0); PG8_MMA(1, 1, At, B1); PG8_BAR; PG8_SCHED;
        }
        if (wr == 0) PG8_BAR;
        if constexpr (Epi::PRE) E(acc, cur, wr, wc, lds); else E(acc, cur, wr, wc);
        S.done(cur);
        if (!has_next) break;
        if constexpr (Epi::PRE) { PG8_BAR; E.pre(lds, nxt, wr); }
#pragma unroll
        for (int a = 0; a < 2; ++a)
#pragma unroll
            for (int b = 0; b < 2; ++b)
#pragma unroll
                for (int m = 0; m < 4; ++m)
#pragma unroll
                    for (int n = 0; n < 2; ++n) acc[a][b][m][n] = (f32x4){0.f, 0.f, 0.f, 0.f};
        cur = nxt; cA = nA; cB = nB; ++ui;
        if constexpr (GATHER) {
#pragma unroll
            for (int _h = 0; _h < 2; ++_h)
#pragma unroll
                for (int _i = 0; _i < 2; ++_i) cOA[_h][_i] = nOA[_h][_i]; }
        if (wr == 1) PG8_BAR;
    }
    PG8_WAIT_V(0);
    PG8_BAR;
#undef PG8_SA
#undef PG8_SB
#undef PG8_STAGE_A
#undef PG8_STAGE_B
#undef PG8_LDA
#undef PG8_LDB
#undef PG8_MMA
#undef PG8_WAIT_V
#undef PG8_WAIT_L
#undef PG8_BAR
#undef PG8_SCHED
#undef PG8_SETOFF
}
}
typedef float f32x2 __attribute__((ext_vector_type(2)));
using pg8::cvt_pk_bf16;

struct EpiProj {
    static constexpr bool PERM = true, MID = false, PRE = false;
    bf16_t* O; float* iw; float* logf; const float* b_forget; unsigned char* ikf;
    __device__ __forceinline__ void operator()(const f32x4 (&acc)[2][2][4][2], const pg8::Unit& u, int wr, int wc) const {
        int ln_ = threadIdx.x & 63; asm volatile("" : "+v"(ln_)); const int fr = ln_ & 15, fq = ln_ >> 4;
        const int row0 = u.pm * 256 + wr * 64 + fr, col0 = u.pn * 256 + wc * 32 + 8 * fq;
        const float sc = (u.pn < 4) ? C2 : 1.f;
#pragma unroll
        for (int ai = 0; ai < 2; ++ai)
#pragma unroll
            for (int m = 0; m < 4; ++m) {
                const int row = row0 + ai * 128 + m * 16;
                bf16_t* rowp = O + (size_t)row * NPROJ + col0;
#pragma unroll
                for (int bj = 0; bj < 2; ++bj) {
                    const f32x4 v0 = acc[ai][bj][m][0] * sc, v1 = acc[ai][bj][m][1] * sc;
                    u32x4 w; w.x = cvt_pk_bf16(v0[0], v0[1]); w.y = cvt_pk_bf16(v0[2], v0[3]); w.z = cvt_pk_bf16(v1[0], v1[1]); w.w = cvt_pk_bf16(v1[2], v1[3]);
                    *(u32x4*)(rowp + bj * 128) = w;
                    if (u.pn == 11 && bj == 0 && wc < 2)
                        *(u32x4*)(ikf + ((size_t)(row >> 5) << 12) + (wc * 2 + (fq >> 1)) * 1024 + (row & 31) * 32 + (fq & 1) * 16) = w;
                }
                if (u.pn == 11 && wc == 2 && fq < 2) {
                    const f32x4 v0 = acc[ai][0][m][0], v1 = acc[ai][0][m][1];
                    if (fq == 0) { *(f32x4*)(iw + (size_t)row * 8) = v0; *(f32x4*)(iw + (size_t)row * 8 + 4) = v1; }
                    else {
                        f32x4 o0, o1;
#pragma unroll
                        for (int i = 0; i < 4; ++i) {
                            const float z0 = v0[i] + b_forget[i], z1 = v1[i] + b_forget[4 + i];
                            o0[i] = fminf(z0, 0.f) - __logf(1.f + __expf(-fabsf(z0))); o1[i] = fminf(z1, 0.f) - __logf(1.f + __expf(-fabsf(z1)));
                        }
                        *(f32x4*)(logf + (size_t)row * 8) = o0; *(f32x4*)(logf + (size_t)row * 8 + 4) = o1;
                    }
                }
            }
    }
};

struct EpiOut {
    static constexpr bool PERM = false, MID = true, PRE = true;
    const float* x; float* x1; const float* mod; const float* ssq; float* x1ssq;
    __device__ __forceinline__ void rowscale(int row, int fq, float& ra, float& rb) const {
        const f32x4 a = *((const f32x4*)(ssq + (size_t)row * 16) + fq);
        const float t = (a[0] + a[1]) + (a[2] + a[3]);
        const float u2 = t + __shfl_xor(t, 16), v2 = __shfl_xor(u2, 32);
        const float sa = (fq < 2) ? u2 : v2, sb = (fq < 2) ? v2 : u2;
        ra = __builtin_amdgcn_rsqf(sa * (1.f / 512.f) + EPS); rb = __builtin_amdgcn_rsqf(sb * (1.f / 512.f) + EPS);
    }
    static constexpr int EPRE_OFF = 131072 + 2048;
    __device__ __forceinline__ void pre(LAS unsigned char* lds, const pg8::Unit& u, int wr) const {
        int ln_ = threadIdx.x & 63; asm volatile("" : "+v"(ln_)); const int fr = ln_ & 15, fq = ln_ >> 4;
        LAS f32x2* pr = (LAS f32x2*)(lds + EPRE_OFF);
        f32x4 a[8];
#pragma unroll
        for (int i = 0; i < 8; ++i) a[i] = *((const f32x4*)(ssq + (size_t)(u.pm * 256 + (i >> 2) * 128 + wr * 64 + (i & 3) * 16 + fr) * 16) + fq);
#pragma unroll
        for (int i = 0; i < 8; ++i) {
            const float t = (a[i][0] + a[i][1]) + (a[i][2] + a[i][3]);
            const float u2 = t + __shfl_xor(t, 16), v2 = __shfl_xor(u2, 32);
            const float sa = (fq < 2) ? u2 : v2, sb = (fq < 2) ? v2 : u2;
            const float ra = __builtin_amdgcn_rsqf(sa * (1.f / 512.f) + EPS), rb = __builtin_amdgcn_rsqf(sb * (1.f / 512.f) + EPS);
            f32x2 w2; w2.x = ra * __builtin_amdgcn_rcpf(rb); w2.y = rb;
            pr[(i >> 2) * 128 + wr * 64 + (i & 3) * 16 + fr] = w2;
        }
    }
    __device__ __forceinline__ void mid(f32x4 (&acc)[2][2][4][2], const pg8::Unit& u, int wr, LAS unsigned char* lds) const {
        int ln_ = threadIdx.x & 63; asm volatile("" : "+v"(ln_)); const int fr = ln_ & 15;
        const LAS f32x2* pr = (const LAS f32x2*)(lds + EPRE_OFF);
#pragma unroll
        for (int ai = 0; ai < 2; ++ai)
#pragma unroll
            for (int m = 0; m < 4; ++m) {
                const float f = pr[ai * 128 + wr * 64 + m * 16 + fr].x;
#pragma unroll
                for (int bj = 0; bj < 2; ++bj)
#pragma unroll
                    for (int n = 0; n < 2; ++n) acc[ai][bj][m][n] = acc[ai][bj][m][n] * f;
            }
    }
    __device__ __forceinline__ void operator()(const f32x4 (&acc)[2][2][4][2], const pg8::Unit& u, int wr, int wc, LAS unsigned char* lds) const {
        int ln_ = threadIdx.x & 63; asm volatile("" : "+v"(ln_)); const int fr = ln_ & 15, fq = ln_ >> 4;
        const LAS f32x2* pr = (const LAS f32x2*)(lds + EPRE_OFF);
        const int col0 = u.pn * 256 + wc * 32 + 4 * fq;
        bf16_t* x1b = (bf16_t*)x1;
        f32x4 gmv[2][2];
        {
            const int b0 = (u.pm * 256) >> 11;
#pragma unroll
            for (int bj = 0; bj < 2; ++bj)
#pragma unroll
                for (int n = 0; n < 2; ++n) gmv[bj][n] = *(const f32x4*)(mod + b0 * NMOD + 2 * DM + col0 + bj * 128 + n * 16);
        }
        const int rbase = u.pm * 256 + wr * 64 + fr;
        f32x4 xb[3][4];
#pragma unroll
        for (int i = 0; i < 2; ++i)
#pragma unroll
            for (int j = 0; j < 4; ++j) xb[i][j] = __builtin_nontemporal_load((const f32x4*)(x + (size_t)(rbase + (i >> 2) * 128 + (i & 3) * 16) * DM + col0 + (j >> 1) * 128 + (j & 1) * 16));
#pragma unroll
        for (int i = 0; i < 8; ++i) {
            const int ai = i >> 2, m = i & 3;
            if (i + 2 < 8) {
#pragma unroll
                for (int j = 0; j < 4; ++j) xb[(i + 2) % 3][j] = __builtin_nontemporal_load((const f32x4*)(x + (size_t)(rbase + ((i + 2) >> 2) * 128 + ((i + 2) & 3) * 16) * DM + col0 + (j >> 1) * 128 + (j & 1) * 16));
            }
            const int row = rbase + ai * 128 + m * 16;
            const float rb = pr[ai * 128 + wr * 64 + m * 16 + fr].y;
            float q = 0.f;
#pragma unroll
            for (int bj = 0; bj < 2; ++bj) {
                unsigned pw[2][2];
#pragma unroll
                for (int n = 0; n < 2; ++n) {
                    const f32x4 xv = xb[i % 3][bj * 2 + n], gm = gmv[bj][n];
                    const f32x4 o = xv + gm * (acc[ai][bj][m][n] * rb);
                    pw[n][0] = cvt_pk_bf16(o[0], o[1]); pw[n][1] = cvt_pk_bf16(o[2], o[3]);
                    q += (o[0] * o[0] + o[1] * o[1]) + (o[2] * o[2] + o[3] * o[3]);
                }
                const auto s0 = __builtin_amdgcn_permlane16_swap(pw[0][0], pw[1][0], false, false);
                const auto s1 = __builtin_amdgcn_permlane16_swap(pw[0][1], pw[1][1], false, false);
                const unsigned a0 = s0[0], b0 = s0[1], a1 = s1[0], b1 = s1[1];
                u32x4 w; w.x = a0; w.y = a1; w.z = b0; w.w = b1;
                const int col = (fq & 1) ? col0 - 4 + bj * 128 + 16 : col0 + bj * 128;
                *(u32x4*)(x1b + (size_t)row * (2 * DM) + col) = w;
            }
            q += __shfl_xor(q, 16); q += __shfl_xor(q, 32);
            if (fq == 0) x1ssq[(size_t)row * 16 + u.pn * 4 + wc] = q;
        }
    }
};

struct EpiAct {
    static constexpr bool PERM = true, MID = false, PRE = true;
    static constexpr int EPRE_OFF = 131072 + 2048;
    bf16_t* act; const float* rws;
    __device__ __forceinline__ void pre(LAS unsigned char* lds, const pg8::Unit& u, int wr) const {
        int ln_ = threadIdx.x & 63; asm volatile("" : "+v"(ln_)); const int fr = ln_ & 15;
        LAS float* pw = (LAS float*)(lds + EPRE_OFF);
        float w[8];
#pragma unroll
        for (int i = 0; i < 8; ++i) { const int rl = (i >> 2) * 128 + wr * 64 + (i & 3) * 16 + fr; w[i] = (u.r0 + rl < u.cnt) ? rws[u.e * 16384 + u.r0 + rl] : 0.f; }
#pragma unroll
        for (int i = 0; i < 8; ++i) pw[(i >> 2) * 128 + wr * 64 + (i & 3) * 16 + fr] = w[i];
    }
    __device__ __forceinline__ void operator()(const f32x4 (&acc)[2][2][4][2], const pg8::Unit& u, int wr, int wc, LAS unsigned char* lds) const {
        int ln_ = threadIdx.x & 63; asm volatile("" : "+v"(ln_)); const int fr = ln_ & 15, fq = ln_ >> 4;
        const LAS float* pw = (const LAS float*)(lds + EPRE_OFF);
        const int col0 = u.pn * 128 + wc * 32 + 8 * fq;
#pragma unroll
        for (int ai = 0; ai < 2; ++ai)
#pragma unroll
            for (int m = 0; m < 4; ++m) {
                const int rl = ai * 128 + wr * 64 + m * 16 + fr;
                const float w = pw[rl];
                f32x4 o[2];
#pragma unroll
                for (int n = 0; n < 2; ++n)
#pragma unroll
                    for (int i = 0; i < 4; ++i) { const float gv = acc[ai][0][m][n][i], uv = acc[ai][1][m][n][i]; o[n][i] = gv * __builtin_amdgcn_rcpf(1.f + __expf(-gv)) * uv * w; }
                u32x4 pk; pk.x = cvt_pk_bf16(o[0][0], o[0][1]); pk.y = cvt_pk_bf16(o[0][2], o[0][3]); pk.z = cvt_pk_bf16(o[1][0], o[1][1]); pk.w = cvt_pk_bf16(o[1][2], o[1][3]);
                *(u32x4*)(act + ((size_t)u.pm * 256 + rl) * 256 + col0) = pk;
            }
    }
};

struct EpiDown {
    static constexpr bool PERM = true, MID = false, PRE = true;
    static constexpr int EPRE_OFF = 131072 + 2048;
    bf16_t* y; const int* list;
    __device__ __forceinline__ void pre(LAS unsigned char* lds, const pg8::Unit& u, int wr) const {
        int ln_ = threadIdx.x & 63; asm volatile("" : "+v"(ln_)); const int fr = ln_ & 15;
        LAS int* ps = (LAS int*)(lds + EPRE_OFF);
        int s[8];
#pragma unroll
        for (int i = 0; i < 8; ++i) { const int rl = (i >> 2) * 128 + wr * 64 + (i & 3) * 16 + fr; s[i] = (u.r0 + rl < u.cnt) ? list[u.e * 16384 + u.r0 + rl] : -1; }
#pragma unroll
        for (int i = 0; i < 8; ++i) ps[(i >> 2) * 128 + wr * 64 + (i & 3) * 16 + fr] = s[i];
    }
    __device__ __forceinline__ void operator()(const f32x4 (&acc)[2][2][4][2], const pg8::Unit& u, int wr, int wc, LAS unsigned char* lds) const {
        int ln_ = threadIdx.x & 63; asm volatile("" : "+v"(ln_)); const int fr = ln_ & 15, fq = ln_ >> 4;
        const LAS int* ps = (const LAS int*)(lds + EPRE_OFF);
        const int col0 = u.pn * 256 + wc * 32 + 8 * fq;
#pragma unroll
        for (int ai = 0; ai < 2; ++ai)
#pragma unroll
            for (int m = 0; m < 4; ++m) {
                const int rl = ai * 128 + wr * 64 + m * 16 + fr;
                const int slot = ps[rl];
                if (slot >= 0) {
#pragma unroll
                    for (int bj = 0; bj < 2; ++bj) {
                        const f32x4 v0 = acc[ai][bj][m][0], v1 = acc[ai][bj][m][1];
                        u32x4 pk; pk.x = cvt_pk_bf16(v0[0], v0[1]); pk.y = cvt_pk_bf16(v0[2], v0[3]); pk.z = cvt_pk_bf16(v1[0], v1[1]); pk.w = cvt_pk_bf16(v1[2], v1[3]);
                        *(u32x4*)(y + (size_t)slot * DM + col0 + bj * 128) = pk;
                    }
                }
            }
    }
};

constexpr int MOE_TAB_OFF = 131072 + 1024;
__device__ __forceinline__ void moe_order_setup(const unsigned* cnt, LAS int* tab) {
    const int tid = threadIdx.x;
    if (tid < 64) {
        const int e = tid & 31;
        const int c = (int)cnt[e * 64];
        const int nt_ = (c + 255) >> 8;
        int inc = nt_;
#pragma unroll
        for (int o = 1; o < 32; o <<= 1) { const int t = __shfl_up(inc, o, 32); if (e >= o) inc += t; }
        if (tid < 32) { tab[e] = c; tab[32 + e] = inc - nt_; if (e == 31) tab[64] = inc; }
    }
    __syncthreads();
}
struct MoeOrder {
    const LAS int* tab; const int* list; unsigned* flags; int NN, G, c; size_t a_tile, b_exp, b_tile; bool gather; int mode; int c0;
    __device__ bool next(int i, pg8::Unit& u) const {
        const int L = (i == 0) ? c0 : i * G + c, tau = L / NN, pn = L - tau * NN;
        if (tau >= __builtin_amdgcn_readfirstlane(tab[64])) return false;
        int e = 0;
#pragma unroll 1
        for (int s = 16; s >= 1; s >>= 1) if (__builtin_amdgcn_readfirstlane(tab[32 + e + s]) <= tau) e += s;
        u.pm = tau; u.pn = pn; u.e = e; u.r0 = (tau - __builtin_amdgcn_readfirstlane(tab[32 + e])) * 256; u.cnt = __builtin_amdgcn_readfirstlane(tab[e]);
        u.aoff = gather ? 0 : (size_t)tau * a_tile; u.boff = (size_t)e * b_exp + (size_t)pn * b_tile; return true;
    }
    __device__ __forceinline__ unsigned arow(const pg8::Unit& u, int R) const {
        int r = u.r0 + R; if (r >= u.cnt) r = u.cnt - 1;
        return (unsigned)(list[u.e * 16384 + r] >> 1);
    }
    __device__ __forceinline__ void a_ready(const pg8::Unit& u) const {
        if (mode == 1) {
            unsigned* f = flags + 32 * u.pm; unsigned sp = 0;
            while (__hip_atomic_load(f, __ATOMIC_RELAXED, __HIP_MEMORY_SCOPE_AGENT) < 2u) { __builtin_amdgcn_s_sleep(4); if (++sp > (1u << 20)) break; }
            asm volatile("" ::: "memory");
        }
    }
    __device__ __forceinline__ void done(const pg8::Unit& u) const {
        if (mode == 0) {
            asm volatile("s_waitcnt vmcnt(0)" ::: "memory");
            __builtin_amdgcn_s_barrier();
            if (threadIdx.x == 0) {
                __builtin_amdgcn_fence(__ATOMIC_RELEASE, "agent");
                asm volatile("s_waitcnt vmcnt(0)" ::: "memory");
                __hip_atomic_fetch_add(flags + 32 * u.pm, 1u, __ATOMIC_RELAXED, __HIP_MEMORY_SCOPE_AGENT);
            }
        }
    }
};
constexpr int AT_K = 0, AT_V = 16384, AT_CUM = 32768, AT_WSF = 40960, AT_OST = 43008, AT_END = 43008 + 32768;
constexpr float ATT_THR = 6.0f;
__device__ __forceinline__ int crow(int r, int hi) { return (r & 3) + 8 * (r >> 2) + 4 * hi; }
typedef short v4i16_t __attribute__((ext_vector_type(4)));
typedef __bf16 bf16x2_t __attribute__((ext_vector_type(2)));
__device__ __forceinline__ v4i16_t vtr(const LAS unsigned char* p) { return __builtin_amdgcn_ds_read_tr16_b64_v4i16((LAS v4i16_t*)p); }
__device__ __forceinline__ float max3f(float a, float b, float c) { return fmaxf(fmaxf(a, b), c); }

template <int MODE> __device__ __forceinline__ void att_cinit(f32x16& c0, f32x16& c1, const LAS float* cumk, int kv0, int hi, float m_run, float slope2, u32x2 mw, int qrow, bool band) {
    if (MODE == 0) {
#pragma unroll
        for (int g4 = 0; g4 < 4; ++g4) {
            const f32x4 a = *(const LAS f32x4*)(cumk + kv0 + 8 * g4 + 4 * hi), c = *(const LAS f32x4*)(cumk + kv0 + 32 + 8 * g4 + 4 * hi);
#pragma unroll
            for (int i = 0; i < 4; ++i) { c0[4 * g4 + i] = a[i] - m_run; c1[4 * g4 + i] = c[i] - m_run; }
        }
        if (band) {
#pragma unroll
            for (int r = 0; r < 16; ++r) { const int kv = kv0 + crow(r, hi); if (kv > qrow) c0[r] = -INFINITY; if (kv + 32 > qrow) c1[r] = -INFINITY; }
        }
    } else {
        const float base0 = slope2 * (float)(kv0 + 4 * hi) - m_run, base1 = base0 + slope2 * 32.f;
        const unsigned w0 = mw.x >> (4 * hi), w1 = mw.y >> (4 * hi);
#pragma unroll
        for (int r = 0; r < 16; ++r) {
            const int cr = (r & 3) + 8 * (r >> 2);
            const float v0 = fmaf(slope2, (float)cr, base0), v1 = fmaf(slope2, (float)cr, base1);
            const int t0 = ((int)(w0 << (31 - cr))) >> 31, t1 = ((int)(w1 << (31 - cr))) >> 31;
            c0[r] = __builtin_bit_cast(float, (__builtin_bit_cast(int, v0) & t0) | (int)(0xff800000u & ~(unsigned)t0));
            c1[r] = __builtin_bit_cast(float, (__builtin_bit_cast(int, v1) & t1) | (int)(0xff800000u & ~(unsigned)t1));
        }
    }
}
__device__ __forceinline__ void att_kload(bf16x8 (&kf)[8], const LAS unsigned char* kb) {
#pragma unroll
    for (int d0 = 0; d0 < 4; ++d0) { kf[2 * d0] = *(const LAS bf16x8*)(kb + d0 * 2048); kf[2 * d0 + 1] = *(const LAS bf16x8*)(kb + d0 * 2048 + 512); }
}
struct AttState { float m_run, l_run; bool started, resc; };

template <int MODE, bool FIRST, bool HAS_NEXT, bool MAYDEAD>
__device__ __forceinline__ void att_step(f32x16& X0, f32x16& X1, f32x16& Y0, f32x16& Y1, f32x16 (&o)[2], const bf16x8 (&qr)[4], bf16x8 (&kf)[8], AttState& st,
                                         const LAS unsigned char* vprev, const LAS unsigned char* knext, int kv0_next, u32x2 mw_next, bool band_next,
                                         const LAS float* cumk, LAS float* wsf, int r32, int hi, float slope2, int qrow, bool dead_rt) {
    const bool dead = MAYDEAD && dead_rt;
    bf16x8 vfr[4][2];
    if (!FIRST && !dead) {
#pragma unroll
        for (int ks = 0; ks < 4; ++ks)
#pragma unroll
            for (int d0 = 0; d0 < 2; ++d0) {
                const v4i16_t lo = vtr(vprev + d0 * 4096 + ks * 1024), hh = vtr(vprev + d0 * 4096 + ks * 1024 + 512);
                vfr[ks][d0] = (bf16x8){lo[0], lo[1], lo[2], lo[3], hh[0], hh[1], hh[2], hh[3]};
            }
    }
    bf16x8 pa[4];
    if (!dead) {
#pragma unroll
        for (int d0 = 0; d0 < 4; ++d0) {
            X0 = __builtin_amdgcn_mfma_f32_32x32x16_bf16(kf[2 * d0], qr[d0], X0, 0, 0, 0);
            X1 = __builtin_amdgcn_mfma_f32_32x32x16_bf16(kf[2 * d0 + 1], qr[d0], X1, 0, 0, 0);
        }
    }
    if (!FIRST && !dead) {
        float s0 = 0.f, s1 = 0.f, s2 = 0.f, s3 = 0.f;
        const bf16x2_t one2 = __builtin_bit_cast(bf16x2_t, 0x3f803f80u);
#pragma unroll
        for (int s = 0; s < 2; ++s) {
            const unsigned a0 = pg8::cvt_pk_bf16(Y0[8 * s + 0], Y0[8 * s + 1]), a1 = pg8::cvt_pk_bf16(Y0[8 * s + 2], Y0[8 * s + 3]), a2 = pg8::cvt_pk_bf16(Y0[8 * s + 4], Y0[8 * s + 5]), a3 = pg8::cvt_pk_bf16(Y0[8 * s + 6], Y0[8 * s + 7]);
            const unsigned b0 = pg8::cvt_pk_bf16(Y1[8 * s + 0], Y1[8 * s + 1]), b1 = pg8::cvt_pk_bf16(Y1[8 * s + 2], Y1[8 * s + 3]), b2 = pg8::cvt_pk_bf16(Y1[8 * s + 4], Y1[8 * s + 5]), b3 = pg8::cvt_pk_bf16(Y1[8 * s + 6], Y1[8 * s + 7]);
            s0 = __builtin_amdgcn_fdot2_f32_bf16(__builtin_bit_cast(bf16x2_t, a0), one2, s0, false); s1 = __builtin_amdgcn_fdot2_f32_bf16(__builtin_bit_cast(bf16x2_t, a1), one2, s1, false);
            s2 = __builtin_amdgcn_fdot2_f32_bf16(__builtin_bit_cast(bf16x2_t, a2), one2, s2, false); s3 = __builtin_amdgcn_fdot2_f32_bf16(__builtin_bit_cast(bf16x2_t, a3), one2, s3, false);
            s0 = __builtin_amdgcn_fdot2_f32_bf16(__builtin_bit_cast(bf16x2_t, b0), one2, s0, false); s1 = __builtin_amdgcn_fdot2_f32_bf16(__builtin_bit_cast(bf16x2_t, b1), one2, s1, false);
            s2 = __builtin_amdgcn_fdot2_f32_bf16(__builtin_bit_cast(bf16x2_t, b2), one2, s2, false); s3 = __builtin_amdgcn_fdot2_f32_bf16(__builtin_bit_cast(bf16x2_t, b3), one2, s3, false);
            u32x4 w0, w1; w0.x = a0; w0.y = a1; w0.z = a2; w0.w = a3; w1.x = b0; w1.y = b1; w1.z = b2; w1.w = b3;
            pa[s] = __builtin_bit_cast(bf16x8, w0); pa[2 + s] = __builtin_bit_cast(bf16x8, w1);
        }
        st.l_run += (s0 + s1) + (s2 + s3);
    }
    if (!FIRST && !dead) {
#pragma unroll
        for (int d0 = 0; d0 < 2; ++d0) o[d0] = __builtin_amdgcn_mfma_f32_32x32x16_bf16(pa[0], vfr[0][d0], o[d0], 0, 0, 0);
    }
    if (!dead) {
        float a = max3f(X0[0], X0[1], X1[0]), c = max3f(X0[2], X0[3], X1[1]); a = max3f(a, X1[2], X1[3]);
#pragma unroll
        for (int r = 4; r < 16; r += 4) { a = max3f(a, X0[r], X0[r + 1]); c = max3f(c, X0[r + 2], X0[r + 3]); a = max3f(a, X1[r], X1[r + 1]); c = max3f(c, X1[r + 2], X1[r + 3]); }
        float rm = fmaxf(a, c); rm = fmaxf(rm, __shfl_xor(rm, 32));
        const bool bump = st.started ? (rm > ATT_THR) : (rm > -INFINITY);
        if (__any(bump)) {
            const float dl = bump ? rm : 0.f;
#pragma unroll
            for (int r = 0; r < 16; ++r) { X0[r] -= dl; X1[r] -= dl; }
            st.m_run += dl;
            const float f = (bump && st.started) ? __builtin_amdgcn_exp2f(-dl) : 1.f;
            st.l_run *= f; if (hi == 0) wsf[r32] = f; st.resc = true; st.started = st.started || bump;
        }
    }
    if (!FIRST && !dead) {
#pragma unroll
        for (int ks = 1; ks < 4; ++ks)
#pragma unroll
            for (int d0 = 0; d0 < 2; ++d0) o[d0] = __builtin_amdgcn_mfma_f32_32x32x16_bf16(pa[ks], vfr[ks][d0], o[d0], 0, 0, 0);
    }
    if (!dead) {
#pragma unroll
        for (int r = 0; r < 16; ++r) { X0[r] = __builtin_amdgcn_exp2f(X0[r]); X1[r] = __builtin_amdgcn_exp2f(X1[r]); }
    } else { X0 = f32x16{}; X1 = f32x16{}; }
    if (!FIRST) {
#pragma unroll
        for (int i = 0; i < 6; ++i) { __builtin_amdgcn_sched_group_barrier(0x008, 1, 0); __builtin_amdgcn_sched_group_barrier(0x400, 5, 0); }
    }
    asm volatile("" : "+v"(X0), "+v"(X1));
    if (HAS_NEXT) { att_kload(kf, knext); att_cinit<MODE>(Y0, Y1, cumk, kv0_next, hi, st.m_run, slope2, mw_next, qrow, band_next); }
    if (st.resc) {
#pragma unroll
        for (int g4 = 0; g4 < 4; ++g4) {
            const f32x4 fv = *(const LAS f32x4*)(wsf + 8 * g4 + 4 * hi);
#pragma unroll
            for (int i = 0; i < 4; ++i) { o[0][4 * g4 + i] *= fv[i]; o[1][4 * g4 + i] *= fv[i]; }
        }
        st.resc = false;
    }
}

template <int MODE>
__device__ __forceinline__ void attn_unit(const Params& p, int b, int h, int qb, LAS unsigned char* lds, bool do_scan) {
    int tid_ = threadIdx.x; asm volatile("" : "+v"(tid_)); const int tid = tid_, lane = tid & 63, r32 = lane & 31, hi = lane >> 5, wid = __builtin_amdgcn_readfirstlane(tid >> 6);
    const bf16_t* proj = (const bf16_t*)(p.ws + WS_PROJ);
    const int rowbase = b * SEQ, q0 = qb * 256;
    const int qcol = (MODE == 0 ? C_BQ : C_AQ) + h * 64;
    const int kcol = (MODE == 0 ? C_BK + h * 64 : C_AK + (h >> 2) * 64);
    const int vcol = (MODE == 0 ? C_BV + h * 64 : C_AV + (h >> 2) * 64);
    const int NT = (q0 + 256) / 64;
    LAS float* cumk = (LAS float*)(lds + AT_CUM);
    LAS float* wsf = (LAS float*)(lds + AT_WSF) + wid * 64;
    const float slope2 = (MODE == 1) ? exp2f(-(float)(h + 1)) * LOG2E : 0.f;
    const bf16_t* ksrc = proj + (size_t)(rowbase + lane) * NPROJ + kcol + wid * 8;
    const bf16_t* vsrc = proj + (size_t)(rowbase + 16 * (wid & 3) + (lane >> 2)) * NPROJ + vcol + (wid >> 2) * 32 + (lane & 3) * 8;
    const int stoff = wid * 1024 + lane * 16;
    const size_t tstride = (size_t)64 * NPROJ;
    const u32x4 k0 = *(const u32x4*)(ksrc + (size_t)(NT - 1) * tstride), k1 = *(const u32x4*)(ksrc + (size_t)(NT - 2) * tstride);
    const int qrow = q0 + wid * 32 + r32;
    bf16x8 qr[4];
    {
        const bf16_t* qp = proj + (size_t)(rowbase + qrow) * NPROJ + qcol + hi * 8;
#pragma unroll
        for (int d0 = 0; d0 < 4; ++d0) qr[d0] = *(const bf16x8*)(qp + d0 * 16);
    }
    const unsigned* mrow = (const unsigned*)(p.ws + WS_MASK) + (size_t)(rowbase + qrow) * 64;
    u32x2 mw0 = (u32x2){0u, 0u}; if (MODE == 1) mw0 = *(const u32x2*)(mrow + 2 * (NT - 1));
    if (MODE == 0 && do_scan) {
        const float* lf = (const float*)(p.ws + WS_LOGF);
        const int NK = q0 + 256;
        float v[4]; float run = 0.f;
#pragma unroll
        for (int i = 0; i < 4; ++i) { const int s = 4 * tid + i; const float x = (s < NK) ? lf[(size_t)(rowbase + s) * 8 + h] : 0.f; run += x; v[i] = run; }
        float inc = run;
#pragma unroll
        for (int o = 1; o < 64; o <<= 1) { const float t = __shfl_up(inc, o); if (lane >= o) inc += t; }
        LAS float* wt = (LAS float*)(lds + AT_WSF);
        if (lane == 63) wt[wid] = inc;
        __syncthreads();
        float pre = inc - run;
        for (int w = 0; w < wid; ++w) pre += wt[w];
#pragma unroll
        for (int i = 0; i < 4; ++i) cumk[4 * tid + i] = -(pre + v[i]) * LOG2E;
        __syncthreads();
    }
    *(LAS u32x4*)(lds + AT_K + stoff) = k0; *(LAS u32x4*)(lds + AT_K + 8192 + stoff) = k1;
    __syncthreads();
    AttState st; st.m_run = 0.f; st.l_run = 0.f; st.started = false; st.resc = false;
    f32x16 o[2]; o[0] = f32x16{}; o[1] = f32x16{};
    f32x16 A0, A1, B0, B1; A0 = f32x16{}; A1 = f32x16{}; B0 = f32x16{}; B1 = f32x16{};
    bf16x8 kf[8];
    const int wq_lo = q0 + wid * 32;
    const LAS unsigned char* kfrag = lds + AT_K + hi * 1024 + r32 * 16;
    const LAS unsigned char* vfrag = lds + AT_V + ((lane >> 4) & 1) * 32 + (lane & 3) * 8 + (4 * hi + ((lane & 15) >> 2)) * 64;
    {
        att_kload(kf, kfrag);
        att_cinit<MODE>(A0, A1, cumk, 64 * (NT - 1), hi, 0.f, slope2, mw0, qrow, true);
    }
    LDS_BARRIER();
#define ATT_ITER(U, FIRST_, NEXT_, DEAD_, X0, X1, Y0, Y1) do { const int u = (U); \
        int tk = NT - 3 - u; tk = tk < 0 ? 0 : tk; \
        const u32x4 kreg = *(const u32x4*)(ksrc + (size_t)tk * tstride); \
        const u32x4 vreg = *(const u32x4*)(vsrc + (size_t)(NT - 1 - u) * tstride); \
        int tn = NT - 2 - u; tn = tn < 0 ? 0 : tn; \
        u32x2 mwn = (u32x2){0u, 0u}; \
        if (MODE == 1) mwn = *(const u32x2*)(mrow + 2 * tn); \
        const LAS unsigned char* vprev = vfrag + ((u - 1) & 1) * 8192; \
        const LAS unsigned char* knext = kfrag + ((u + 1) & 1) * 8192; \
        att_step<MODE, FIRST_, NEXT_, DEAD_>(X0, X1, Y0, Y1, o, qr, kf, st, vprev, knext, 64 * tn, mwn, (64 * tn + 63 > wq_lo), cumk, wsf, r32, hi, slope2, qrow, (64 * (NT - 1 - u) > wq_lo + 31)); \
        *(LAS u32x4*)(lds + AT_K + (u & 1) * 8192 + stoff) = kreg; \
        *(LAS u32x4*)(lds + AT_V + (u & 1) * 8192 + stoff) = vreg; \
        LDS_BARRIER(); } while (0)
    ATT_ITER(0, true, true, true, A0, A1, B0, B1);
    for (int uu = 1; uu < NT - 1; uu += 2) {
        ATT_ITER(uu, false, true, false, B0, B1, A0, A1);
        ATT_ITER(uu + 1, false, true, false, A0, A1, B0, B1);
    }
    ATT_ITER(NT - 1, false, false, false, B0, B1, A0, A1);
#undef ATT_ITER
    {
        const f32x16 Y0 = B0, Y1 = B1;
        float s0 = 0.f, s1 = 0.f;
#pragma unroll
        for (int r = 0; r < 16; r += 2) { s0 += Y0[r] + Y1[r]; s1 += Y0[r + 1] + Y1[r + 1]; }
        st.l_run += s0 + s1;
        const LAS unsigned char* vprev = vfrag + ((NT - 1) & 1) * 8192;
#pragma unroll
        for (int s = 0; s < 4; ++s) {
            u32x4 w;
            if (s < 2) { w.x = pg8::cvt_pk_bf16(Y0[8 * s + 0], Y0[8 * s + 1]); w.y = pg8::cvt_pk_bf16(Y0[8 * s + 2], Y0[8 * s + 3]); w.z = pg8::cvt_pk_bf16(Y0[8 * s + 4], Y0[8 * s + 5]); w.w = pg8::cvt_pk_bf16(Y0[8 * s + 6], Y0[8 * s + 7]); }
            else { const int q = s - 2; w.x = pg8::cvt_pk_bf16(Y1[8 * q + 0], Y1[8 * q + 1]); w.y = pg8::cvt_pk_bf16(Y1[8 * q + 2], Y1[8 * q + 3]); w.z = pg8::cvt_pk_bf16(Y1[8 * q + 4], Y1[8 * q + 5]); w.w = pg8::cvt_pk_bf16(Y1[8 * q + 6], Y1[8 * q + 7]); }
            const bf16x8 pa = __builtin_bit_cast(bf16x8, w);
#pragma unroll
            for (int d0 = 0; d0 < 2; ++d0) {
                const v4i16_t lo = vtr(vprev + d0 * 4096 + s * 1024), hh = vtr(vprev + d0 * 4096 + s * 1024 + 512);
                const bf16x8 vf = (bf16x8){lo[0], lo[1], lo[2], lo[3], hh[0], hh[1], hh[2], hh[3]};
                o[d0] = __builtin_amdgcn_mfma_f32_32x32x16_bf16(pa, vf, o[d0], 0, 0, 0);
            }
        }
    }
    float l_run = st.l_run;
    l_run += __shfl_xor(l_run, 32);
    if (hi == 0) wsf[32 + r32] = l_run;
    float rli[16];
#pragma unroll
    for (int g4 = 0; g4 < 4; ++g4) {
        const f32x4 lv = *(const LAS f32x4*)(wsf + 32 + 8 * g4 + 4 * hi);
#pragma unroll
        for (int i = 0; i < 4; ++i) rli[4 * g4 + i] = __builtin_amdgcn_rcpf(lv[i]);
    }
    LAS bf16_t* stg = (LAS bf16_t*)(lds + AT_OST) + wid * 2048;
#pragma unroll
    for (int r = 0; r < 16; ++r) {
        const int orow = crow(r, hi);
#pragma unroll
        for (int d0 = 0; d0 < 2; ++d0) stg[orow * 64 + d0 * 32 + r32] = (bf16_t)f2bf(o[d0][r] * rli[r]);
    }
    bf16_t* O = (bf16_t*)(p.ws + WS_O);
    float* ssq = (float*)(p.ws + WS_SSQ);
    const int ocol = (MODE == 1 ? 0 : 512) + h * 64, slot = (MODE == 1 ? 0 : 8) + h;
#pragma unroll
    for (int i = 0; i < 4; ++i) {
        const int row = i * 8 + (lane >> 3), ch = lane & 7;
        const u32x4 v = *(const LAS u32x4*)(stg + row * 64 + ch * 8);
        const size_t grow = (size_t)(rowbase + q0 + wid * 32 + row);
        *(u32x4*)(O + grow * DM + ocol + ch * 8) = v;
        float q = 0.f;
#pragma unroll
        for (int j = 0; j < 4; ++j) { const float a = bf2f((unsigned short)(v[j] & 0xffff)), c = bf2f((unsigned short)(v[j] >> 16)); q += a * a + c * c; }
        q += __shfl_xor(q, 1); q += __shfl_xor(q, 2); q += __shfl_xor(q, 4);
        if (ch == 0) ssq[grow * 16 + slot] = q;
    }
    LDS_BARRIER();
}
constexpr int IX_SC = 0, IX_HIST = 131072, IX_CAND = 131072 + 2048, IX_END = 131072 + 4096;
#define IX_DPP(OP, ctrl, rm) v = OP(v, __builtin_bit_cast(float, __builtin_amdgcn_update_dpp(__builtin_bit_cast(int, v), __builtin_bit_cast(int, v), ctrl, rm, 0xf, false)))
__device__ __forceinline__ float wave_maxf(float v) {
    IX_DPP(fmaxf, 0x111, 0xf); IX_DPP(fmaxf, 0x112, 0xf); IX_DPP(fmaxf, 0x114, 0xf); IX_DPP(fmaxf, 0x118, 0xf); IX_DPP(fmaxf, 0x142, 0xa); IX_DPP(fmaxf, 0x143, 0xc);
    return __builtin_bit_cast(float, __builtin_amdgcn_readlane(__builtin_bit_cast(int, v), 63));
}
__device__ __forceinline__ float wave_minf(float v) {
    IX_DPP(fminf, 0x111, 0xf); IX_DPP(fminf, 0x112, 0xf); IX_DPP(fminf, 0x114, 0xf); IX_DPP(fminf, 0x118, 0xf); IX_DPP(fminf, 0x142, 0xa); IX_DPP(fminf, 0x143, 0xc);
    return __builtin_bit_cast(float, __builtin_amdgcn_readlane(__builtin_bit_cast(int, v), 63));
}
#undef IX_DPP
struct IxOps { bf16x8 aq[2][4]; bf16x8 kf[2][4]; };
__device__ __forceinline__ void ix_prefetch(IxOps& X, const bf16_t* proj, const unsigned char* ikf, int rowbase, int t0, int wid, int r32, int hi) {
    const int i = r32, qi = 2 * ((i >> 2) & 1) + (i >> 4), head = 4 * ((i >> 3) & 1) + (i & 3);
#pragma unroll
    for (int g = 0; g < 2; ++g) {
        const bf16_t* ap = proj + (size_t)(rowbase + t0 + 4 * g + qi) * NPROJ + C_IQ + head * 64 + hi * 8;
#pragma unroll
        for (int d0 = 0; d0 < 4; ++d0) X.aq[g][d0] = *(const bf16x8*)(ap + d0 * 16);
    }
    const int NTI = (t0 + 7) / 32 + 1;
#pragma unroll
    for (int q = 0; q < 2; ++q) {
        const int j = wid + 8 * q;
        if (j < NTI) {
            const unsigned char* kp = ikf + ((size_t)((rowbase >> 5) + j) << 12) + r32 * 32 + hi * 16;
#pragma unroll
            for (int d0 = 0; d0 < 4; ++d0) X.kf[q][d0] = *(const bf16x8*)(kp + d0 * 1024);
        }
    }
}
__device__ __forceinline__ void ix_tile(const bf16x8 (&aq)[2][4], const bf16x8 (&kf)[4], const float (&wq)[2][2][8], LAS float* sc, int key, int hi) {
#pragma unroll
    for (int g = 0; g < 2; ++g) {
        f32x16 d = f32x16{};
#pragma unroll
        for (int d0 = 0; d0 < 4; ++d0) d = __builtin_amdgcn_mfma_f32_32x32x16_bf16(aq[g][d0], kf[d0], d, 0, 0, 0);
#pragma unroll
        for (int a = 0; a < 2; ++a) {
            float sv = 0.f;
#pragma unroll
            for (int hh = 0; hh < 8; ++hh) { const float dv = d[8 * a + hh]; const int db = __builtin_bit_cast(int, dv); sv += wq[g][a][hh] * __builtin_bit_cast(float, db > 0 ? db : 0); }
            sc[(4 * g + 2 * hi + a) * 2048 + key] = sv;
        }
    }
}
__device__ __forceinline__ void ix_score(const IxOps& X, const Params& p, int rowbase, int t0, LAS float* sc, int wid, int r32, int hi) {
    const unsigned char* ikf = p.ws + WS_IKF;
    const float* iwp = (const float*)(p.ws + WS_IW);
    const int NTI = (t0 + 7) / 32 + 1;
    float wq[2][2][8];
#pragma unroll
    for (int g = 0; g < 2; ++g)
#pragma unroll
        for (int a = 0; a < 2; ++a) {
            const float* wp = iwp + (size_t)(rowbase + t0 + 4 * g + 2 * hi + a) * 8;
            const f32x4 w0 = *(const f32x4*)wp, w1 = *(const f32x4*)(wp + 4);
#pragma unroll
            for (int j = 0; j < 4; ++j) { wq[g][a][j] = w0[j]; wq[g][a][4 + j] = w1[j]; }
        }
    bf16x8 cur[2][4], nxt[2][4];
#pragma unroll
    for (int q = 0; q < 2; ++q)
#pragma unroll
        for (int d0 = 0; d0 < 4; ++d0) { cur[q][d0] = X.kf[q][d0]; nxt[q][d0] = X.kf[q][d0]; }
#pragma unroll 1
    for (int bb = 0; bb < 4; ++bb) {
        if (wid + 16 * bb >= NTI) break;
#pragma unroll
        for (int q = 0; q < 2; ++q) {
            const int j = wid + 16 * (bb + 1) + 8 * q;
            if (bb < 3 && j < NTI) {
                const unsigned char* kp = ikf + ((size_t)((rowbase >> 5) + j) << 12) + r32 * 32 + hi * 16;
#pragma unroll
                for (int d0 = 0; d0 < 4; ++d0) nxt[q][d0] = *(const bf16x8*)(kp + d0 * 1024);
            }
        }
#pragma unroll
        for (int q = 0; q < 2; ++q) { const int j = wid + 16 * bb + 8 * q; if (j < NTI) ix_tile(X.aq, cur[q], wq, sc, 32 * j + r32, hi); }
#pragma unroll
        for (int q = 0; q < 2; ++q)
#pragma unroll
            for (int d0 = 0; d0 < 4; ++d0) cur[q][d0] = nxt[q][d0];
    }
}

template <int NR>
__device__ __forceinline__ int ix_count_ge(const float (&val)[NR], float piv, unsigned& accw) {
    unsigned acc = 0u;
    f32x2 pp; pp.x = piv; pp.y = piv;
#pragma unroll
    for (int i = 0; i < NR; i += 2) {
        f32x2 a; a.x = val[i]; a.y = val[i + 1];
        const f32x2 d = a - pp; const float dx = d.x, dy = d.y;
        acc = __builtin_amdgcn_alignbit(acc, __builtin_bit_cast(unsigned, dx), 31);
        acc = __builtin_amdgcn_alignbit(acc, __builtin_bit_cast(unsigned, dy), 31);
    }
    accw = acc;
    int t = NR - __popc(acc);
    asm volatile("s_nop 1\n\tv_add_u32_dpp %0, %0, %0 row_shr:1 row_mask:0xf bank_mask:0xf\n\t"
                 "s_nop 1\n\tv_add_u32_dpp %0, %0, %0 row_shr:2 row_mask:0xf bank_mask:0xf\n\t"
                 "s_nop 1\n\tv_add_u32_dpp %0, %0, %0 row_shr:4 row_mask:0xf bank_mask:0xf\n\t"
                 "s_nop 1\n\tv_add_u32_dpp %0, %0, %0 row_shr:8 row_mask:0xf bank_mask:0xf\n\t"
                 "s_nop 1\n\tv_add_u32_dpp %0, %0, %0 row_bcast:15 row_mask:0xa bank_mask:0xf\n\t"
                 "s_nop 1\n\tv_add_u32_dpp %0, %0, %0 row_bcast:31 row_mask:0xc bank_mask:0xf\n\t"
                 "s_nop 1" : "+v"(t));
    return __builtin_amdgcn_readlane(t, 63);
}
template <int NR>
__device__ __forceinline__ void ix_select_impl(const LAS float* myv, LAS unsigned* hist, LAS float* cand, unsigned* mrow, int n, int lane) {
    float val[NR];
#pragma unroll
    for (int i = 0; i < NR; ++i) { const int key = 64 * i + lane; const float x = myv[key]; val[i] = (key < n) ? x : -INFINITY; }
    float vmax = -INFINITY, vmin = INFINITY;
#pragma unroll
    for (int i = 0; i < NR; ++i) { vmax = fmaxf(vmax, val[i]); vmin = fminf(vmin, (val[i] == -INFINITY) ? INFINITY : val[i]); }
    float lo = wave_minf(vmin); const float top0 = wave_maxf(vmax);
    float ub = INFINITY;
    const int k = 256;
    int cge_lo = n, cge_ub = 0;
    const int nv = (n - lane + 63) >> 6;
    unsigned acc_lo = (1u << (NR - nv)) - 1u, acc_ub = (NR == 32) ? 0xffffffffu : ((1u << (NR & 31)) - 1u);
    float vstar = lo; int rprime = k; bool ties = true;
    const unsigned long long ltmask = (lane == 0) ? 0ull : (~0ull >> (64 - lane));
#pragma unroll 1
    for (int iter = 0; iter < 200; ++iter) {
        const int c = cge_lo - cge_ub;
        if (c <= 64) {
            const int kr = k - cge_ub;
            unsigned B = ~acc_lo & acc_ub;
            const int pc = __popc(B);
            int slot = 0;
#pragma unroll
            for (int b = 0; b < 6; ++b) {
                const unsigned long long bm = __ballot((pc >> b) & 1);
                slot += (int)__builtin_amdgcn_mbcnt_hi((unsigned)(bm >> 32), __builtin_amdgcn_mbcnt_lo((unsigned)bm, 0u)) << b;
            }
            cand[lane] = -INFINITY;
            while (__any(B != 0u)) {
                if (B != 0u) { const int j = __ffs((int)B) - 1; cand[slot] = myv[64 * (NR - 1 - j) + lane]; ++slot; B &= B - 1u; }
            }
            const float mine = cand[lane];
            int gt = 0, ge = 0;
#pragma unroll 1
            for (int jj = 0; jj < c; jj += 16) {
                f32x4 x[4];
#pragma unroll
                for (int q = 0; q < 4; ++q) x[q] = *(const LAS f32x4*)(cand + jj + 4 * q);
#pragma unroll
                for (int q = 0; q < 4; ++q)
#pragma unroll
                    for (int e = 0; e < 4; ++e) { gt += (x[q][e] > mine) ? 1 : 0; ge += (x[q][e] >= mine) ? 1 : 0; }
            }
            const bool ok = (lane < c) && (gt < kr) && (kr <= ge);
            const unsigned long long om = __ballot(ok);
            const int L2 = om ? (__ffsll((long long)om) - 1) : 0;
            vstar = __builtin_bit_cast(float, __builtin_amdgcn_readlane(__builtin_bit_cast(int, mine), L2));
            const int gtl = __builtin_amdgcn_readlane(gt, L2), gel = __builtin_amdgcn_readlane(ge, L2);
            rprime = kr - gtl; ties = (gel - gtl) != rprime;
            break;
        }
        const float top = (ub == INFINITY) ? top0 : ub;
        const float mid = lo + (top - lo) * 0.5f;
        if (!(mid > lo) || !(mid < top)) {
            unsigned dummy;
            if (ub == INFINITY && top0 > lo) {
                const int m = ix_count_ge<NR>(val, top0, dummy);
                if (m >= k) { vstar = top0; rprime = k; } else { vstar = lo; rprime = k - m; }
            } else { vstar = lo; rprime = k - cge_ub; }
            ties = true;
            break;
        }
        unsigned aw;
        const int cnt = ix_count_ge<NR>(val, mid, aw);
        if (cnt >= k) { lo = mid; cge_lo = cnt; acc_lo = aw; } else { ub = mid; cge_ub = cnt; acc_ub = aw; }
    }
    LAS unsigned long long* mw = (LAS unsigned long long*)hist;
    unsigned wlo = 0u, whi = 0u;
    if (!ties) {
#define IX_WL(i) if (i < NR) { const unsigned long long sm = __ballot(val[i < NR ? i : 0] >= vstar); \
            asm volatile("s_nop 1\n\tv_writelane_b32 %0, %1, " #i : "+v"(wlo) : "s"((unsigned)sm)); asm volatile("v_writelane_b32 %0, %1, " #i : "+v"(whi) : "s"((unsigned)(sm >> 32))); }
        IX_WL(0) IX_WL(1) IX_WL(2) IX_WL(3) IX_WL(4) IX_WL(5) IX_WL(6) IX_WL(7) IX_WL(8) IX_WL(9) IX_WL(10) IX_WL(11) IX_WL(12) IX_WL(13) IX_WL(14) IX_WL(15)
        IX_WL(16) IX_WL(17) IX_WL(18) IX_WL(19) IX_WL(20) IX_WL(21) IX_WL(22) IX_WL(23) IX_WL(24) IX_WL(25) IX_WL(26) IX_WL(27) IX_WL(28) IX_WL(29) IX_WL(30) IX_WL(31)
#undef IX_WL
    } else {
        int run = 0;
#pragma unroll
        for (int i = 0; i < NR; ++i) {
            const float v = val[i];
            const bool eq = (v == vstar);
            const unsigned long long em = __ballot(eq);
            const bool sel = (v > vstar) || (eq && (run + __popcll(em & ltmask)) < rprime);
            run += __popcll(em);
            const unsigned long long sm = __ballot(sel);
            if (lane == 0) mw[i] = sm;
        }
    }
    if (ties && lane < NR) { const unsigned long long w = mw[lane < NR ? lane : 0]; wlo = (unsigned)w; whi = (unsigned)(w >> 32); }
    if (lane < 32) *(unsigned long long*)(mrow + 2 * lane) = ((unsigned long long)whi << 32) | wlo;
}
__device__ __forceinline__ void ix_select(const LAS float* myv, LAS unsigned* hist, LAS float* cand, unsigned* mrow, int n, int lane) {
    const int nact = (n + 63) >> 6;
    if (nact <= 8) ix_select_impl<8>(myv, hist, cand, mrow, n, lane);
    else if (nact <= 16) ix_select_impl<16>(myv, hist, cand, mrow, n, lane);
    else if (nact <= 24) ix_select_impl<24>(myv, hist, cand, mrow, n, lane);
    else ix_select_impl<32>(myv, hist, cand, mrow, n, lane);
}

__device__ __forceinline__ int ix_unit_t0(int i, int j) { return 8 * (32 + 32 * i + ((i & 1) ? 31 - j : j)); }
__device__ __forceinline__ void indexer_wg(const Params& p, int b, int j, LAS unsigned char* lds) {
    int tid_ = threadIdx.x; asm volatile("" : "+v"(tid_)); const int tid = tid_, lane = tid & 63, r32 = lane & 31, hi = lane >> 5, wid = __builtin_amdgcn_readfirstlane(tid >> 6);
    const bf16_t* proj = (const bf16_t*)(p.ws + WS_PROJ);
    const int rowbase = b * SEQ;
    LAS unsigned* hist = (LAS unsigned*)(lds + IX_HIST) + wid * 64;
    LAS float* cand = (LAS float*)(lds + IX_CAND) + wid * 64;
    IxOps X;
    ix_prefetch(X, proj, p.ws + WS_IKF, rowbase, ix_unit_t0(6, j), wid, r32, hi);
    const int xstride = (int)gridDim.x * 8; int xr = (int)blockIdx.x * 8 + wid; int xleft = 7;
    for (int i = 6; i >= 0; --i) {
        const int t0 = ix_unit_t0(i, j);
        LAS float* sc = (LAS float*)(lds + IX_SC) + (i & 1) * (8 * 2048);
        LAS float* sco = (LAS float*)(lds + IX_SC) + ((i + 1) & 1) * (8 * 2048);
        const bool xi = (xleft > 0) && (xr < NXITEMS);
        const TItem xt = txitem(p, xi ? xr : 0);
        if (xi) titem_dma_issue(xt, lane, sco + wid * 2048);
        ix_score(X, p, rowbase, t0, sc, wid, r32, hi);
        if (xi) { asm volatile("s_waitcnt vmcnt(0)" ::: "memory"); titem_dma_finish(xt, lane, sco + wid * 2048); xr += xstride; --xleft; }
        LDS_BARRIER();
        if (i > 0) ix_prefetch(X, proj, p.ws + WS_IKF, rowbase, ix_unit_t0(i - 1, j), wid, r32, hi);
        const int t = t0 + wid;
        ix_select(sc + wid * 2048, hist, cand, (unsigned*)(p.ws + WS_MASK) + (size_t)(rowbase + t) * 64, t + 1, lane);
    }
    __syncthreads();
}

__device__ __forceinline__ void trivial_mask_rows(const Params& p) {
    unsigned* mask = (unsigned*)(p.ws + WS_MASK);
    const int G = gridDim.x;
    for (int i = blockIdx.x * 512 + threadIdx.x; i < BATCH * 256 * 64; i += G * 512) {
        const int w = i & 63, t = (i >> 6) & 255, b = i >> 14;
        unsigned v;
        if (32 * w + 31 <= t) v = 0xffffffffu; else if (32 * w > t) v = 0u; else v = (1u << (t - 32 * w + 1)) - 1u;
        mask[(size_t)(b * SEQ + t) * 64 + w] = v;
    }
}
constexpr int RT_LG = 0;
constexpr int RT_CNT = 98304;
struct RtStage { f32x4 aa, ab, ca, cb; bf16x8 fh[3], fl[3]; };
__device__ __forceinline__ void rt_load(RtStage& S, const float* ma, const float* mc, const bf16_t* bh, const bf16_t* bl, int k) {
    S.aa = *(const f32x4*)(ma + k); S.ab = *(const f32x4*)(ma + k + 4); S.ca = *(const f32x4*)(mc + k); S.cb = *(const f32x4*)(mc + k + 4);
#pragma unroll
    for (int nb = 0; nb < 3; ++nb) { S.fh[nb] = *(const bf16x8*)(bh + (size_t)nb * 16 * 1024 + k); S.fl[nb] = *(const bf16x8*)(bl + (size_t)nb * 16 * 1024 + k); }
}
__device__ __forceinline__ void router_phase(const Params& p, LAS unsigned char* lds) {
    int tid_ = threadIdx.x; asm volatile("" : "+v"(tid_)); const int tid = tid_, lane = tid & 63, wid = __builtin_amdgcn_readfirstlane(tid >> 6), G = gridDim.x;
    const float* x1 = p.out; const float* x1ssq = (const float*)(p.ws + WS_X1SSQ); const float* mod2 = (const float*)(p.ws + WS_MOD2);
    bf16_t* H2 = (bf16_t*)(p.ws + WS_H);
    const bf16_t* wrh = (const bf16_t*)(p.ws + WS_WR); const bf16_t* wrl = wrh + 48 * 1024;
    unsigned* cnt = (unsigned*)(p.ws + WS_CNT); int* list = (int*)(p.ws + WS_LIST); float* rws = (float*)(p.ws + WS_RWS);
    const int iters = (NTOK / 64 + G - 1) / G;
    for (int it = 0; it < iters; ++it) {
        int ln_ = lane; asm volatile("" : "+v"(ln_)); const int row = ln_ & 15, kq = ln_ >> 4;
        const int wu = it * G + blockIdx.x;
        const bool active = wu < NTOK / 64;
        if (active) {
            const int tok0 = 64 * wu, b = tok0 >> 11, kw = 128 * wid + 8 * kq;
            const bf16_t* xr = (const bf16_t*)x1 + (size_t)(tok0 + row) * (2 * DM) + kw;
            u32x4 xs[4][4];
#pragma unroll
            for (int s = 0; s < 4; ++s)
#pragma unroll
                for (int tb = 0; tb < 4; ++tb) xs[s][tb] = __builtin_nontemporal_load((const u32x4*)(xr + (size_t)tb * 16 * 2 * DM + 32 * s));
            float rstd[4];
#pragma unroll
            for (int tb = 0; tb < 4; ++tb) {
                const f32x4 a = *((const f32x4*)(x1ssq + (size_t)(tok0 + 16 * tb + row) * 16) + kq);
                float q = (a[0] + a[1]) + (a[2] + a[3]);
                q += __shfl_xor(q, 16); q += __shfl_xor(q, 32);
                rstd[tb] = __builtin_amdgcn_rsqf(q * (1.f / DM) + EPS);
            }
            f32x4 acc[4][3];
#pragma unroll
            for (int tb = 0; tb < 4; ++tb) { acc[tb][0] = f32x4{}; acc[tb][1] = f32x4{}; acc[tb][2] = f32x4{}; }
            const float* ma = mod2 + (size_t)(b * 2) * 1024 + kw; const float* mc = ma + 1024;
            const bf16_t* bh = wrh + (size_t)row * 1024 + kw; const bf16_t* bl = wrl + (size_t)row * 1024 + kw;
            RtStage S0, S1;
            rt_load(S0, ma, mc, bh, bl, 0);
#pragma unroll
            for (int s = 0; s < 4; ++s) {
                const int k = 32 * s;
                if (s + 1 < 4) rt_load(S1, ma, mc, bh, bl, k + 32);
#pragma unroll
                for (int tb = 0; tb < 4; ++tb) {
                    const u32x4 xw = xs[s][tb];
                    const f32x4 xa = (f32x4){__builtin_bit_cast(float, xw.x << 16), __builtin_bit_cast(float, xw.x & 0xffff0000u), __builtin_bit_cast(float, xw.y << 16), __builtin_bit_cast(float, xw.y & 0xffff0000u)};
                    const f32x4 xb = (f32x4){__builtin_bit_cast(float, xw.z << 16), __builtin_bit_cast(float, xw.z & 0xffff0000u), __builtin_bit_cast(float, xw.w << 16), __builtin_bit_cast(float, xw.w & 0xffff0000u)};
                    const f32x4 ha = xa * rstd[tb] * S0.aa + S0.ca, hb = xb * rstd[tb] * S0.ab + S0.cb;
                    u32x4 w; w.x = pg8::cvt_pk_bf16(ha[0], ha[1]); w.y = pg8::cvt_pk_bf16(ha[2], ha[3]); w.z = pg8::cvt_pk_bf16(hb[0], hb[1]); w.w = pg8::cvt_pk_bf16(hb[2], hb[3]);
                    *(u32x4*)(H2 + (size_t)(tok0 + 16 * tb + row) * DM + kw + k) = w;
                    const bf16x8 af = __builtin_bit_cast(bf16x8, w);
                    u32x4 wl;
                    wl.x = pg8::cvt_pk_bf16(ha[0] - __builtin_bit_cast(float, w.x << 16), ha[1] - __builtin_bit_cast(float, w.x & 0xffff0000u));
                    wl.y = pg8::cvt_pk_bf16(ha[2] - __builtin_bit_cast(float, w.y << 16), ha[3] - __builtin_bit_cast(float, w.y & 0xffff0000u));
                    wl.z = pg8::cvt_pk_bf16(hb[0] - __builtin_bit_cast(float, w.z << 16), hb[1] - __builtin_bit_cast(float, w.z & 0xffff0000u));
                    wl.w = pg8::cvt_pk_bf16(hb[2] - __builtin_bit_cast(float, w.w << 16), hb[3] - __builtin_bit_cast(float, w.w & 0xffff0000u));
                    const bf16x8 al = __builtin_bit_cast(bf16x8, wl);
#pragma unroll
                    for (int nb = 0; nb < 3; ++nb) {
                        acc[tb][nb] = __builtin_amdgcn_mfma_f32_16x16x32_bf16(af, S0.fh[nb], acc[tb][nb], 0, 0, 0);
                        acc[tb][nb] = __builtin_amdgcn_mfma_f32_16x16x32_bf16(af, S0.fl[nb], acc[tb][nb], 0, 0, 0);
                        acc[tb][nb] = __builtin_amdgcn_mfma_f32_16x16x32_bf16(al, S0.fh[nb], acc[tb][nb], 0, 0, 0);
                    }
                }
                S0 = S1;
            }
#pragma unroll
            for (int tb = 0; tb < 4; ++tb) {
                LAS float* lg = (LAS float*)(lds + RT_LG) + (wid * 4 + tb) * 768;
#pragma unroll
                for (int nb = 0; nb < 3; ++nb)
#pragma unroll
                    for (int i = 0; i < 4; ++i) lg[(4 * kq + i) * 48 + 16 * nb + row] = acc[tb][nb][i];
            }
        }
        LDS_BARRIER();
        LAS unsigned* lcnt = (LAS unsigned*)(lds + RT_CNT);
        if (tid < 64) lcnt[tid] = 0u;
        LDS_BARRIER();
        int ea = 0, eb = 0, tk = 0; unsigned la = 0, lb = 0; float w1 = 0.f, w2 = 0.f; bool act = false;
        if (wid == 0) {
            const int pr = lane >> 4, tl = lane & 15;
            act = active;
            if (act) {
                const LAS float* l0 = (const LAS float*)(lds + RT_LG) + pr * 768 + tl * 48;
                tk = 64 * wu + 16 * pr + tl;
                float gl[4]; int gs = 0; float gmax;
#pragma unroll
                for (int j = 0; j < 4; ++j) { float s = p.b_group[j];
#pragma unroll
                    for (int w8 = 0; w8 < 8; ++w8) s += l0[w8 * 3072 + j];
                    gl[j] = s; }
                gmax = gl[0];
#pragma unroll
                for (int j = 1; j < 4; ++j) if (gl[j] > gmax) { gmax = gl[j]; gs = j; }
                float den = 0.f;
#pragma unroll
                for (int j = 0; j < 4; ++j) den += __expf(gl[j] - gmax);
                const float pg = 1.f / den;
                float v1 = -INFINITY, v2 = -INFINITY; int i1 = 0, i2 = 0;
                float evs[8];
                { const f32x4 b0 = *(const f32x4*)(p.b_router + gs * 8), b1 = *(const f32x4*)(p.b_router + gs * 8 + 4);
#pragma unroll
                  for (int j = 0; j < 4; ++j) { evs[j] = b0[j]; evs[4 + j] = b1[j]; } }
#pragma unroll
                for (int j = 0; j < 8; ++j) {
#pragma unroll
                    for (int w8 = 0; w8 < 8; ++w8) evs[j] += l0[w8 * 3072 + 16 + 8 * gs + j];
                }
#pragma unroll
                for (int j = 0; j < 8; ++j) {
                    const float ev = evs[j];
                    if (ev > v1) { v2 = v1; i2 = i1; v1 = ev; i1 = j; } else if (ev > v2) { v2 = ev; i2 = j; }
                }
                const float e2 = __expf(v2 - v1);
                w1 = pg / (1.f + e2); w2 = pg * e2 / (1.f + e2);
                ea = gs * 8 + i1; eb = gs * 8 + i2;
                la = __hip_atomic_fetch_add(lcnt + ea, 1u, __ATOMIC_RELAXED, __HIP_MEMORY_SCOPE_WORKGROUP);
                lb = __hip_atomic_fetch_add(lcnt + eb, 1u, __ATOMIC_RELAXED, __HIP_MEMORY_SCOPE_WORKGROUP);
            }
            int ln2 = lane; asm volatile("" : "+v"(ln2));
            if (ln2 < 32) { const unsigned c = lcnt[ln2]; unsigned base = 0u; if (c) base = atomicAdd(cnt + ln2 * 64, c); lcnt[32 + ln2] = base; }
            if (act) {
                const unsigned sa = lcnt[32 + ea] + la, sb = lcnt[32 + eb] + lb;
                list[ea * 16384 + sa] = tk * 2; list[eb * 16384 + sb] = tk * 2 + 1;
                rws[ea * 16384 + sa] = w1; rws[eb * 16384 + sb] = w2;
            }
        }
        LDS_BARRIER();
    }
}
constexpr int MISC_OFF = LDS_BYTES - 64;
__device__ __forceinline__ int vb_of(LAS unsigned char* lds) { return __builtin_amdgcn_readfirstlane(((volatile LAS int*)(lds + MISC_OFF))[4]); }
__device__ __forceinline__ int vcu_of(LAS unsigned char* lds) { return __builtin_amdgcn_readfirstlane(((volatile LAS int*)(lds + MISC_OFF))[5]); }
__device__ __forceinline__ void phase1_inproj(const Params& p, LAS unsigned char* lds) {
    pg8::Gemm g{(const bf16_t*)(p.ws + WS_H), (const bf16_t*)(p.ws + WS_WIN), 1024};
    pg8::StaticOrder S; S.init(NTOK, NPROJ, 1024, gridDim.x, vb_of(lds));
    EpiProj E{(bf16_t*)(p.ws + WS_PROJ), (float*)(p.ws + WS_IW), (float*)(p.ws + WS_LOGF), p.b_forget, p.ws + WS_IKF};
    pg8::gemm_phase<EpiProj, pg8::StaticOrder, false>(lds, g, S, E);
}
template <int MODE> __device__ __forceinline__ void attn_phase(const Params& p, LAS unsigned char* lds) {
    const int G = gridDim.x;
    for (int v = vcu_of(lds); v < 256; v += G) {
        const int bh = v >> 2, s = v & 3;
        attn_unit<MODE>(p, bh >> 3, bh & 7, 7 - s, lds, true);
        attn_unit<MODE>(p, bh >> 3, bh & 7, s, lds, false);
    }
}
__device__ __forceinline__ void indexer_phase(const Params& p, LAS unsigned char* lds) {
    const int G = gridDim.x;
    for (int v = vcu_of(lds); v < 256; v += G) indexer_wg(p, v >> 5, v & 31, lds);
    {
        __syncthreads();
        int tid_ = threadIdx.x; asm volatile("" : "+v"(tid_)); const int lane = tid_ & 63, wave = tid_ >> 6;
        LAS float* scr = (LAS float*)(lds + wave * 8704);
        const int done = (vcu_of(lds) < 256) ? 7 : 0;
        float tv[32];
        for (int xr = ((done * G + (int)blockIdx.x) * 8 + wave); xr < NXITEMS; xr += G * 8) { const TItem t = txitem(p, xr); titem_load(t, lane, tv); titem_store(t, lane, tv, scr); }
    }
    trivial_mask_rows(p);
}
__device__ __forceinline__ void phase4_outproj(const Params& p, LAS unsigned char* lds) {
    pg8::Gemm g{(const bf16_t*)(p.ws + WS_O), (const bf16_t*)(p.ws + WS_WOUT), 1024};
    pg8::StaticOrder S; S.init(NTOK, DM, 1024, gridDim.x, vb_of(lds));
    EpiOut E{p.x, p.out, (const float*)(p.ws + WS_MOD), (const float*)(p.ws + WS_SSQ), (float*)(p.ws + WS_X1SSQ)};
    pg8::gemm_phase<EpiOut, pg8::StaticOrder, false>(lds, g, S, E);
}
__device__ __forceinline__ void phase_moe(const Params& p, LAS unsigned char* lds) {
    LAS int* tab = (LAS int*)(lds + MOE_TAB_OFF); moe_order_setup((const unsigned*)(p.ws + WS_CNT), tab);
    unsigned* flags = (unsigned*)(p.ws + WS_TFLAG);
    const int G = gridDim.x, c = vb_of(lds), cx = vcu_of(lds);
    {
        pg8::Gemm g{(const bf16_t*)(p.ws + WS_H), (const bf16_t*)(p.ws + WS_WGU), 1024};
        MoeOrder S{tab, (const int*)(p.ws + WS_LIST), flags, 2, G, c, 0, (size_t)512 * 1024 * 2, (size_t)256 * 1024 * 2, true, 0, cx};
        EpiAct E{(bf16_t*)(p.ws + WS_ACT), (const float*)(p.ws + WS_RWS)};
        pg8::gemm_phase<EpiAct, MoeOrder, true>(lds, g, S, E);
    }
    {
        const int T = __builtin_amdgcn_readfirstlane(tab[64]);
        const int n2 = (2 * T > G && 2 * T < 2 * G) ? 2 * T - G : 0;
        const int x_ = c & 7, r_ = c >> 3, G8 = G >> 3;
        int lidx = 0;
        for (int xx = 0; xx < 8; ++xx) { const int hx = (n2 > xx) ? (n2 - xx + 7) >> 3 : 0; if (xx < x_) lidx += G8 - hx; else if (xx == x_) lidx += r_ - hx; }
        const int cl = ((G & 7) == 0) ? lidx : c - n2;
        pg8::Gemm g{(const bf16_t*)(p.ws + WS_ACT), (const bf16_t*)(p.ws + WS_WD), 256};
        MoeOrder S{tab, (const int*)(p.ws + WS_LIST), flags, 4, G - n2, cl, (size_t)256 * 256 * 2, (size_t)1024 * 256 * 2, (size_t)256 * 256 * 2, false, 1, cl};
        EpiDown E{(bf16_t*)(p.ws + WS_Y), (const int*)(p.ws + WS_LIST)};
        if (c >= n2) pg8::gemm_phase<EpiDown, MoeOrder, false>(lds, g, S, E);
    }
}

__global__ void __launch_bounds__(512, 2) mega(Params p) {
    extern __shared__ __attribute__((aligned(16))) unsigned char lds_raw[];
    LAS unsigned char* lds = (LAS unsigned char*)lds_raw;
    cg::grid_group grid = cg::this_grid();
    if (p.ws == nullptr) grid.sync();
    volatile LAS unsigned* st = (volatile LAS unsigned*)(lds + LDS_BYTES - 64);
    if (threadIdx.x < 4) st[threadIdx.x] = 0u;
    __syncthreads();
    const XcdBarrier bar = xcd_barrier_post((unsigned*)(p.ws + WS_BAR), st);
#define GSYNC() xcd_barrier(bar)
#ifndef REP_MASK
#define REP_MASK 0
#endif
#ifndef TPROBE
#define TPROBE -1
#endif
    unsigned long long tp0_ = 0; (void)tp0_;
#define PH_BEGIN(i) do { if (TPROBE == (i) || (TPROBE == 10 && (i) == 0)) tp0_ = __builtin_amdgcn_s_memrealtime(); } while (0)
#define PH_END(i) do { if (TPROBE == (i)) { if (threadIdx.x == 0) { const unsigned long long t1_ = __builtin_amdgcn_s_memrealtime(); const unsigned long long d_ = t1_ - tp0_; \
        while (__builtin_amdgcn_s_memrealtime() - t1_ < d_) __builtin_amdgcn_s_sleep(8); } __syncthreads(); } } while (0)
    PH_BEGIN(0);
    f32x4 vx0[8][4];
    phase0(p, lds, vx0);
    if (TPROBE == 10) { if (threadIdx.x == 0) { const unsigned long long t1_ = __builtin_amdgcn_s_memrealtime(); const unsigned long long d_ = t1_ - tp0_; while (__builtin_amdgcn_s_memrealtime() - t1_ < d_) __builtin_amdgcn_s_sleep(8); } __syncthreads(); }
    phase0b(p, vx0);
    xcd_barrier_census(bar);
    GSYNC(); PH_END(0); PH_BEGIN(2);
    {
        volatile LAS int* mi = (volatile LAS int*)(lds + MISC_OFF);
        if (threadIdx.x < 64) {
            const int G = gridDim.x; unsigned* bw = (unsigned*)(p.ws + WS_BAR);
            const int jx = (int)threadIdx.x & 15;
            const unsigned cx = xb_ld(&bw[XB_XCNT(jx)]);
            const bool okj = (jx < 8) ? (cx == (unsigned)(G / 8)) : (cx == 0u);
            const bool uni = (G % 8 == 0) && (__ballot(okj) == ~0ull);
            if (threadIdx.x == 0) {
                const int rank = mi[2], x = (int)bar.x, bx = blockIdx.x;
                mi[4] = uni ? rank * 8 + x : bx;
                mi[5] = uni ? x * (G / 8) + rank : ((G % 8 == 0) ? (bx % 8) * (G / 8) + bx / 8 : bx);
            }
        }
        __syncthreads();
    }
    phase1_inproj(p, lds);
#if (REP_MASK) & 4
    phase1_inproj(p, lds);
#endif
    GSYNC(); PH_END(2); PH_BEGIN(3);
    attn_phase<0>(p, lds);
#if (REP_MASK) & 8
    attn_phase<0>(p, lds);
#endif
    indexer_phase(p, lds);
#if (REP_MASK) & 16
    indexer_phase(p, lds);
#endif
    GSYNC(); PH_END(3); PH_BEGIN(4);
    attn_phase<1>(p, lds);
#if (REP_MASK) & 32
    attn_phase<1>(p, lds);
#endif
    GSYNC(); PH_END(4); PH_BEGIN(5);
    phase4_outproj(p, lds);
#if (REP_MASK) & 64
    phase4_outproj(p, lds);
#endif
    GSYNC(); PH_END(5); PH_BEGIN(6);
    router_phase(p, lds);
    GSYNC(); PH_END(6); PH_BEGIN(7);
    phase_moe(p, lds);
    GSYNC(); PH_END(7); PH_BEGIN(9);
    phase_final(p, false);
    if (TPROBE == 9) { asm volatile("s_waitcnt vmcnt(0)" ::: "memory"); __syncthreads(); } PH_END(9);
}

extern "C" void kernel_launch(void* const* d_in, const int* in_sizes, int n_in, void* d_out, int out_size, void* d_ws, size_t ws_size, hipStream_t stream) {
    static int grid = 0;
    if (grid == 0) {
        if (n_in != 19 || out_size != NTOK * DM || ws_size < WS_END) { fprintf(stderr, "kernel_launch: unexpected problem (n_in %d out %d ws %zu)\n", n_in, out_size, ws_size); grid = -1; return; }
        int dev = 0, cus = 0, per_cu = 0;
        (void)hipGetDevice(&dev);
        (void)hipDeviceGetAttribute(&cus, hipDeviceAttributeMultiprocessorCount, dev);
        (void)hipFuncSetAttribute((const void*)mega, hipFuncAttributeMaxDynamicSharedMemorySize, LDS_BYTES);
        (void)hipOccupancyMaxActiveBlocksPerMultiprocessor(&per_cu, (const void*)mega, 512, LDS_BYTES);
        if (per_cu < 1) { fprintf(stderr, "kernel_launch: occupancy query says %d blocks per CU\n", per_cu); per_cu = 1; }
        grid = cus;
        if (grid % 8) grid -= grid % 8;
    }
    if (grid < 0) return;
    Params p{};
    const float** f = (const float**)&p;
    for (int i = 0; i < 19; ++i) f[i] = (const float*)d_in[i];
    p.out = (float*)d_out; p.ws = (unsigned char*)d_ws;
    (void)hipMemsetAsync(d_ws, 0, WS_ZERO_BYTES, stream);
    void* args[] = {&p};
    hipError_t e = hipLaunchCooperativeKernel((const void*)mega, dim3(grid), dim3(512), args, LDS_BYTES, stream);
    if (e != hipSuccess) fprintf(stderr, "cooperative launch failed: %s (grid %d)\n", hipGetErrorString(e), grid);
}
```
